# Optimizing an MI355X kernel written in HIP

```python
import math
import jax, jax.numpy as jnp
from jax import lax
import numpy as np

D_MODEL = 1024
BATCH = 8
SEQ = 2048
DEPTH = 2
DEC_BATCH = 128
DEC_SEQ = 8
PAST_LEN = 16384
PAGE_SIZE = 128

N_MIXERS = 2
N_A = (DEPTH + 1) // 2
N_B = DEPTH // 2
HGRN_HEADS = 8
HGRN_DK = 128
HGRN_DV = D_MODEL // HGRN_HEADS
MLSTM_HEADS = 8
MLSTM_DV = D_MODEL // MLSTM_HEADS
MLSTM_DK = MLSTM_DV // 2
D_FF = 4 * D_MODEL
CHUNK = 64
GATE_SOFTCAP = 15.0
EPS = 1e-6

kernel_name = "hgrn2_mlstm_hybrid_step"

F32 = jnp.float32


def rmsnorm(x, w):
    x32 = x.astype(F32)
    y = x32 * lax.rsqrt(jnp.mean(x32 * x32, axis=-1, keepdims=True) + EPS)
    return (y * w.astype(F32)).astype(x.dtype)


def head_rmsnorm(o, w):
    H, d = o.shape[-2], o.shape[-1]
    return o * lax.rsqrt(jnp.mean(o * o, axis=-1, keepdims=True) + EPS) * w.astype(F32).reshape(H, d)


def softcap(x, cap):
    return cap * jnp.tanh(x / cap)


def _to_chunks(a, L):
    B, T, H, d = a.shape
    return a.reshape(B, T // L, L, H, d).transpose(1, 0, 3, 2, 4)


def _from_chunks(a):
    NC, B, H, L, d = a.shape
    return a.transpose(1, 0, 3, 2, 4).reshape(B, NC * L, H, d)


def hgrn2_recurrence(q, k, v, log_f, S0):
    T = q.shape[1]
    L = math.gcd(T, CHUNK)
    causal = jnp.tril(jnp.ones((L, L), dtype=bool))

    def step(S, inp):
        qc, kc, vc, fc = inp
        b = jnp.cumsum(fc, axis=2)
        diff = b[:, :, :, None, :] - b[:, :, None, :, :]
        decay = jnp.exp(jnp.where(causal[:, :, None], diff, -jnp.inf))
        A = jnp.einsum('bhtd,bhsd,bhtsd->bhts', qc, kc, decay)
        o = jnp.einsum('bhts,bhsv->bhtv', A, vc) + jnp.einsum('bhtd,bhdv->bhtv', qc * jnp.exp(b), S)
        bL = b[:, :, -1:, :]
        S_new = jnp.exp(bL[:, :, 0, :, None]) * S + jnp.einsum('bhsd,bhsv->bhdv', kc * jnp.exp(bL - b), vc)
        return S_new, o

    S_T, o = lax.scan(step, S0, (_to_chunks(q, L), _to_chunks(k, L), _to_chunks(v, L), _to_chunks(log_f, L)))
    return _from_chunks(o), S_T


def hgrn2_mixer(h, S0, w_in, lb, out_norm_w, w_out):
    B, T, _ = h.shape
    hk = HGRN_HEADS * HGRN_DK
    hv = HGRN_HEADS * HGRN_DV
    proj = h @ w_in
    q, f, i, g = jnp.split(proj, [hk, 2 * hk, 2 * hk + hv], axis=-1)
    forget = lb + (1.0 - lb) * jax.nn.sigmoid(f.astype(F32))
    log_f = jnp.log(forget)
    k = 1.0 - forget
    shp = lambda a, d: a.reshape(B, T, HGRN_HEADS, d)
    o, S_T = hgrn2_recurrence(shp(jax.nn.silu(q.astype(F32)), HGRN_DK), shp(k, HGRN_DK),
                              shp(i.astype(F32), HGRN_DV), shp(log_f, HGRN_DK), S0.astype(F32))
    o = head_rmsnorm(o, out_norm_w) * shp(jax.nn.silu(g.astype(F32)), HGRN_DV)
    out = o.reshape(B, T, hv).astype(h.dtype) @ w_out
    return out, S_T.astype(S0.dtype)


def mlstm_recurrence(q, k, v, log_i, log_f, C0, n0, m0):
    T = q.shape[1]
    L = math.gcd(T, CHUNK)
    causal = jnp.tril(jnp.ones((L, L), dtype=bool))

    def step(carry, inp):
        C, n, m = carry
        qc, kc, vc, ic, fc = inp
        ic = ic[..., 0]
        fc = fc[..., 0]
        b = jnp.cumsum(fc, axis=-1)
        logw = jnp.where(causal, b[..., :, None] - b[..., None, :] + ic[..., None, :], -jnp.inf)
        inter = b + m[..., None]
        m_t = jnp.maximum(inter, jnp.max(logw, axis=-1))
        w_intra = jnp.exp(logw - m_t[..., None])
        w_inter = jnp.exp(inter - m_t)
        s = jnp.einsum('bhtd,bhsd->bhts', qc, kc) * w_intra
        num = jnp.einsum('bhts,bhsv->bhtv', s, vc) + w_inter[..., None] * jnp.einsum('bhtd,bhdv->bhtv', qc, C)
        den = jnp.sum(s, axis=-1) + w_inter * jnp.einsum('bhtd,bhd->bht', qc, n)
        h = num / jnp.maximum(jnp.abs(den), jnp.exp(-m_t))[..., None]
        bL = b[..., -1]
        g = bL[..., None] - b + ic
        m_new = jnp.maximum(bL + m, jnp.max(g, axis=-1))
        ws = jnp.exp(g - m_new[..., None])
        wc = jnp.exp(bL + m - m_new)
        C_new = wc[..., None, None] * C + jnp.einsum('bhs,bhsd,bhsv->bhdv', ws, kc, vc)
        n_new = wc[..., None] * n + jnp.einsum('bhs,bhsd->bhd', ws, kc)
        return (C_new, n_new, m_new), h

    (C_T, n_T, m_T), h = lax.scan(
        step, (C0, n0, m0),
        (_to_chunks(q, L), _to_chunks(k, L), _to_chunks(v, L),
         _to_chunks(log_i[..., None], L), _to_chunks(log_f[..., None], L)))
    return _from_chunks(h), C_T, n_T, m_T


def mlstm_mixer(h, C0, n0, m0, w_in, gate_bias, out_norm_w, w_out):
    B, T, _ = h.shape
    H = MLSTM_HEADS
    qk = H * MLSTM_DK
    hv = H * MLSTM_DV
    proj = (h @ w_in).astype(F32)
    q, k, v, o, gi, gf = jnp.split(proj, [qk, 2 * qk, 2 * qk + hv, 2 * qk + 2 * hv, 2 * qk + 2 * hv + H], axis=-1)
    gb = gate_bias.astype(F32)
    log_i = softcap(gi + gb[:H], GATE_SOFTCAP)
    log_f = jax.nn.log_sigmoid(softcap(gf + gb[H:], GATE_SOFTCAP))
    q = q * (MLSTM_DK ** -0.5)
    hh, C_T, n_T, m_T = mlstm_recurrence(
        q.reshape(B, T, H, MLSTM_DK), k.reshape(B, T, H, MLSTM_DK), v.reshape(B, T, H, MLSTM_DV),
        log_i, log_f, C0.astype(F32), n0.astype(F32), m0.astype(F32))
    hh = head_rmsnorm(hh, out_norm_w) * jax.nn.sigmoid(o).reshape(B, T, H, MLSTM_DV)
    out = hh.reshape(B, T, hv).astype(h.dtype) @ w_out
    return out, C_T.astype(C0.dtype), n_T.astype(n0.dtype), m_T.astype(m0.dtype)


def sqrelu_mlp(x, w_up, w_down):
    return jnp.square(jax.nn.relu(x @ w_up)) @ w_down


def trunk(x, S_in, C_in, n_in, m_in, norm_mixer_w, norm_ffn_w, hgrn_w_in, hgrn_lower_bound_logits,
          hgrn_out_norm_w, hgrn_w_out, mlstm_w_in, mlstm_gate_bias, mlstm_out_norm_w, mlstm_w_out,
          ffn_w_up, ffn_w_down, final_norm_w):
    lower_bounds = jnp.cumsum(jax.nn.softmax(hgrn_lower_bound_logits.astype(F32), axis=0), axis=0)
    S_out, C_out, n_out, m_out = [], [], [], []
    for layer in range(DEPTH):
        hn = rmsnorm(x, norm_mixer_w[layer])
        j = layer // N_MIXERS
        if layer % N_MIXERS == 0:
            out, S = hgrn2_mixer(hn, S_in[j], hgrn_w_in[j], lower_bounds[layer], hgrn_out_norm_w[j], hgrn_w_out[j])
            S_out.append(S)
        else:
            out, C, n, m = mlstm_mixer(hn, C_in[j], n_in[j], m_in[j], mlstm_w_in[j], mlstm_gate_bias[j],
                                       mlstm_out_norm_w[j], mlstm_w_out[j])
            C_out.append(C)
            n_out.append(n)
            m_out.append(m)
        x = x + out
        x = x + sqrelu_mlp(rmsnorm(x, norm_ffn_w[layer]), ffn_w_up[layer], ffn_w_down[layer])
    y = rmsnorm(x, final_norm_w)
    return y, jnp.stack(S_out), jnp.stack(C_out), jnp.stack(n_out), jnp.stack(m_out)


def setup_inputs(seed: int = 0) -> dict:
    key = jax.random.key(seed)
    ks = jax.random.split(key, 24)
    nrm = lambda k, shape, s: jax.random.normal(k, shape, F32) * s
    hk = HGRN_HEADS * HGRN_DK
    hv = HGRN_HEADS * HGRN_DV
    qk = MLSTM_HEADS * MLSTM_DK
    mv = MLSTM_HEADS * MLSTM_DV
    H = MLSTM_HEADS
    gate_bias = jnp.concatenate([
        nrm(ks[10], (N_B, H), 0.1),
        3.0 + 3.0 * jax.random.uniform(ks[11], (N_B, H), F32)], axis=-1)
    return {
        "x_prompt": nrm(ks[0], (BATCH, SEQ, D_MODEL), 1.0),
        "x_sample": nrm(ks[1], (DEC_BATCH, DEC_SEQ, D_MODEL), 1.0),
        "state_hgrn_S": nrm(ks[2], (N_A, DEC_BATCH, HGRN_HEADS, HGRN_DK, HGRN_DV), 0.5),
        "state_mlstm_C": nrm(ks[3], (N_B, DEC_BATCH, MLSTM_HEADS, MLSTM_DK, MLSTM_DV), 0.3),
        "state_mlstm_n": nrm(ks[4], (N_B, DEC_BATCH, MLSTM_HEADS, MLSTM_DK), 0.3),
        "state_mlstm_m": jax.random.uniform(ks[5], (N_B, DEC_BATCH, MLSTM_HEADS), F32, -2.0, 2.0),
        "norm_mixer_w": 1.0 + nrm(ks[6], (DEPTH, D_MODEL), 0.02),
        "norm_ffn_w": 1.0 + nrm(ks[7], (DEPTH, D_MODEL), 0.02),
        "hgrn_w_in": nrm(ks[8], (N_A, D_MODEL, 2 * hk + 2 * hv), D_MODEL ** -0.5),
        "hgrn_lower_bound_logits": nrm(ks[9], (DEPTH + 1, hk), 0.1),
        "hgrn_out_norm_w": 1.0 + nrm(ks[12], (N_A, hv), 0.02),
        "hgrn_w_out": nrm(ks[13], (N_A, hv, D_MODEL), hv ** -0.5),
        "mlstm_w_in": nrm(ks[14], (N_B, D_MODEL, 2 * qk + 2 * mv + 2 * H), D_MODEL ** -0.5),
        "mlstm_gate_bias": gate_bias,
        "mlstm_out_norm_w": 1.0 + nrm(ks[15], (N_B, mv), 0.02),
        "mlstm_w_out": nrm(ks[16], (N_B, mv, D_MODEL), mv ** -0.5),
        "ffn_w_up": nrm(ks[17], (DEPTH, D_MODEL, D_FF), D_MODEL ** -0.5),
        "ffn_w_down": nrm(ks[18], (DEPTH, D_FF, D_MODEL), D_FF ** -0.5),
        "final_norm_w": 1.0 + nrm(ks[19], (D_MODEL,), 0.02),
    }


def reference(x_prompt, x_sample, state_hgrn_S, state_mlstm_C, state_mlstm_n, state_mlstm_m,
              norm_mixer_w, norm_ffn_w, hgrn_w_in, hgrn_lower_bound_logits, hgrn_out_norm_w, hgrn_w_out,
              mlstm_w_in, mlstm_gate_bias, mlstm_out_norm_w, mlstm_w_out, ffn_w_up, ffn_w_down, final_norm_w):
    Bp = x_prompt.shape[0]
    S0 = jnp.zeros((N_A, Bp) + state_hgrn_S.shape[2:], state_hgrn_S.dtype)
    C0 = jnp.zeros((N_B, Bp) + state_mlstm_C.shape[2:], state_mlstm_C.dtype)
    n0 = jnp.zeros((N_B, Bp) + state_mlstm_n.shape[2:], state_mlstm_n.dtype)
    m0 = jnp.zeros((N_B, Bp) + state_mlstm_m.shape[2:], state_mlstm_m.dtype)
    y_prompt, S_p, C_p, n_p, m_p = trunk(
        x_prompt, S0, C0, n0, m0, norm_mixer_w, norm_ffn_w, hgrn_w_in, hgrn_lower_bound_logits,
        hgrn_out_norm_w, hgrn_w_out, mlstm_w_in, mlstm_gate_bias, mlstm_out_norm_w, mlstm_w_out,
        ffn_w_up, ffn_w_down, final_norm_w)
    y_sample, S_s, C_s, n_s, m_s = trunk(
        x_sample, state_hgrn_S, state_mlstm_C, state_mlstm_n, state_mlstm_m, norm_mixer_w, norm_ffn_w,
        hgrn_w_in, hgrn_lower_bound_logits, hgrn_out_norm_w, hgrn_w_out, mlstm_w_in, mlstm_gate_bias,
        mlstm_out_norm_w, mlstm_w_out, ffn_w_up, ffn_w_down, final_norm_w)
    return (y_prompt, y_sample, S_p, C_p, n_p, m_p, S_s, C_s, n_s, m_s)
```

```cpp
#include <hip/hip_runtime.h>
#include <cstdio>
#include <cstdint>
#include <cmath>
namespace pg8 {
#define PG8_LAS __attribute__((address_space(3)))
typedef unsigned short bf16_t;
typedef short bf16x8 __attribute__((ext_vector_type(8)));
typedef float f32x4 __attribute__((ext_vector_type(4)));
typedef unsigned u32x4 __attribute__((ext_vector_type(4)));
constexpr int BM = 256, BK = 64, HALF = 128, HTB = HALF * BK * 2  , STAGE_BYTES = 8 * HTB, NXCD = 8, WGM = 8;

__host__ __device__ __forceinline__ int lds_byte(int r, int c) { const int st = (r >> 4) * 2 + (c >> 5), rr = r & 15, cc = c & 31, ob = rr * 64 + cc * 2; return st * 1024 + (ob ^ (((ob >> 9) & 1) << 5)); }
__host__ __device__ __forceinline__ void stage_rc(int b, int& R, int& C) { const int st = b / 1024, sb = b % 1024, swz = sb ^ (((sb >> 9) & 1) << 5); R = (st >> 1) * 16 + swz / 64; C = (st & 1) * 32 + (swz % 64) / 2; }
__host__ __device__ __forceinline__ int perm32(int rho) { const int n = rho >> 4, i = rho & 15; return 8 * (i >> 2) + 4 * n + (i & 3); }

struct Unit { int pm, pn; };
struct Gemm { const bf16_t* A; const bf16_t* Bt; int M, N, K; };

struct StaticOrder {
    int nM, nN, nwg, G, c;
    __host__ __device__ void init(int M, int N, int G_, int c_) { nM = M / BM; nN = N / BM; nwg = nM * nN; G = G_; c = c_; }
    __host__ __device__ bool next(int i, Unit& u) const {
        const long L = (long)i * G + c; if (L >= nwg) return false;
        int wgid = (int)L; { const int q = nwg / NXCD, r = nwg % NXCD, xcd = wgid % NXCD, off = wgid / NXCD; wgid = (xcd < r ? xcd * (q + 1) : r * (q + 1) + (xcd - r) * q) + off; }
        const int nig = WGM * nN, gid = wgid / nig, fm = gid * WGM, gsz = (nM - fm) < WGM ? (nM - fm) : WGM;
        u.pm = fm + ((wgid % nig) % gsz); u.pn = (wgid % nig) / gsz; return true;
    }
    __device__ __forceinline__ void a_ready(const Unit&) const {}
    __device__ __forceinline__ void done(const Unit&) const {}
};

typedef unsigned u32x2 __attribute__((ext_vector_type(2)));
__device__ __forceinline__ unsigned f2bf_(float f) { unsigned u = __builtin_bit_cast(unsigned, f); return (u + 0x7fffu + ((u >> 16) & 1u)) >> 16; }
__device__ __forceinline__ unsigned pkbf(float lo, float hi) { return f2bf_(lo) | (f2bf_(hi) << 16); }
__device__ __forceinline__ unsigned pkh(float lo, float hi) { const _Float16 a = (_Float16)lo, b = (_Float16)hi; return (unsigned)__builtin_bit_cast(unsigned short, a) | ((unsigned)__builtin_bit_cast(unsigned short, b) << 16); }
__device__ __forceinline__ float sigm(float x) { return __builtin_amdgcn_rcpf(1.0f + __expf(-x)); }
constexpr float NORM_EPS = 1e-6f;

struct EpiHgrnIn {
    static constexpr bool PERM = true, AFTER_DRAIN = false;
    bf16_t* Q; bf16_t* LF; bf16_t* V; bf16_t* G; const float* ss; const float* lb;
    template <int GRP> __device__ __forceinline__ void run(const f32x4 (&acc)[2][2][4][2], const Unit& u, int wr, int wc, int fr, int fq) const {
        const int row0 = u.pm * BM + wr * 64 + fr, gc0 = (u.pn & 3) * BM + wc * 32 + 8 * fq;
        bf16_t* dst = GRP == 0 ? Q : GRP == 1 ? LF : GRP == 2 ? V : G;
        f32x4 lbv[2][2];
        if (GRP == 1) {
#pragma unroll
            for (int bj = 0; bj < 2; ++bj)
#pragma unroll
                for (int n = 0; n < 2; ++n) lbv[bj][n] = *(const f32x4*)(lb + gc0 + bj * HALF + 4 * n);
        }
#pragma unroll
        for (int ai = 0; ai < 2; ++ai)
#pragma unroll
            for (int m = 0; m < 4; ++m) { const int row = row0 + ai * HALF + m * 16; const float rs = rsqrtf(ss[row] * (1.0f / 1024.0f) + NORM_EPS);
                bf16_t* rowp = dst + (size_t)row * 1024 + gc0;
#pragma unroll
                for (int bj = 0; bj < 2; ++bj) { float x[8];
#pragma unroll
                    for (int n = 0; n < 2; ++n)
#pragma unroll
                        for (int j = 0; j < 4; ++j) x[4 * n + j] = acc[ai][bj][m][n][j] * rs;
                    u32x4 w;
                    if (GRP == 0 || GRP == 3) {
#pragma unroll
                        for (int j = 0; j < 8; ++j) x[j] = x[j] * sigm(x[j]);
                    }
                    if (GRP == 1) {
#pragma unroll
                        for (int j = 0; j < 8; ++j) { const float l = lbv[bj][j >> 2][j & 3]; x[j] = __logf(l + (1.0f - l) * sigm(x[j])); }
                        w.x = pkh(x[0], x[1]); w.y = pkh(x[2], x[3]); w.z = pkh(x[4], x[5]); w.w = pkh(x[6], x[7]);
                    } else { w.x = pkbf(x[0], x[1]); w.y = pkbf(x[2], x[3]); w.z = pkbf(x[4], x[5]); w.w = pkbf(x[6], x[7]); }
                    *(u32x4*)(rowp + bj * HALF) = w; } }
    }
    __device__ __forceinline__ void operator()(const f32x4 (&acc)[2][2][4][2], const Unit& u, int wr, int wc, int fr, int fq) const {
        const int grp = u.pn >> 2;
        if (grp == 0) run<0>(acc, u, wr, wc, fr, fq); else if (grp == 1) run<1>(acc, u, wr, wc, fr, fq); else if (grp == 2) run<2>(acc, u, wr, wc, fr, fq); else run<3>(acc, u, wr, wc, fr, fq);
    }
};

struct EpiMlstmIn {
    static constexpr bool PERM = true, AFTER_DRAIN = false;
    bf16_t* Qm; bf16_t* Km; bf16_t* Vm; bf16_t* Om; float* GT; const float* ss; const float* gb;
    template <int GRP> __device__ __forceinline__ void run(const f32x4 (&acc)[2][2][4][2], const Unit& u, int wr, int wc, int fr, int fq) const {
        const int row0 = u.pm * BM + wr * 64 + fr;
        const int ld = GRP < 2 ? 512 : 1024;
        const int tb = GRP == 0 ? 0 : GRP == 1 ? 2 : GRP == 2 ? 4 : 8;
        const int gc0 = (u.pn - tb) * BM + wc * 32 + 8 * fq;
        bf16_t* dst = GRP == 0 ? Qm : GRP == 1 ? Km : GRP == 2 ? Vm : Om;
#pragma unroll
        for (int ai = 0; ai < 2; ++ai)
#pragma unroll
            for (int m = 0; m < 4; ++m) { const int row = row0 + ai * HALF + m * 16; const float rs = rsqrtf(ss[row] * (1.0f / 1024.0f) + NORM_EPS);
                bf16_t* rowp = dst + (size_t)row * ld + gc0;
#pragma unroll
                for (int bj = 0; bj < 2; ++bj) { float x[8];
#pragma unroll
                    for (int n = 0; n < 2; ++n)
#pragma unroll
                        for (int j = 0; j < 4; ++j) x[4 * n + j] = acc[ai][bj][m][n][j] * rs;
                    if (GRP == 0) {
#pragma unroll
                        for (int j = 0; j < 8; ++j) x[j] *= 0.125f;
                    }
                    if (GRP == 3) {
#pragma unroll
                        for (int j = 0; j < 8; ++j) x[j] = sigm(x[j]);
                    }
                    u32x4 w; w.x = pkbf(x[0], x[1]); w.y = pkbf(x[2], x[3]); w.z = pkbf(x[4], x[5]); w.w = pkbf(x[6], x[7]);
                    *(u32x4*)(rowp + bj * HALF) = w; } }
    }
    __device__ __forceinline__ void gates(const f32x4 (&acc)[2][2][4][2], const Unit& u, int wr, int wc, int fr, int fq) const {
        if (wc != 0 || fq >= 2) return;
        const int row0 = u.pm * BM + wr * 64 + fr;
#pragma unroll
        for (int ai = 0; ai < 2; ++ai)
#pragma unroll
            for (int m = 0; m < 4; ++m) { const int row = row0 + ai * HALF + m * 16; const float rs = rsqrtf(ss[row] * (1.0f / 1024.0f) + NORM_EPS);
                float x[8];
#pragma unroll
                for (int n = 0; n < 2; ++n)
#pragma unroll
                    for (int j = 0; j < 4; ++j) x[4 * n + j] = acc[ai][0][m][n][j] * rs;
#pragma unroll
                for (int j = 0; j < 8; ++j) { const float z = 15.0f * tanhf((x[j] + gb[8 * fq + j]) * (1.0f / 15.0f)); x[j] = fq == 0 ? z : -log1pf(expf(-z)); }
                float* o = GT + (size_t)row * 16 + 8 * fq;
                *(f32x4*)o = (f32x4){x[0], x[1], x[2], x[3]}; *(f32x4*)(o + 4) = (f32x4){x[4], x[5], x[6], x[7]}; }
    }
    __device__ __forceinline__ void operator()(const f32x4 (&acc)[2][2][4][2], const Unit& u, int wr, int wc, int fr, int fq) const {
        const int pn = u.pn;
        if (pn < 2) run<0>(acc, u, wr, wc, fr, fq); else if (pn < 4) run<1>(acc, u, wr, wc, fr, fq); else if (pn < 8) run<2>(acc, u, wr, wc, fr, fq); else if (pn < 12) run<3>(acc, u, wr, wc, fr, fq); else gates(acc, u, wr, wc, fr, fq);
    }
};

struct EpiUp {
    static constexpr bool PERM = true, AFTER_DRAIN = false;
    bf16_t* U; const float* ss;
    __device__ __forceinline__ void operator()(const f32x4 (&acc)[2][2][4][2], const Unit& u, int wr, int wc, int fr, int fq) const {
        const int row0 = u.pm * BM + wr * 64 + fr, c0 = u.pn * BM + wc * 32 + 8 * fq;
#pragma unroll
        for (int ai = 0; ai < 2; ++ai)
#pragma unroll
            for (int m = 0; m < 4; ++m) { const int row = row0 + ai * HALF + m * 16; const float rs = rsqrtf(ss[row] * (1.0f / 1024.0f) + NORM_EPS);
                bf16_t* rowp = U + (size_t)row * 4096 + c0;
#pragma unroll
                for (int bj = 0; bj < 2; ++bj) { float x[8];
#pragma unroll
                    for (int n = 0; n < 2; ++n)
#pragma unroll
                        for (int j = 0; j < 4; ++j) { const float a = fmaxf(acc[ai][bj][m][n][j] * rs, 0.0f); x[4 * n + j] = a * a; }
                    u32x4 w; w.x = pkbf(x[0], x[1]); w.y = pkbf(x[2], x[3]); w.z = pkbf(x[4], x[5]); w.w = pkbf(x[6], x[7]);
                    *(u32x4*)(rowp + bj * HALF) = w; } }
    }
};

struct EpiResid {
    static constexpr bool PERM = false, AFTER_DRAIN = false;
    const float* base0; const float* base1; float* X; bf16_t* Xb; float* ssq;
    __device__ __forceinline__ void operator()(const f32x4 (&acc)[2][2][4][2], const Unit& u, int wr, int wc, int fr, int fq) const {
        const int row0 = u.pm * BM + wr * 64 + fr, c0 = u.pn * BM + wc * 32 + 4 * fq;
        const float* bs = u.pm < 64 ? base0 : base1 - (size_t)16384 * 1024;
#pragma unroll
        for (int ai = 0; ai < 2; ++ai)
#pragma unroll
            for (int m = 0; m < 4; ++m) { const int row = row0 + ai * HALF + m * 16; const size_t off = (size_t)row * 1024 + c0; float s = 0.f;
#pragma unroll
                for (int bj = 0; bj < 2; ++bj)
#pragma unroll
                    for (int n = 0; n < 2; ++n) { const f32x4 b = *(const f32x4*)(bs + off + bj * HALF + n * 16); const f32x4 v = b + acc[ai][bj][m][n];
                        *(f32x4*)(X + off + bj * HALF + n * 16) = v; u32x2 w; w.x = pkbf(v[0], v[1]); w.y = pkbf(v[2], v[3]); *(u32x2*)(Xb + off + bj * HALF + n * 16) = w;
                        s += (v[0] * v[0] + v[1] * v[1]) + (v[2] * v[2] + v[3] * v[3]); }
                s += __shfl_xor(s, 16); s += __shfl_xor(s, 32);
                if (fq == 0) atomicAdd(ssq + row, s); }
    }
};
template <class Epi, class Sched, bool ALIGN_EPI = false, bool SP2 = false>
__device__ __forceinline__ void gemm_phase(PG8_LAS unsigned char* lds, const Gemm g, const Sched& S, const Epi& E) {
    const int tid = threadIdx.x, wid = __builtin_amdgcn_readfirstlane(tid >> 6), lane = tid & 63, wr = wid >> 2, wc = wid & 3, fr = lane & 15, fq = lane >> 4;
    const int K = g.K, nt = K / BK;
    unsigned voffA[2], voffB[2];
#pragma unroll
    for (int i = 0; i < 2; ++i) { int R, C; stage_rc(tid * 16 + i * 8192, R, C); const int Rb = Epi::PERM ? ((R & ~31) + perm32(R & 31)) : R;
        voffA[i] = (unsigned)(R * K + C) * 2u; voffB[i] = (unsigned)(Rb * K + C) * 2u; }
    const size_t kstep = (size_t)(BK * 2);
    const size_t hstep = (size_t)HALF * K * 2;
    const size_t tstep = 2 * hstep;
    const unsigned ldsw = (unsigned)wid * 1024u;
    const int aoff = lds_byte(wr * 64 + fr, fq * 8), boff = lds_byte(wc * 32 + fr, fq * 8);
#define PG8_SA(b, h) (((b) * 2 + (h)) * HTB)
#define PG8_SB(b, h) ((4 + (b) * 2 + (h)) * HTB)
#define PG8_STAGE(bufoff, gbase, voff) do { _Pragma("unroll") for (int _i = 0; _i < 2; ++_i) \
        __builtin_amdgcn_global_load_lds((const unsigned*)((const char*)(gbase) + (voff)[_i]), (PG8_LAS unsigned*)(lds + (bufoff) + ldsw + _i * 8192), 16, 0, 0); } while (0)
#define PG8_LDA(dst, b, h) do { _Pragma("unroll") for (int m = 0; m < 4; ++m) _Pragma("unroll") for (int k = 0; k < 2; ++k) dst[m][k] = *(const PG8_LAS bf16x8*)(lds + PG8_SA(b, h) + aoff + m * 2048 + k * 1024); } while (0)
#define PG8_LDB(dst, b, h) do { _Pragma("unroll") for (int n = 0; n < 2; ++n) _Pragma("unroll") for (int k = 0; k < 2; ++k) dst[n][k] = *(const PG8_LAS bf16x8*)(lds + PG8_SB(b, h) + boff + n * 2048 + k * 1024); } while (0)
#define PG8_MMA(ai, bj, At, Bt) do { __builtin_amdgcn_s_setprio(1); _Pragma("unroll") for (int m = 0; m < 4; ++m) _Pragma("unroll") for (int n = 0; n < 2; ++n) _Pragma("unroll") for (int k = 0; k < 2; ++k) \
        acc[ai][bj][m][n] = __builtin_amdgcn_mfma_f32_16x16x32_bf16(Bt[n][k], At[m][k], acc[ai][bj][m][n], 0, 0, 0); __builtin_amdgcn_s_setprio(0); } while (0)
#define PG8_WAIT_V(n) asm volatile("s_waitcnt vmcnt(" #n ")" ::: "memory")
#define PG8_WAIT_L(n) asm volatile("s_waitcnt lgkmcnt(" #n ")" ::: "memory")
#define PG8_BAR __builtin_amdgcn_s_barrier()
#define PG8_SCHED __builtin_amdgcn_sched_barrier(0)
    Unit cur, nxt; int ui = 0;
    if (!S.next(0, cur)) return;
    f32x4 acc[2][2][4][2];
#pragma unroll
    for (int a = 0; a < 2; ++a)
#pragma unroll
        for (int b = 0; b < 2; ++b)
#pragma unroll
            for (int m = 0; m < 4; ++m)
#pragma unroll
                for (int n = 0; n < 2; ++n) acc[a][b][m][n] = (f32x4){0.f, 0.f, 0.f, 0.f};
    bf16x8 At[4][2], B0[2][2], B1[2][2];
    const char* cA = (const char*)g.A + (size_t)cur.pm * tstep; const char* cB = (const char*)g.Bt + (size_t)cur.pn * tstep;
    S.a_ready(cur);
    if constexpr (SP2) {
        PG8_STAGE(PG8_SB(0, 0), cB, voffB); PG8_STAGE(PG8_SB(0, 1), cB + hstep, voffB); PG8_STAGE(PG8_SA(0, 0), cA, voffA); PG8_STAGE(PG8_SA(0, 1), cA + hstep, voffA);
        if (wr == 1) PG8_BAR;
        PG8_WAIT_V(2); PG8_BAR;
        PG8_STAGE(PG8_SB(1, 0), cB + kstep, voffB); PG8_STAGE(PG8_SA(1, 0), cA + kstep, voffA); PG8_STAGE(PG8_SB(1, 1), cB + hstep + kstep, voffB);
        PG8_WAIT_V(6); PG8_BAR;
    } else {
        PG8_STAGE(PG8_SB(0, 0), cB, voffB); PG8_STAGE(PG8_SA(0, 0), cA, voffA); PG8_STAGE(PG8_SB(0, 1), cB + hstep, voffB); PG8_STAGE(PG8_SA(0, 1), cA + hstep, voffA);
        if (wr == 1) PG8_BAR;
        PG8_WAIT_V(4); PG8_BAR;
        PG8_STAGE(PG8_SB(1, 0), cB + kstep, voffB); PG8_STAGE(PG8_SA(1, 0), cA + kstep, voffA); PG8_STAGE(PG8_SB(1, 1), cB + hstep + kstep, voffB);
        PG8_WAIT_V(6); PG8_BAR;
    }
    for (;;) {
        const bool has_next = S.next(ui + 1, nxt);
        const char* nA = has_next ? (const char*)g.A + (size_t)nxt.pm * tstep : cA; const char* nB = has_next ? (const char*)g.Bt + (size_t)nxt.pn * tstep : cB;
        for (int t = 0; t < nt; t += 2) {
            const bool last = (t == nt - 2);
            const char* a1 = cA + (size_t)(t + 1) * kstep;
            const char* a2 = last ? nA : cA + (size_t)(t + 2) * kstep; const char* b2 = last ? nB : cB + (size_t)(t + 2) * kstep;
            const char* a3 = a2 + kstep; const char* b3 = b2 + kstep;
            if (last && has_next) S.a_ready(nxt);
            if constexpr (SP2) {
            PG8_LDB(B0, 0, 0); PG8_LDB(B1, 0, 1); PG8_SCHED; PG8_LDA(At, 0, 0); PG8_STAGE(PG8_SA(1, 1), a1 + hstep, voffA);
            PG8_WAIT_V(8); PG8_WAIT_L(0); PG8_BAR; PG8_MMA(0, 0, At, B0); PG8_MMA(0, 1, At, B1); PG8_BAR; PG8_SCHED;
            PG8_LDA(At, 0, 1); PG8_STAGE(PG8_SB(0, 0), b2, voffB); PG8_STAGE(PG8_SB(0, 1), b2 + hstep, voffB); PG8_STAGE(PG8_SA(0, 0), a2, voffA);
            PG8_WAIT_V(8); PG8_WAIT_L(0); PG8_BAR; PG8_MMA(1, 0, At, B0); PG8_MMA(1, 1, At, B1); PG8_BAR; PG8_SCHED;
            PG8_LDB(B0, 1, 0); PG8_LDB(B1, 1, 1); PG8_SCHED; PG8_LDA(At, 1, 0); PG8_STAGE(PG8_SA(0, 1), a2 + hstep, voffA);
            PG8_WAIT_V(8); PG8_WAIT_L(0); PG8_BAR; PG8_MMA(0, 0, At, B0); PG8_MMA(0, 1, At, B1); PG8_BAR; PG8_SCHED;
            PG8_LDA(At, 1, 1); PG8_STAGE(PG8_SB(1, 0), b3, voffB); PG8_STAGE(PG8_SB(1, 1), b3 + hstep, voffB); PG8_STAGE(PG8_SA(1, 0), a3, voffA);
            PG8_WAIT_V(8); PG8_WAIT_L(0); PG8_BAR; PG8_MMA(1, 0, At, B0); PG8_MMA(1, 1, At, B1); PG8_BAR; PG8_SCHED;
            } else {
            PG8_LDB(B0, 0, 0); PG8_SCHED; PG8_LDA(At, 0, 0); PG8_STAGE(PG8_SA(1, 1), a1 + hstep, voffA);
            PG8_WAIT_L(8); PG8_BAR; PG8_WAIT_L(0); PG8_MMA(0, 0, At, B0); PG8_BAR; PG8_SCHED;
            PG8_LDB(B1, 0, 1); PG8_STAGE(PG8_SB(0, 0), b2, voffB);
            PG8_BAR; PG8_WAIT_L(0); PG8_MMA(0, 1, At, B1); PG8_BAR;
            PG8_LDA(At, 0, 1); PG8_STAGE(PG8_SA(0, 0), a2, voffA);
            PG8_BAR; PG8_WAIT_L(0); PG8_MMA(1, 0, At, B0); PG8_BAR; PG8_SCHED;
            PG8_STAGE(PG8_SB(0, 1), b2 + hstep, voffB);
            PG8_WAIT_V(6); PG8_BAR; PG8_MMA(1, 1, At, B1); PG8_BAR;
            PG8_LDB(B0, 1, 0); PG8_SCHED; PG8_LDA(At, 1, 0); PG8_STAGE(PG8_SA(0, 1), a2 + hstep, voffA);
            PG8_WAIT_L(8); PG8_BAR; PG8_WAIT_L(0); PG8_MMA(0, 0, At, B0); PG8_BAR; PG8_SCHED;
            PG8_LDB(B1, 1, 1); PG8_STAGE(PG8_SB(1, 0), b3, voffB);
            PG8_BAR; PG8_WAIT_L(0); PG8_MMA(0, 1, At, B1); PG8_BAR;
            PG8_LDA(At, 1, 1); PG8_STAGE(PG8_SA(1, 0), a3, voffA);
            PG8_BAR; PG8_WAIT_L(0); PG8_MMA(1, 0, At, B0); PG8_BAR; PG8_SCHED;
            PG8_STAGE(PG8_SB(1, 1), b3 + hstep, voffB);
            PG8_WAIT_V(6); PG8_BAR; PG8_MMA(1, 1, At, B1); PG8_BAR;
            }
        }
        if constexpr (ALIGN_EPI) { if (wr == 0) PG8_BAR; }
        if constexpr (!Epi::AFTER_DRAIN) { E(acc, cur, wr, wc, fr, fq); S.done(cur); }
        if (!has_next) break;
#pragma unroll
        for (int a = 0; a < 2; ++a)
#pragma unroll
            for (int b = 0; b < 2; ++b)
#pragma unroll
                for (int m = 0; m < 4; ++m)
#pragma unroll
                    for (int n = 0; n < 2; ++n) acc[a][b][m][n] = (f32x4){0.f, 0.f, 0.f, 0.f};
        cur = nxt; cA = nA; cB = nB; ++ui;
        if constexpr (ALIGN_EPI) { if (wr == 1) PG8_BAR; }
    }
    PG8_WAIT_V(0);
    if constexpr (!ALIGN_EPI) { if (wr == 0) PG8_BAR; }
    PG8_BAR;
    if constexpr (Epi::AFTER_DRAIN) { E.fused(acc, cur, wr, wc, fr, fq, lds, wid, lane); S.done(cur); }
#undef PG8_SA
#undef PG8_SB
#undef PG8_STAGE
#undef PG8_LDA
#undef PG8_LDB
#undef PG8_MMA
#undef PG8_WAIT_V
#undef PG8_WAIT_L
#undef PG8_BAR
#undef PG8_SCHED
}
}
constexpr int NWAVES = 8;
#ifndef MK_N_LAUNCHES
#define MK_N_LAUNCHES 1
#endif
constexpr int N_PHASES = 12;
constexpr int MROWS = 17408, MP = 16384, DM = 1024, DFF = 4096, NIN1 = 3088, NIN1P = 3328;
constexpr size_t MiB = 1u << 20;
constexpr size_t WS_CTL = 0, CTL_ZERO_BYTES = 1 * MiB;
constexpr size_t WS_SS = 128 * 1024;
constexpr size_t WS_LB = 1 * MiB;
constexpr size_t WS_WIN0 = 2 * MiB, WS_WOUT0 = 10 * MiB, WS_WUP0 = 12 * MiB, WS_WDN0 = 20 * MiB, WS_WIN1 = 28 * MiB, WS_WOUT1 = 35 * MiB, WS_WUP1 = 37 * MiB, WS_WDN1 = 45 * MiB;
constexpr size_t WS_XB = 53 * MiB;
constexpr size_t WS_ACT = 87 * MiB;
constexpr size_t ACT_T = (size_t)MROWS * 1024 * 2;
constexpr size_t WS_Q = WS_ACT, WS_LF = WS_ACT + ACT_T, WS_V = WS_ACT + 2 * ACT_T, WS_G = WS_ACT + 3 * ACT_T;
constexpr size_t WS_QM = WS_ACT, WS_KM = WS_ACT + ACT_T / 2, WS_VM = WS_ACT + ACT_T, WS_OM = WS_ACT + 2 * ACT_T, WS_GT = WS_ACT + 3 * ACT_T;
constexpr size_t WS_END = WS_ACT + 4 * ACT_T;
static_assert(WS_END <= 224 * MiB, "d_ws map");
constexpr int CW_BAR = 4096;
constexpr size_t OUT_Y = 0, OUT_SP = 17825792, OUT_CP = 18874368, OUT_NP = 19398656, OUT_MP = 19402752, OUT_SS = 19402816, OUT_CS = 36180032, OUT_NS = 44568640, OUT_MS = 44634176, OUT_END = 44635200;
constexpr int RING_BYTES = 131072, LDSCTL_OFF = RING_BYTES, MISC_OFF = LDSCTL_OFF + 320, LDS_BYTES = 147456;

#define GAS __attribute__((address_space(1)))
#define LAS __attribute__((address_space(3)))
typedef unsigned short bf16;
typedef unsigned v4u __attribute__((ext_vector_type(4)));
typedef unsigned v2u __attribute__((ext_vector_type(2)));
typedef float f32x4 __attribute__((ext_vector_type(4)));
typedef float f32x2 __attribute__((ext_vector_type(2)));
typedef short bf16x8 __attribute__((ext_vector_type(8)));
typedef GAS unsigned gu32;
#define RLX_AGENT __ATOMIC_RELAXED, __HIP_MEMORY_SCOPE_AGENT
#define LDS_WAIT() asm volatile("s_waitcnt lgkmcnt(0)" ::: "memory")
#define VM_WAIT() asm volatile("s_waitcnt vmcnt(0)" ::: "memory")
__device__ __forceinline__ unsigned f2bf(float f) { unsigned u = __builtin_bit_cast(unsigned, f); return (u + 0x7fffu + ((u >> 16) & 1u)) >> 16; }
__device__ __forceinline__ unsigned pk2(float lo, float hi) { return f2bf(lo) | (f2bf(hi) << 16); }
__device__ __forceinline__ float bflo(unsigned w) { return __builtin_bit_cast(float, w << 16); }
__device__ __forceinline__ float bfhi(unsigned w) { return __builtin_bit_cast(float, w & 0xffff0000u); }
__device__ __forceinline__ float bf1(unsigned short h) { return __builtin_bit_cast(float, (unsigned)h << 16); }
__device__ __forceinline__ float hlo(unsigned w) { return (float)__builtin_bit_cast(_Float16, (unsigned short)(w & 0xffffu)); }
__device__ __forceinline__ float hhi(unsigned w) { return (float)__builtin_bit_cast(_Float16, (unsigned short)(w >> 16)); }
__device__ __forceinline__ float h1(unsigned short h) { return (float)__builtin_bit_cast(_Float16, h); }

#define XB_TMO      128
#define XB_XCNT(j)  (256  + 64 * (j))
#define XB_XSUB(j)  (1280 + 64 * (j))
#define XB_XGEN(j)  (2304 + 64 * (j))
#define XB_TOP      3328
#define XB_TOPGEN   3392
#define XCD_BAR_WORDS 3456
#define XB_SPIN_CAP (1u << 18)
__device__ __forceinline__ unsigned xb_ld(unsigned* p)              { return __hip_atomic_load(p, __ATOMIC_RELAXED, __HIP_MEMORY_SCOPE_AGENT); }
__device__ __forceinline__ unsigned xb_add(unsigned* p, unsigned v) { return __hip_atomic_fetch_add(p, v, __ATOMIC_RELAXED, __HIP_MEMORY_SCOPE_AGENT); }
__device__ __forceinline__ unsigned xb_xcc_id() { return (unsigned)__builtin_amdgcn_s_getreg((3 << 11) | 20) & 0xFu; }
#define XB_SPIN(cond, bar) do { unsigned _sp = 0; while (cond) { __builtin_amdgcn_s_sleep(1); \
    if ((++_sp & 255u) == 0u) { if (xb_ld(&(bar)[XB_TMO])) break; if (_sp > XB_SPIN_CAP) { atomicAdd(&(bar)[XB_TMO], 1u); break; } } } } while (0)
struct XcdBarrier { unsigned* bar; unsigned x; volatile LAS unsigned* st; };
__device__ __forceinline__ XcdBarrier xcd_barrier_post(unsigned* bar, volatile LAS unsigned* st) {
    XcdBarrier b; b.bar = bar; b.x = xb_xcc_id(); b.st = st;
    if (threadIdx.x == 0) (void)xb_add(&bar[XB_XCNT(b.x)], 1u);
    return b;
}
__device__ __forceinline__ void xcd_barrier_complete(unsigned* bar, unsigned x, unsigned& nloc, unsigned& nx) {
    const unsigned G = gridDim.x * gridDim.y * gridDim.z;
    unsigned sum, cnt, mine, sp = 0u;
    for (;;) {
        sum = 0u; cnt = 0u; mine = 0u;
#pragma unroll
        for (unsigned j = 0; j < 16; ++j) { const unsigned c = xb_ld(&bar[XB_XCNT(j)]); sum += c; cnt += (c > 0u) ? 1u : 0u; mine = (j == x) ? c : mine; }
        if (sum == G) break;
        __builtin_amdgcn_s_sleep(1);
        if ((++sp & 255u) == 0u) { if (xb_ld(&bar[XB_TMO])) break; if (sp > XB_SPIN_CAP) { atomicAdd(&bar[XB_TMO], 1u); break; } }
    }
    nloc = mine > 0u ? mine : 1u; nx = cnt > 0u ? cnt : 1u;
}
__device__ __forceinline__ void xcd_barrier(const XcdBarrier& b) {
    asm volatile("s_waitcnt vmcnt(0)" ::: "memory");
    __syncthreads();
    if (threadIdx.x == 0) {
        unsigned* bar = b.bar;
        __builtin_amdgcn_s_waitcnt(0);
        unsigned nloc = b.st[0], nx = b.st[1];
        if (nloc == 0u) { xcd_barrier_complete(bar, b.x, nloc, nx); b.st[0] = nloc; b.st[1] = nx; }
        const unsigned old = xb_add(&bar[XB_XSUB(b.x)], 1u);
        const unsigned gen = old / nloc;
        if (old + 1u == (gen + 1u) * nloc) {
            __builtin_amdgcn_fence(__ATOMIC_RELEASE, "agent");
            asm volatile("s_waitcnt vmcnt(0)" ::: "memory");
            const unsigned og = xb_add(&bar[XB_TOP], 1u);
            const unsigned tg = og / nx;
            if (og + 1u == (tg + 1u) * nx) xb_add(&bar[XB_TOPGEN], 1u);
            else XB_SPIN(xb_ld(&bar[XB_TOPGEN]) == tg, bar);
            __builtin_amdgcn_fence(__ATOMIC_ACQUIRE, "agent");
            xb_add(&bar[XB_XGEN(b.x)], 1u);
            asm volatile("s_waitcnt vmcnt(0)" ::: "memory");
        } else {
            XB_SPIN(xb_ld(&bar[XB_XGEN(b.x)]) == gen, bar);
            __builtin_amdgcn_fence(__ATOMIC_ACQUIRE, "agent");
            asm volatile("s_waitcnt vmcnt(0)" ::: "memory");
        }
    }
    __syncthreads();
}

__device__ __forceinline__ float wave_sum(float v) {
#pragma unroll
    for (int o = 1; o < 64; o <<= 1) v += __shfl_xor(v, o);
    return v;
}
__device__ __forceinline__ void p0_transpose_item(const float* W, int K, int N, const float* sc, bf16* WT, LAS float* scr, int item, int lane) {
    const int nblk = (N + 31) / 32, kb = item / nblk, nb = item % nblk, k0 = 64 * kb, n0 = 32 * nb;
    const bool nok = (n0 + (lane & 31)) < N;
#pragma unroll 8
    for (int i = 0; i < 32; ++i) { const int kk = 2 * i + (lane >> 5); float v = nok ? W[(size_t)(k0 + kk) * N + n0 + (lane & 31)] : 0.f; if (sc) v *= sc[k0 + kk]; scr[kk * 33 + (lane & 31)] = v; }
    LDS_WAIT(); asm volatile("" ::: "memory");
    const int c = lane & 7;
#pragma unroll
    for (int j = 0; j < 4; ++j) { const int n = (lane >> 3) + 8 * j; const LAS float* s = scr + (8 * c) * 33 + n;
        v4u o; o.x = pk2(s[0 * 33], s[1 * 33]); o.y = pk2(s[2 * 33], s[3 * 33]); o.z = pk2(s[4 * 33], s[5 * 33]); o.w = pk2(s[6 * 33], s[7 * 33]);
        *(GAS v4u*)(WT + (size_t)(n0 + n) * K + k0 + 8 * c) = o; }
    LDS_WAIT(); asm volatile("" ::: "memory");
}
#define MFMA16(a, b, c) __builtin_amdgcn_mfma_f32_16x16x32_bf16((a), (b), (c), 0, 0, 0)
#define LDSV(T, off) (*(LAS T*)(lds + (off)))
#define LDSF(off) (*(const LAS bf16x8*)(lds + (off)))
namespace hg {
constexpr int QP = 0, KP = QP + 64 * 272, KPPT = KP + 64 * 272, VT = KPPT + 128 * 144, AM = VT + 128 * 144, ST = AM + 64 * 144, GT = ST + 128 * 272, DEC = GT + 8 * 128 * 4, NP = DEC + 512, END = NP + 512;
static_assert(END <= RING_BYTES, "hgrn LDS");
}
__device__ __forceinline__ void hgrn_prompt_item(LAS unsigned char* lds, int b, int h, const bf16* Qb, const bf16* LFb, const bf16* Vb, const bf16* Gb, bf16* Ob, const float* onw, float* S_out) {
    using namespace hg;
    const int tid = threadIdx.x, lane = tid & 63, w = __builtin_amdgcn_readfirstlane(tid >> 6), fr = lane & 15, fq = lane >> 4;
    const int tb = w & 3, wh = w >> 2;
    const size_t rowb = (size_t)b * 2048;
    const int colp = h * 128 + 2 * lane;
    __syncthreads();
    for (int i = tid; i < 128 * 272 / 4; i += 512) LDSV(unsigned, ST + 4 * i) = 0u;
    __syncthreads();
    f32x4 sacc[8];
#pragma unroll
    for (int j = 0; j < 8; ++j) sacc[j] = (f32x4){0.f, 0.f, 0.f, 0.f};
    f32x4 wn[4];
#pragma unroll
    for (int j = 0; j < 4; ++j) wn[j] = *(const f32x4*)(onw + h * 128 + (4 * wh + j) * 16 + 4 * fq);
    unsigned rq[8], rl[8], rv[8];
#pragma unroll
    for (int i = 0; i < 8; ++i) { const size_t e = (rowb + 8 * w + i) * 1024 + colp; rq[i] = *(const unsigned*)(Qb + e); rl[i] = *(const unsigned*)(LFb + e); rv[i] = *(const unsigned*)(Vb + e); }
    for (int c = 0; c < 32; ++c) {
        float c0[8], c1[8]; { float a0 = 0.f, a1 = 0.f;
#pragma unroll
            for (int i = 0; i < 8; ++i) { a0 += hlo(rl[i]); a1 += hhi(rl[i]); c0[i] = a0; c1[i] = a1; }
            LDSV(f32x2, GT + (w * 128 + 2 * lane) * 4) = (f32x2){a0, a1}; }
        __syncthreads();
        float pre0 = 0.f, pre1 = 0.f, tot0 = 0.f, tot1 = 0.f;
#pragma unroll
        for (int g = 0; g < 8; ++g) { const f32x2 x = LDSV(f32x2, GT + (g * 128 + 2 * lane) * 4); tot0 += x.x; tot1 += x.y; if (g < w) { pre0 += x.x; pre1 += x.y; } }
        if (w == 0) LDSV(f32x2, DEC + 2 * lane * 4) = (f32x2){__expf(tot0), __expf(tot1)};
        { unsigned kk0[4], kk1[4], vv0[4], vv1[4]; float pk0 = 0.f, pk1 = 0.f;
#pragma unroll
            for (int i = 0; i < 8; ++i) {
                const float b0 = pre0 + c0[i], b1 = pre1 + c1[i];
                const float k0 = 1.0f - __expf(hlo(rl[i])), k1 = 1.0f - __expf(hhi(rl[i]));
                const float e0 = __expf(b0), e1 = __expf(b1), n0 = __expf(-b0), n1 = __expf(-b1), l0 = __expf(tot0 - b0), l1 = __expf(tot1 - b1);
                LDSV(unsigned, QP + (8 * w + i) * 272 + 4 * lane) = pk2(bflo(rq[i]) * e0, bfhi(rq[i]) * e1);
                LDSV(unsigned, KP + (8 * w + i) * 272 + 4 * lane) = pk2(k0 * n0, k1 * n1);
                const float x0 = k0 * l0, x1 = k1 * l1;
                if (i & 1) { kk0[i >> 1] = pk2(pk0, x0); kk1[i >> 1] = pk2(pk1, x1); vv0[i >> 1] = (rv[i - 1] & 0xffffu) | (rv[i] << 16); vv1[i >> 1] = (rv[i - 1] >> 16) | (rv[i] & 0xffff0000u); }
                else { pk0 = x0; pk1 = x1; }
            }
            LDSV(v4u, KPPT + (2 * lane) * 144 + 16 * w) = (v4u){kk0[0], kk0[1], kk0[2], kk0[3]};
            LDSV(v4u, KPPT + (2 * lane + 1) * 144 + 16 * w) = (v4u){kk1[0], kk1[1], kk1[2], kk1[3]};
            LDSV(v4u, VT + (2 * lane) * 144 + 16 * w) = (v4u){vv0[0], vv0[1], vv0[2], vv0[3]};
            LDSV(v4u, VT + (2 * lane + 1) * 144 + 16 * w) = (v4u){vv1[0], vv1[1], vv1[2], vv1[3]}; }
        if (c + 1 < 32) {
#pragma unroll
            for (int i = 0; i < 8; ++i) { const size_t e = (rowb + (size_t)(c + 1) * 64 + 8 * w + i) * 1024 + colp; rq[i] = *(const unsigned*)(Qb + e); rl[i] = *(const unsigned*)(LFb + e); rv[i] = *(const unsigned*)(Vb + e); }
        }
        const size_t orow = (rowb + (size_t)c * 64 + tb * 16 + fr) * 1024 + h * 128 + 4 * fq;
        v2u rg[4];
#pragma unroll
        for (int j = 0; j < 4; ++j) rg[j] = *(const v2u*)(Gb + orow + (4 * wh + j) * 16);
        __syncthreads();
#pragma unroll
        for (int j = 0; j < 2; ++j) { const int sb = 2 * wh + j; f32x4 a = (f32x4){0.f, 0.f, 0.f, 0.f};
            if (sb <= tb) {
#pragma unroll
                for (int kk = 0; kk < 4; ++kk) a = MFMA16(LDSF(KP + (sb * 16 + fr) * 272 + kk * 64 + fq * 16), LDSF(QP + (tb * 16 + fr) * 272 + kk * 64 + fq * 16), a);
                const int t = tb * 16 + fr, s0 = sb * 16 + 4 * fq;
#pragma unroll
                for (int r = 0; r < 4; ++r) if (s0 + r > t) a[r] = 0.f;
            }
            LDSV(v2u, AM + (tb * 16 + fr) * 144 + (sb * 16 + 4 * fq) * 2) = (v2u){pk2(a[0], a[1]), pk2(a[2], a[3])}; }
        __syncthreads();
        f32x4 oacc[4];
        { bf16x8 bA[2], bQ[4];
#pragma unroll
            for (int kk = 0; kk < 2; ++kk) bA[kk] = LDSF(AM + (tb * 16 + fr) * 144 + kk * 64 + fq * 16);
#pragma unroll
            for (int kk = 0; kk < 4; ++kk) bQ[kk] = LDSF(QP + (tb * 16 + fr) * 272 + kk * 64 + fq * 16);
#pragma unroll
            for (int j = 0; j < 4; ++j) { const int dvb = 4 * wh + j; f32x4 a = (f32x4){0.f, 0.f, 0.f, 0.f};
#pragma unroll
                for (int kk = 0; kk < 2; ++kk) a = MFMA16(LDSF(VT + (dvb * 16 + fr) * 144 + kk * 64 + fq * 16), bA[kk], a);
#pragma unroll
                for (int kk = 0; kk < 4; ++kk) a = MFMA16(LDSF(ST + (dvb * 16 + fr) * 272 + kk * 64 + fq * 16), bQ[kk], a);
                oacc[j] = a; } }
        { float ss = 0.f;
#pragma unroll
            for (int j = 0; j < 4; ++j) ss += (oacc[j][0] * oacc[j][0] + oacc[j][1] * oacc[j][1]) + (oacc[j][2] * oacc[j][2] + oacc[j][3] * oacc[j][3]);
            ss += __shfl_xor(ss, 16); ss += __shfl_xor(ss, 32);
            if (fq == 0) LDSV(float, NP + ((tb * 16 + fr) * 2 + wh) * 4) = ss; }
        { const f32x4 dec = LDSV(f32x4, DEC + (16 * w + 4 * fq) * 4); bf16x8 aK[2];
#pragma unroll
            for (int kk = 0; kk < 2; ++kk) aK[kk] = LDSF(KPPT + (16 * w + fr) * 144 + kk * 64 + fq * 16);
#pragma unroll
            for (int j = 0; j < 8; ++j) { f32x4 a = sacc[j] * dec;
#pragma unroll
                for (int kk = 0; kk < 2; ++kk) a = MFMA16(aK[kk], LDSF(VT + (j * 16 + fr) * 144 + kk * 64 + fq * 16), a);
                sacc[j] = a; } }
        __syncthreads();
        { const f32x2 p = LDSV(f32x2, NP + (tb * 16 + fr) * 8); const float rstd = rsqrtf((p.x + p.y) * (1.0f / 128.0f) + 1e-6f);
#pragma unroll
            for (int j = 0; j < 4; ++j) { const f32x4 o = oacc[j] * rstd * wn[j];
                *(v2u*)(Ob + orow + (4 * wh + j) * 16) = (v2u){pk2(o[0] * bflo(rg[j].x), o[1] * bfhi(rg[j].x)), pk2(o[2] * bflo(rg[j].y), o[3] * bfhi(rg[j].y))}; } }
#pragma unroll
        for (int j = 0; j < 8; ++j) LDSV(v2u, ST + (j * 16 + fr) * 272 + (16 * w + 4 * fq) * 2) = (v2u){pk2(sacc[j][0], sacc[j][1]), pk2(sacc[j][2], sacc[j][3])};
    }
    float* so = S_out + (size_t)(b * 8 + h) * 128 * 128;
#pragma unroll
    for (int j = 0; j < 8; ++j)
#pragma unroll
        for (int r = 0; r < 4; ++r) so[(size_t)(16 * w + 4 * fq + r) * 128 + j * 16 + fr] = sacc[j][r];
}
__device__ __forceinline__ void hgrn_sample_item(LAS unsigned char* lds, int b, int h, const bf16* Qb, const bf16* LFb, const bf16* Vb, const bf16* Gb, bf16* Ob, const float* onw, const float* S_in, float* S_out) {
    constexpr int FKQ = 0, VS = 16384, RED = 20480;
    const int tid = threadIdx.x, lane = tid & 63, w = __builtin_amdgcn_readfirstlane(tid >> 6), c4 = tid & 31, dg = tid >> 5;
    const size_t rowb = (size_t)MP + (size_t)b * 8;
    __syncthreads();
#pragma unroll
    for (int e = tid; e < 1024; e += 512) { const int t = e >> 7, d = e & 127; const size_t g = (rowb + t) * 1024 + h * 128 + d;
        const float f = __expf(h1(LFb[g])); LDSV(f32x4, FKQ + e * 16) = (f32x4){f, 1.0f - f, bf1(Qb[g]), 0.f}; LDSV(float, VS + e * 4) = bf1(Vb[g]); }
    const size_t sbase = ((size_t)(b * 8 + h) * 128 + 8 * dg) * 128 + 4 * c4;
    f32x4 s[8], po[8];
#pragma unroll
    for (int i = 0; i < 8; ++i) s[i] = *(const f32x4*)(S_in + sbase + (size_t)i * 128);
    __syncthreads();
#pragma unroll
    for (int t = 0; t < 8; ++t) { const f32x4 vv = LDSV(f32x4, VS + (t * 128 + 4 * c4) * 4); f32x4 p = (f32x4){0.f, 0.f, 0.f, 0.f};
#pragma unroll
        for (int i = 0; i < 8; ++i) { const f32x4 x = LDSV(f32x4, FKQ + (t * 128 + 8 * dg + i) * 16); s[i] = s[i] * x[0] + vv * x[1]; p += s[i] * x[2]; }
        po[t] = p; }
#pragma unroll
    for (int t = 0; t < 8; ++t) LDSV(f32x4, RED + ((dg * 8 + t) * 128 + 4 * c4) * 4) = po[t];
#pragma unroll
    for (int i = 0; i < 8; ++i) *(f32x4*)(S_out + sbase + (size_t)i * 128) = s[i];
    __syncthreads();
    { const int t = w; float o0 = 0.f, o1 = 0.f;
#pragma unroll
        for (int g = 0; g < 16; ++g) { const f32x2 x = LDSV(f32x2, RED + ((g * 8 + t) * 128 + 2 * lane) * 4); o0 += x.x; o1 += x.y; }
        const float rstd = rsqrtf(wave_sum(o0 * o0 + o1 * o1) * (1.0f / 128.0f) + 1e-6f);
        const size_t g = (rowb + t) * 1024 + h * 128 + 2 * lane; const unsigned gg = *(const unsigned*)(Gb + g);
        *(unsigned*)(Ob + g) = pk2(o0 * rstd * onw[h * 128 + 2 * lane] * bflo(gg), o1 * rstd * onw[h * 128 + 2 * lane + 1] * bfhi(gg)); }
}
namespace ml {
constexpr int Q = 0, K = Q + 64 * 144, KWT = K + 64 * 144, AM = KWT + 64 * 144, VTE = AM + 64 * 144, CTE = VTE + 144 * 144, AS = CTE + 144 * 144, MT = AS + 256, WI = MT + 256, EM = WI + 256, WS = EM + 256, DEN = WS + 256, SC = DEN + 256, NP = SC + 16, END = NP + 512;
static_assert(END <= RING_BYTES, "mlstm LDS");
}
__device__ __forceinline__ void mlstm_prompt_item(LAS unsigned char* lds, int b, int h, const bf16* Qm, const bf16* Km, const bf16* Vm, const bf16* Om, const float* GTg, bf16* Hb, const float* onw, float* C_out, float* n_out, float* m_out) {
    using namespace ml;
    const int tid = threadIdx.x, lane = tid & 63, w = __builtin_amdgcn_readfirstlane(tid >> 6), fr = lane & 15, fq = lane >> 4;
    const int tb = w & 3, wh = w >> 2;
    const size_t rowb = (size_t)b * 2048;
    const int dp = tid & 31, tg4 = tid >> 5;
    __syncthreads();
    for (int i = tid; i < 144 * 144 / 4; i += 512) { LDSV(unsigned, CTE + 4 * i) = 0u; const int row = (4 * i) / 144; LDSV(unsigned, VTE + 4 * i) = row == 128 ? 0x3f803f80u : 0u; }
    __syncthreads();
    f32x4 cacc[5];
#pragma unroll
    for (int j = 0; j < 5; ++j) cacc[j] = (f32x4){0.f, 0.f, 0.f, 0.f};
    f32x4 wn[4];
#pragma unroll
    for (int j = 0; j < 4; ++j) wn[j] = *(const f32x4*)(onw + h * 128 + (4 * wh + j) * 16 + 4 * fq);
    float m_prev = 0.f;
    unsigned rq[4], rk[4], rv[8]; float gli = 0.f, glf = 0.f;
#pragma unroll
    for (int i = 0; i < 4; ++i) { const size_t e = (rowb + 4 * tg4 + i) * 512 + h * 64 + 2 * dp; rq[i] = *(const unsigned*)(Qm + e); rk[i] = *(const unsigned*)(Km + e); }
#pragma unroll
    for (int i = 0; i < 8; ++i) rv[i] = *(const unsigned*)(Vm + (rowb + 8 * w + i) * 1024 + h * 128 + 2 * lane);
    if (w == 0) { gli = GTg[(rowb + lane) * 16 + h]; glf = GTg[(rowb + lane) * 16 + 8 + h]; }
    for (int c = 0; c < 32; ++c) {
        if (w == 0) {
            float bs = glf;
#pragma unroll
            for (int o = 1; o < 64; o <<= 1) { const float x = __shfl_up(bs, o); if (lane >= o) bs += x; }
            const float a = gli - bs; float pm = a;
#pragma unroll
            for (int o = 1; o < 64; o <<= 1) { const float x = __shfl_up(pm, o); if (lane >= o) pm = fmaxf(pm, x); }
            const float Mt = fmaxf(m_prev, pm), M63 = __shfl(Mt, 63), b63 = __shfl(bs, 63);
            LDSV(float, AS + 4 * lane) = a; LDSV(float, MT + 4 * lane) = Mt; LDSV(float, WI + 4 * lane) = __expf(m_prev - Mt); LDSV(float, EM + 4 * lane) = __expf(-(bs + Mt)); LDSV(float, WS + 4 * lane) = __expf(a - M63);
            if (lane == 0) { LDSV(float, SC) = __expf(m_prev - M63); LDSV(float, SC + 4) = b63 + M63; }
        }
#pragma unroll
        for (int i = 0; i < 4; ++i) { LDSV(unsigned, Q + (4 * tg4 + i) * 144 + 4 * dp) = rq[i]; LDSV(unsigned, K + (4 * tg4 + i) * 144 + 4 * dp) = rk[i]; }
        LDSV(v4u, VTE + (2 * lane) * 144 + 16 * w) = (v4u){(rv[0] & 0xffffu) | (rv[1] << 16), (rv[2] & 0xffffu) | (rv[3] << 16), (rv[4] & 0xffffu) | (rv[5] << 16), (rv[6] & 0xffffu) | (rv[7] << 16)};
        LDSV(v4u, VTE + (2 * lane + 1) * 144 + 16 * w) = (v4u){(rv[0] >> 16) | (rv[1] & 0xffff0000u), (rv[2] >> 16) | (rv[3] & 0xffff0000u), (rv[4] >> 16) | (rv[5] & 0xffff0000u), (rv[6] >> 16) | (rv[7] & 0xffff0000u)};
        __syncthreads();
        { const f32x4 ws = LDSV(f32x4, WS + 16 * tg4);
            LDSV(v2u, KWT + (2 * dp) * 144 + 8 * tg4) = (v2u){pk2(bflo(rk[0]) * ws[0], bflo(rk[1]) * ws[1]), pk2(bflo(rk[2]) * ws[2], bflo(rk[3]) * ws[3])};
            LDSV(v2u, KWT + (2 * dp + 1) * 144 + 8 * tg4) = (v2u){pk2(bfhi(rk[0]) * ws[0], bfhi(rk[1]) * ws[1]), pk2(bfhi(rk[2]) * ws[2], bfhi(rk[3]) * ws[3])}; }
        const float wc = LDSV(float, SC), m_next = LDSV(float, SC + 4);
        if (c + 1 < 32) { const size_t r1 = rowb + (size_t)(c + 1) * 64;
#pragma unroll
            for (int i = 0; i < 4; ++i) { const size_t e = (r1 + 4 * tg4 + i) * 512 + h * 64 + 2 * dp; rq[i] = *(const unsigned*)(Qm + e); rk[i] = *(const unsigned*)(Km + e); }
#pragma unroll
            for (int i = 0; i < 8; ++i) rv[i] = *(const unsigned*)(Vm + (r1 + 8 * w + i) * 1024 + h * 128 + 2 * lane);
            if (w == 0) { gli = GTg[(r1 + lane) * 16 + h]; glf = GTg[(r1 + lane) * 16 + 8 + h]; }
        }
        const size_t orow = (rowb + (size_t)c * 64 + tb * 16 + fr) * 1024 + h * 128 + 4 * fq;
        v2u rg[4];
#pragma unroll
        for (int j = 0; j < 4; ++j) rg[j] = *(const v2u*)(Om + orow + (4 * wh + j) * 16);
        __syncthreads();
        { const float Mt = LDSV(float, MT + (tb * 16 + fr) * 4);
#pragma unroll
            for (int j = 0; j < 2; ++j) { const int sb = 2 * wh + j; f32x4 a = (f32x4){0.f, 0.f, 0.f, 0.f};
                if (sb <= tb) {
#pragma unroll
                    for (int kk = 0; kk < 2; ++kk) a = MFMA16(LDSF(K + (sb * 16 + fr) * 144 + kk * 64 + fq * 16), LDSF(Q + (tb * 16 + fr) * 144 + kk * 64 + fq * 16), a);
                    const int t = tb * 16 + fr, s0 = sb * 16 + 4 * fq; const f32x4 as = LDSV(f32x4, AS + s0 * 4);
#pragma unroll
                    for (int r = 0; r < 4; ++r) a[r] = (s0 + r > t) ? 0.f : a[r] * __expf(as[r] - Mt);
                }
                LDSV(v2u, AM + (tb * 16 + fr) * 144 + (sb * 16 + 4 * fq) * 2) = (v2u){pk2(a[0], a[1]), pk2(a[2], a[3])}; } }
        __syncthreads();
        f32x4 num[5];
        { bf16x8 bA[2], bQ[2]; const float wi = LDSV(float, WI + (tb * 16 + fr) * 4);
#pragma unroll
            for (int kk = 0; kk < 2; ++kk) { bA[kk] = LDSF(AM + (tb * 16 + fr) * 144 + kk * 64 + fq * 16); bQ[kk] = LDSF(Q + (tb * 16 + fr) * 144 + kk * 64 + fq * 16); }
#pragma unroll
            for (int j = 0; j < 5; ++j) { if (j == 4 && wh != 0) break; const int dvb = j == 4 ? 8 : 4 * wh + j; f32x4 a1 = (f32x4){0.f, 0.f, 0.f, 0.f}, a2 = a1;
#pragma unroll
                for (int kk = 0; kk < 2; ++kk) { a1 = MFMA16(LDSF(VTE + (dvb * 16 + fr) * 144 + kk * 64 + fq * 16), bA[kk], a1); a2 = MFMA16(LDSF(CTE + (dvb * 16 + fr) * 144 + kk * 64 + fq * 16), bQ[kk], a2); }
                num[j] = a1 + a2 * wi; }
            if (wh == 0 && fq == 0) LDSV(float, DEN + (tb * 16 + fr) * 4) = num[4][0]; }
        { bf16x8 aK[2];
#pragma unroll
            for (int kk = 0; kk < 2; ++kk) aK[kk] = LDSF(KWT + (16 * tb + fr) * 144 + kk * 64 + fq * 16);
#pragma unroll
            for (int j = 0; j < 5; ++j) { if (j == 4 && wh != 0) break; const int dvb = j == 4 ? 8 : 4 * wh + j; f32x4 a = cacc[j] * wc;
#pragma unroll
                for (int kk = 0; kk < 2; ++kk) a = MFMA16(aK[kk], LDSF(VTE + (dvb * 16 + fr) * 144 + kk * 64 + fq * 16), a);
                cacc[j] = a; } }
        __syncthreads();
        { const float dn = fmaxf(fabsf(LDSV(float, DEN + (tb * 16 + fr) * 4)), LDSV(float, EM + (tb * 16 + fr) * 4)); const float inv = 1.0f / dn; float ss = 0.f;
#pragma unroll
            for (int j = 0; j < 4; ++j) { num[j] = num[j] * inv; ss += (num[j][0] * num[j][0] + num[j][1] * num[j][1]) + (num[j][2] * num[j][2] + num[j][3] * num[j][3]); }
            ss += __shfl_xor(ss, 16); ss += __shfl_xor(ss, 32);
            if (fq == 0) LDSV(float, NP + ((tb * 16 + fr) * 2 + wh) * 4) = ss; }
        __syncthreads();
        { const f32x2 p = LDSV(f32x2, NP + (tb * 16 + fr) * 8); const float rstd = rsqrtf((p.x + p.y) * (1.0f / 128.0f) + 1e-6f);
#pragma unroll
            for (int j = 0; j < 4; ++j) { const f32x4 o = num[j] * rstd * wn[j];
                *(v2u*)(Hb + orow + (4 * wh + j) * 16) = (v2u){pk2(o[0] * bflo(rg[j].x), o[1] * bfhi(rg[j].x)), pk2(o[2] * bflo(rg[j].y), o[3] * bfhi(rg[j].y))}; } }
#pragma unroll
        for (int j = 0; j < 5; ++j) { if (j == 4 && wh != 0) break; const int dvb = j == 4 ? 8 : 4 * wh + j;
            LDSV(v2u, CTE + (dvb * 16 + fr) * 144 + (16 * tb + 4 * fq) * 2) = (v2u){pk2(cacc[j][0], cacc[j][1]), pk2(cacc[j][2], cacc[j][3])}; }
        m_prev = m_next;
    }
    float* co = C_out + (size_t)(b * 8 + h) * 64 * 128;
#pragma unroll
    for (int j = 0; j < 4; ++j)
#pragma unroll
        for (int r = 0; r < 4; ++r) co[(size_t)(16 * tb + 4 * fq + r) * 128 + (4 * wh + j) * 16 + fr] = cacc[j][r];
    if (wh == 0 && fr == 0) {
#pragma unroll
        for (int r = 0; r < 4; ++r) n_out[(size_t)(b * 8 + h) * 64 + 16 * tb + 4 * fq + r] = cacc[4][r]; }
    if (tid == 0) m_out[b * 8 + h] = m_prev;
}
__device__ __forceinline__ void mlstm_sample_item(LAS unsigned char* lds, int b, int h, const bf16* Qm, const bf16* Km, const bf16* Vm, const bf16* Om, const float* GTg, bf16* Hb, const float* onw,
                                                  const float* C_in, const float* n_in, const float* m_in, float* C_out, float* n_out, float* m_out) {
    constexpr int KQ = 0, VS = 4096, SCL = 8192, DENR = 8320, RED = 20480;
    const int tid = threadIdx.x, lane = tid & 63, w = __builtin_amdgcn_readfirstlane(tid >> 6), c4 = tid & 31, dg = tid >> 5;
    const size_t rowb = (size_t)MP + (size_t)b * 8;
    __syncthreads();
    { const int t = tid >> 6, d = tid & 63; const size_t g = (rowb + t) * 512 + h * 64 + d; LDSV(f32x2, KQ + tid * 8) = (f32x2){bf1(Km[g]), bf1(Qm[g])}; }
#pragma unroll
    for (int e = tid; e < 1024; e += 512) { const int t = e >> 7, d = e & 127; LDSV(float, VS + e * 4) = bf1(Vm[(rowb + t) * 1024 + h * 128 + d]); }
    if (tid == 0) { float m = m_in[b * 8 + h];
        for (int t = 0; t < 8; ++t) { const float li = GTg[(rowb + t) * 16 + h], lf = GTg[(rowb + t) * 16 + 8 + h]; const float mn = fmaxf(lf + m, li);
            LDSV(f32x4, SCL + t * 16) = (f32x4){__expf(lf + m - mn), __expf(li - mn), __expf(-mn), 0.f}; m = mn; }
        m_out[b * 8 + h] = m; }
    const size_t cbase = ((size_t)(b * 8 + h) * 64 + 4 * dg) * 128 + 4 * c4;
    f32x4 cc[4], pn[8]; float nn[4], pd[8];
#pragma unroll
    for (int i = 0; i < 4; ++i) { cc[i] = *(const f32x4*)(C_in + cbase + (size_t)i * 128); nn[i] = n_in[(size_t)(b * 8 + h) * 64 + 4 * dg + i]; }
    __syncthreads();
#pragma unroll
    for (int t = 0; t < 8; ++t) { const f32x4 vv = LDSV(f32x4, VS + (t * 128 + 4 * c4) * 4); const f32x4 sc = LDSV(f32x4, SCL + t * 16); f32x4 p = (f32x4){0.f, 0.f, 0.f, 0.f}; float d = 0.f;
#pragma unroll
        for (int i = 0; i < 4; ++i) { const f32x2 kq = LDSV(f32x2, KQ + (t * 64 + 4 * dg + i) * 8); const float ik = sc[1] * kq.x;
            cc[i] = cc[i] * sc[0] + vv * ik; p += cc[i] * kq.y; nn[i] = nn[i] * sc[0] + ik; d += nn[i] * kq.y; }
        pn[t] = p; pd[t] = d; }
#pragma unroll
    for (int t = 0; t < 8; ++t) { LDSV(f32x4, RED + ((dg * 8 + t) * 128 + 4 * c4) * 4) = pn[t]; if (c4 == 0) LDSV(float, DENR + (dg * 8 + t) * 4) = pd[t]; }
#pragma unroll
    for (int i = 0; i < 4; ++i) { *(f32x4*)(C_out + cbase + (size_t)i * 128) = cc[i]; if (c4 == 0) n_out[(size_t)(b * 8 + h) * 64 + 4 * dg + i] = nn[i]; }
    __syncthreads();
    { const int t = w; float o0 = 0.f, o1 = 0.f, dn = 0.f;
#pragma unroll
        for (int g = 0; g < 16; ++g) { const f32x2 x = LDSV(f32x2, RED + ((g * 8 + t) * 128 + 2 * lane) * 4); o0 += x.x; o1 += x.y; dn += LDSV(float, DENR + (g * 8 + t) * 4); }
        const float inv = 1.0f / fmaxf(fabsf(dn), LDSV(f32x4, SCL + t * 16)[2]); o0 *= inv; o1 *= inv;
        const float rstd = rsqrtf(wave_sum(o0 * o0 + o1 * o1) * (1.0f / 128.0f) + 1e-6f);
        const size_t g = (rowb + t) * 1024 + h * 128 + 2 * lane; const unsigned gg = *(const unsigned*)(Om + g);
        *(unsigned*)(Hb + g) = pk2(o0 * rstd * onw[h * 128 + 2 * lane] * bflo(gg), o1 * rstd * onw[h * 128 + 2 * lane + 1] * bfhi(gg)); }
}
struct Args { const float* in[19]; float* out; unsigned char* ws; int ph_lo, ph_hi, li, pad; };
#ifndef PG8_SP2
#define PG8_SP2 true
#endif
#ifndef PG8_ALIGN
#define PG8_ALIGN true
#endif
__global__ void __launch_bounds__(NWAVES * 64, 2) trunk_fwd(Args args) {
    extern __shared__ __attribute__((aligned(16))) unsigned char lds_raw[];
    LAS unsigned char* lds = (LAS unsigned char*)lds_raw;
    volatile LAS unsigned* MISC = (volatile LAS unsigned*)(lds + MISC_OFF);
    const int tid = threadIdx.x, lane = tid & 63, wave = __builtin_amdgcn_readfirstlane(tid >> 6);
    const int G = gridDim.x, bx = blockIdx.x;
    unsigned char* ws = args.ws; float* out = args.out;
    gu32* ctl = (gu32*)(ws + WS_CTL);
    float* SS = (float*)(ws + WS_SS); float* LB = (float*)(ws + WS_LB);
    bf16* Win0 = (bf16*)(ws + WS_WIN0); bf16* Wout0 = (bf16*)(ws + WS_WOUT0); bf16* Wup0 = (bf16*)(ws + WS_WUP0); bf16* Wdn0 = (bf16*)(ws + WS_WDN0);
    bf16* Win1 = (bf16*)(ws + WS_WIN1); bf16* Wout1 = (bf16*)(ws + WS_WOUT1); bf16* Wup1 = (bf16*)(ws + WS_WUP1); bf16* Wdn1 = (bf16*)(ws + WS_WDN1);
    bf16* Xb = (bf16*)(ws + WS_XB); bf16* U = (bf16*)(ws + WS_ACT);
    bf16* Qb = (bf16*)(ws + WS_Q); bf16* LFb = (bf16*)(ws + WS_LF); bf16* Vb = (bf16*)(ws + WS_V); bf16* Gb = (bf16*)(ws + WS_G);
    bf16* Qm = (bf16*)(ws + WS_QM); bf16* Km = (bf16*)(ws + WS_KM); bf16* Vm = (bf16*)(ws + WS_VM); bf16* Om = (bf16*)(ws + WS_OM); float* GTg = (float*)(ws + WS_GT);
    float* X = out + OUT_Y;
    for (int u = tid; u < (LDS_BYTES - LDSCTL_OFF) / 4; u += NWAVES * 64) ((LAS unsigned*)(lds + LDSCTL_OFF))[u] = 0u;
    __syncthreads();
    XcdBarrier bar; bar.bar = (unsigned*)(ctl + CW_BAR); bar.x = 0; bar.st = nullptr;
    if (MK_N_LAUNCHES == 1) bar = xcd_barrier_post((unsigned*)(ctl + CW_BAR), MISC + 8);
    const int lo = args.ph_lo, hi = args.ph_hi;
#define IN(k) (lo <= (k) && (k) < hi)
#define SEAM(k) do { if (IN(k) && IN((k) + 1)) xcd_barrier(bar); } while (0)

    if (IN(0)) {
        LAS float* scr = (LAS float*)(lds + wave * 16384);
        const int gw = bx * NWAVES + wave, NGW = G * NWAVES;
        constexpr int I0 = 16 * 128, I1 = 16 * 32, I2 = 16 * 128, I3 = 64 * 32, I4 = 16 * 97, I5 = I1, I6 = I2, I7 = I3, NITEMS = I0 + I1 + I2 + I3 + I4 + I5 + I6 + I7;
        for (int it = gw; it < NITEMS; it += NGW) {
            int r = it;
            if (r < I0) { p0_transpose_item(args.in[8], 1024, 4096, args.in[6], Win0, scr, r, lane); continue; } r -= I0;
            if (r < I1) { p0_transpose_item(args.in[11], 1024, 1024, nullptr, Wout0, scr, r, lane); continue; } r -= I1;
            if (r < I2) { p0_transpose_item(args.in[16], 1024, 4096, args.in[7], Wup0, scr, r, lane); continue; } r -= I2;
            if (r < I3) { p0_transpose_item(args.in[17], 4096, 1024, nullptr, Wdn0, scr, r, lane); continue; } r -= I3;
            if (r < I4) { p0_transpose_item(args.in[12], 1024, NIN1, args.in[6] + 1024, Win1, scr, r, lane); continue; } r -= I4;
            if (r < I5) { p0_transpose_item(args.in[15], 1024, 1024, nullptr, Wout1, scr, r, lane); continue; } r -= I5;
            if (r < I6) { p0_transpose_item(args.in[16] + (size_t)1024 * 4096, 1024, 4096, args.in[7] + 1024, Wup1, scr, r, lane); continue; } r -= I6;
            p0_transpose_item(args.in[17] + (size_t)4096 * 1024, 4096, 1024, nullptr, Wdn1, scr, r, lane);
        }
        for (int m = gw; m < MROWS; m += NGW) {
            const float* xr = m < MP ? args.in[0] + (size_t)m * 1024 : args.in[1] + (size_t)(m - MP) * 1024;
            f32x4 v[4]; float s = 0.f;
#pragma unroll
            for (int j = 0; j < 4; ++j) { v[j] = *((const f32x4*)xr + lane + 64 * j); s += (v[j][0] * v[j][0] + v[j][1] * v[j][1]) + (v[j][2] * v[j][2] + v[j][3] * v[j][3]); }
            s = wave_sum(s); if (lane == 0) SS[m] = s;
#pragma unroll
            for (int j = 0; j < 4; ++j) *((v2u*)(Xb + (size_t)m * 1024) + lane + 64 * j) = (v2u){pk2(v[j][0], v[j][1]), pk2(v[j][2], v[j][3])};
        }
        if (bx == 0) for (int d = tid; d < 1024; d += NWAVES * 64) { const float l0 = args.in[9][d], l1 = args.in[9][1024 + d], l2 = args.in[9][2048 + d]; const float mx = fmaxf(l0, fmaxf(l1, l2));
            const float e0 = expf(l0 - mx), e1 = expf(l1 - mx), e2 = expf(l2 - mx); LB[d] = e0 / (e0 + e1 + e2); }
    }
    SEAM(0);
    if (IN(1)) { pg8::Gemm g{Xb, Win0, MROWS, 4096, 1024}; pg8::StaticOrder S; S.init(MROWS, 4096, G, bx);
        pg8::EpiHgrnIn E{Qb, LFb, Vb, Gb, SS, LB};
        pg8::gemm_phase<pg8::EpiHgrnIn, pg8::StaticOrder, PG8_ALIGN, PG8_SP2>(lds, g, S, E); }
    SEAM(1);
    if (IN(2)) {
        const int npb = G > 64 ? 64 : G;
        if (bx < npb) for (int it = bx; it < 64; it += npb) hgrn_prompt_item(lds, it >> 3, it & 7, Qb, LFb, Vb, Gb, Qb, args.in[10], out + OUT_SP);
        const int first = G > 64 ? 64 : 0, nsb = G - first;
        if (bx >= first) for (int it = bx - first; it < 1024; it += nsb) hgrn_sample_item(lds, it >> 3, it & 7, Qb, LFb, Vb, Gb, Qb, args.in[10], args.in[2], out + OUT_SS);
    }
    SEAM(2);
    if (IN(3)) { pg8::Gemm g{Qb, Wout0, MROWS, 1024, 1024}; pg8::StaticOrder S; S.init(MROWS, 1024, G, bx);
        pg8::EpiResid E{args.in[0], args.in[1], X, Xb, SS + MROWS};
        pg8::gemm_phase<pg8::EpiResid, pg8::StaticOrder, PG8_ALIGN, PG8_SP2>(lds, g, S, E); }
    SEAM(3);
    if (IN(4)) { pg8::Gemm g{Xb, Wup0, MROWS, 4096, 1024}; pg8::StaticOrder S; S.init(MROWS, 4096, G, bx);
        pg8::EpiUp E{U, SS + MROWS};
        pg8::gemm_phase<pg8::EpiUp, pg8::StaticOrder, PG8_ALIGN, PG8_SP2>(lds, g, S, E); }
    SEAM(4);
    if (IN(5)) { pg8::Gemm g{U, Wdn0, MROWS, 1024, 4096}; pg8::StaticOrder S; S.init(MROWS, 1024, G, bx);
        pg8::EpiResid E{X, X + (size_t)MP * 1024, X, Xb, SS + 2 * MROWS};
        pg8::gemm_phase<pg8::EpiResid, pg8::StaticOrder, PG8_ALIGN, PG8_SP2>(lds, g, S, E); }
    SEAM(5);
    if (IN(6)) { pg8::Gemm g{Xb, Win1, MROWS, NIN1P, 1024}; pg8::StaticOrder S; S.init(MROWS, NIN1P, G, bx);
        pg8::EpiMlstmIn E{Qm, Km, Vm, Om, GTg, SS + 2 * MROWS, args.in[13]};
        pg8::gemm_phase<pg8::EpiMlstmIn, pg8::StaticOrder, PG8_ALIGN, PG8_SP2>(lds, g, S, E); }
    SEAM(6);
    if (IN(7)) {
        const int npb = G > 64 ? 64 : G;
        if (bx < npb) for (int it = bx; it < 64; it += npb) mlstm_prompt_item(lds, it >> 3, it & 7, Qm, Km, Vm, Om, GTg, Vm, args.in[14], out + OUT_CP, out + OUT_NP, out + OUT_MP);
        const int first = G > 64 ? 64 : 0, nsb = G - first;
        if (bx >= first) for (int it = bx - first; it < 1024; it += nsb) mlstm_sample_item(lds, it >> 3, it & 7, Qm, Km, Vm, Om, GTg, Vm, args.in[14], args.in[3], args.in[4], args.in[5], out + OUT_CS, out + OUT_NS, out + OUT_MS);
    }
    SEAM(7);
    if (IN(8)) { pg8::Gemm g{Vm, Wout1, MROWS, 1024, 1024}; pg8::StaticOrder S; S.init(MROWS, 1024, G, bx);
        pg8::EpiResid E{X, X + (size_t)MP * 1024, X, Xb, SS + 3 * MROWS};
        pg8::gemm_phase<pg8::EpiResid, pg8::StaticOrder, PG8_ALIGN, PG8_SP2>(lds, g, S, E); }
    SEAM(8);
    if (IN(9)) { pg8::Gemm g{Xb, Wup1, MROWS, 4096, 1024}; pg8::StaticOrder S; S.init(MROWS, 4096, G, bx);
        pg8::EpiUp E{U, SS + 3 * MROWS};
        pg8::gemm_phase<pg8::EpiUp, pg8::StaticOrder, PG8_ALIGN, PG8_SP2>(lds, g, S, E); }
    SEAM(9);
    if (IN(10)) { pg8::Gemm g{U, Wdn1, MROWS, 1024, 4096}; pg8::StaticOrder S; S.init(MROWS, 1024, G, bx);
        pg8::EpiResid E{X, X + (size_t)MP * 1024, X, Xb, SS + 4 * MROWS};
        pg8::gemm_phase<pg8::EpiResid, pg8::StaticOrder, PG8_ALIGN, PG8_SP2>(lds, g, S, E); }
    SEAM(10);
    if (IN(11)) {
        const int gw = bx * NWAVES + wave, NGW = G * NWAVES; const float* wf = args.in[18];
        f32x4 wv[4];
#pragma unroll
        for (int j = 0; j < 4; ++j) wv[j] = *((const f32x4*)wf + lane + 64 * j);
        for (int m = gw; m < MROWS; m += NGW) { const float rs = rsqrtf(SS[4 * MROWS + m] * (1.0f / 1024.0f) + 1e-6f); f32x4* xr = (f32x4*)(X + (size_t)m * 1024);
#pragma unroll
            for (int j = 0; j < 4; ++j) xr[lane + 64 * j] = xr[lane + 64 * j] * rs * wv[j]; }
    }
#undef IN
#undef SEAM
}

extern "C" void kernel_launch(void* const* d_in, const int* in_sizes, int n_in, void* d_out, int out_size, void* d_ws, size_t ws_size, hipStream_t stream) {
    static int grid = 0;
    if (grid == 0) {
        if (n_in != 19 || out_size != (int)OUT_END || ws_size < WS_END) { fprintf(stderr, "kernel_launch: unexpected shapes: n_in %d out %d ws %zu\n", n_in, out_size, ws_size); grid = -1; return; }
        int dev = 0, cus = 0, per_cu = 0;
        if (hipGetDevice(&dev) != hipSuccess || hipDeviceGetAttribute(&cus, hipDeviceAttributeMultiprocessorCount, dev) != hipSuccess) { grid = -1; return; }
        if (hipFuncSetAttribute((const void*)trunk_fwd, hipFuncAttributeMaxDynamicSharedMemorySize, LDS_BYTES) != hipSuccess) { fprintf(stderr, "kernel_launch: hipFuncSetAttribute failed\n"); grid = -1; return; }
        if (hipOccupancyMaxActiveBlocksPerMultiprocessor(&per_cu, (const void*)trunk_fwd, NWAVES * 64, LDS_BYTES) != hipSuccess || per_cu < 1) { fprintf(stderr, "kernel_launch: occupancy query says %d blocks per CU\n", per_cu); grid = -1; return; }
        (void)hipGetLastError();
        grid = cus;
    }
    if (grid < 0) return;
    (void)hipMemsetAsync((char*)d_ws + WS_CTL, 0, CTL_ZERO_BYTES, stream);
    Args a{};
    for (int i = 0; i < 19; ++i) a.in[i] = (const float*)d_in[i];
    a.out = (float*)d_out; a.ws = (unsigned char*)d_ws;
#if MK_N_LAUNCHES == 1
    a.ph_lo = 0; a.ph_hi = N_PHASES; a.li = 0;
    hipLaunchKernelGGL(trunk_fwd, dim3(grid), dim3(NWAVES * 64), LDS_BYTES, stream, a);
#else
    for (int li = 0; li < N_PHASES; ++li) { a.ph_lo = li; a.ph_hi = li + 1; a.li = li; hipLaunchKernelGGL(trunk_fwd, dim3(grid), dim3(NWAVES * 64), LDS_BYTES, stream, a); }
#endif
}
```

```cpp
#include <hip/hip_runtime.h>
#include <cstdio>
#include <cstdint>
#include <cmath>
namespace pg8 {
#define PG8_LAS __attribute__((address_space(3)))
typedef unsigned short bf16_t;
typedef short bf16x8 __attribute__((ext_vector_type(8)));
typedef float f32x4 __attribute__((ext_vector_type(4)));
typedef unsigned u32x4 __attribute__((ext_vector_type(4)));
constexpr int BM = 256, BK = 64, HALF = 128, HTB = HALF * BK * 2  , STAGE_BYTES = 8 * HTB, NXCD = 8, WGM = 8;

__host__ __device__ __forceinline__ int lds_byte(int r, int c) { const int st = (r >> 4) * 2 + (c >> 5), rr = r & 15, cc = c & 31, ob = rr * 64 + cc * 2; return st * 1024 + (ob ^ (((ob >> 9) & 1) << 5)); }
__host__ __device__ __forceinline__ void stage_rc(int b, int& R, int& C) { const int st = b / 1024, sb = b % 1024, swz = sb ^ (((sb >> 9) & 1) << 5); R = (st >> 1) * 16 + swz / 64; C = (st & 1) * 32 + (swz % 64) / 2; }
__host__ __device__ __forceinline__ int perm32(int rho) { const int n = rho >> 4, i = rho & 15; return 8 * (i >> 2) + 4 * n + (i & 3); }

struct Unit { int pm, pn; };
struct Gemm { const bf16_t* A; const bf16_t* Bt; int M, N, K; };

struct StaticOrder {
    int nM, nN, nwg, G, c;
    __host__ __device__ void init(int M, int N, int G_, int c_) { nM = M / BM; nN = N / BM; nwg = nM * nN; G = G_; c = c_; }
    __host__ __device__ bool next(int i, Unit& u) const {
        const long L = (long)i * G + c; if (L >= nwg) return false;
        int wgid = (int)L; { const int q = nwg / NXCD, r = nwg % NXCD, xcd = wgid % NXCD, off = wgid / NXCD; wgid = (xcd < r ? xcd * (q + 1) : r * (q + 1) + (xcd - r) * q) + off; }
        const int nig = WGM * nN, gid = wgid / nig, fm = gid * WGM, gsz = (nM - fm) < WGM ? (nM - fm) : WGM;
        u.pm = fm + ((wgid % nig) % gsz); u.pn = (wgid % nig) / gsz; return true;
    }
    __device__ __forceinline__ void a_ready(const Unit&) const {}
    __device__ __forceinline__ void done(const Unit&) const {}
};

typedef unsigned u32x2 __attribute__((ext_vector_type(2)));
__device__ __forceinline__ unsigned f2bf_(float f) { unsigned u = __builtin_bit_cast(unsigned, f); return (u + 0x7fffu + ((u >> 16) & 1u)) >> 16; }
__device__ __forceinline__ unsigned pkbf(float lo, float hi) { return f2bf_(lo) | (f2bf_(hi) << 16); }
__device__ __forceinline__ unsigned pkh(float lo, float hi) { const _Float16 a = (_Float16)lo, b = (_Float16)hi; return (unsigned)__builtin_bit_cast(unsigned short, a) | ((unsigned)__builtin_bit_cast(unsigned short, b) << 16); }
__device__ __forceinline__ float sigm(float x) { return __builtin_amdgcn_rcpf(1.0f + __expf(-x)); }
constexpr float NORM_EPS = 1e-6f;

struct EpiHgrnIn {
    static constexpr bool PERM = true, AFTER_DRAIN = false;
    bf16_t* Q; bf16_t* LF; bf16_t* V; bf16_t* G; const float* ss; const float* lb;
    template <int GRP> __device__ __forceinline__ void run(const f32x4 (&acc)[2][2][4][2], const Unit& u, int wr, int wc, int fr, int fq) const {
        const int row0 = u.pm * BM + wr * 64 + fr, gc0 = (u.pn & 3) * BM + wc * 32 + 8 * fq;
        bf16_t* dst = GRP == 0 ? Q : GRP == 1 ? LF : GRP == 2 ? V : G;
        f32x4 lbv[2][2];
        if (GRP == 1) {
#pragma unroll
            for (int bj = 0; bj < 2; ++bj)
#pragma unroll
                for (int n = 0; n < 2; ++n) lbv[bj][n] = *(const f32x4*)(lb + gc0 + bj * HALF + 4 * n);
        }
#pragma unroll
        for (int ai = 0; ai < 2; ++ai)
#pragma unroll
            for (int m = 0; m < 4; ++m) { const int row = row0 + ai * HALF + m * 16; const float rs = rsqrtf(ss[row] * (1.0f / 1024.0f) + NORM_EPS);
                bf16_t* rowp = dst + (size_t)row * 1024 + gc0;
#pragma unroll
                for (int bj = 0; bj < 2; ++bj) { float x[8];
#pragma unroll
                    for (int n = 0; n < 2; ++n)
#pragma unroll
                        for (int j = 0; j < 4; ++j) x[4 * n + j] = acc[ai][bj][m][n][j] * rs;
                    u32x4 w;
                    if (GRP == 0 || GRP == 3) {
#pragma unroll
                        for (int j = 0; j < 8; ++j) x[j] = x[j] * sigm(x[j]);
                    }
                    if (GRP == 1) {
#pragma unroll
                        for (int j = 0; j < 8; ++j) { const float l = lbv[bj][j >> 2][j & 3]; x[j] = __logf(l + (1.0f - l) * sigm(x[j])); }
                        w.x = pkh(x[0], x[1]); w.y = pkh(x[2], x[3]); w.z = pkh(x[4], x[5]); w.w = pkh(x[6], x[7]);
                    } else { w.x = pkbf(x[0], x[1]); w.y = pkbf(x[2], x[3]); w.z = pkbf(x[4], x[5]); w.w = pkbf(x[6], x[7]); }
                    *(u32x4*)(rowp + bj * HALF) = w; } }
    }
    __device__ __forceinline__ void operator()(const f32x4 (&acc)[2][2][4][2], const Unit& u, int wr, int wc, int fr, int fq) const {
        const int grp = u.pn >> 2;
        if (grp == 0) run<0>(acc, u, wr, wc, fr, fq); else if (grp == 1) run<1>(acc, u, wr, wc, fr, fq); else if (grp == 2) run<2>(acc, u, wr, wc, fr, fq); else run<3>(acc, u, wr, wc, fr, fq);
    }
};

struct EpiMlstmIn {
    static constexpr bool PERM = true, AFTER_DRAIN = false;
    bf16_t* Qm; bf16_t* Km; bf16_t* Vm; bf16_t* Om; float* GT; const float* ss; const float* gb;
    template <int GRP> __device__ __forceinline__ void run(const f32x4 (&acc)[2][2][4][2], const Unit& u, int wr, int wc, int fr, int fq) const {
        const int row0 = u.pm * BM + wr * 64 + fr;
        const int ld = GRP < 2 ? 512 : 1024;
        const int tb = GRP == 0 ? 0 : GRP == 1 ? 2 : GRP == 2 ? 4 : 8;
        const int gc0 = (u.pn - tb) * BM + wc * 32 + 8 * fq;
        bf16_t* dst = GRP == 0 ? Qm : GRP == 1 ? Km : GRP == 2 ? Vm : Om;
#pragma unroll
        for (int ai = 0; ai < 2; ++ai)
#pragma unroll
            for (int m = 0; m < 4; ++m) { const int row = row0 + ai * HALF + m * 16; const float rs = rsqrtf(ss[row] * (1.0f / 1024.0f) + NORM_EPS);
                bf16_t* rowp = dst + (size_t)row * ld + gc0;
#pragma unroll
                for (int bj = 0; bj < 2; ++bj) { float x[8];
#pragma unroll
                    for (int n = 0; n < 2; ++n)
#pragma unroll
                        for (int j = 0; j < 4; ++j) x[4 * n + j] = acc[ai][bj][m][n][j] * rs;
                    if (GRP == 0) {
#pragma unroll
                        for (int j = 0; j < 8; ++j) x[j] *= 0.125f;
                    }
                    if (GRP == 3) {
#pragma unroll
                        for (int j = 0; j < 8; ++j) x[j] = sigm(x[j]);
                    }
                    u32x4 w; w.x = pkbf(x[0], x[1]); w.y = pkbf(x[2], x[3]); w.z = pkbf(x[4], x[5]); w.w = pkbf(x[6], x[7]);
                    *(u32x4*)(rowp + bj * HALF) = w; } }
    }
    __device__ __forceinline__ void gates(const f32x4 (&acc)[2][2][4][2], const Unit& u, int wr, int wc, int fr, int fq) const {
        if (wc != 0 || fq >= 2) return;
        const int row0 = u.pm * BM + wr * 64 + fr;
#pragma unroll
        for (int ai = 0; ai < 2; ++ai)
#pragma unroll
            for (int m = 0; m < 4; ++m) { const int row = row0 + ai * HALF + m * 16; const float rs = rsqrtf(ss[row] * (1.0f / 1024.0f) + NORM_EPS);
                float x[8];
#pragma unroll
                for (int n = 0; n < 2; ++n)
#pragma unroll
                    for (int j = 0; j < 4; ++j) x[4 * n + j] = acc[ai][0][m][n][j] * rs;
#pragma unroll
                for (int j = 0; j < 8; ++j) { const float z = 15.0f * tanhf((x[j] + gb[8 * fq + j]) * (1.0f / 15.0f)); x[j] = fq == 0 ? z : -log1pf(expf(-z)); }
                float* o = GT + (size_t)row * 16 + 8 * fq;
                *(f32x4*)o = (f32x4){x[0], x[1], x[2], x[3]}; *(f32x4*)(o + 4) = (f32x4){x[4], x[5], x[6], x[7]}; }
    }
    __device__ __forceinline__ void operator()(const f32x4 (&acc)[2][2][4][2], const Unit& u, int wr, int wc, int fr, int fq) const {
        const int pn = u.pn;
        if (pn < 2) run<0>(acc, u, wr, wc, fr, fq); else if (pn < 4) run<1>(acc, u, wr, wc, fr, fq); else if (pn < 8) run<2>(acc, u, wr, wc, fr, fq); else if (pn < 12) run<3>(acc, u, wr, wc, fr, fq); else gates(acc, u, wr, wc, fr, fq);
    }
};

struct EpiUp {
    static constexpr bool PERM = true, AFTER_DRAIN = false;
    bf16_t* U; const float* ss;
    __device__ __forceinline__ void operator()(const f32x4 (&acc)[2][2][4][2], const Unit& u, int wr, int wc, int fr, int fq) const {
        const int row0 = u.pm * BM + wr * 64 + fr, c0 = u.pn * BM + wc * 32 + 8 * fq;
#pragma unroll
        for (int ai = 0; ai < 2; ++ai)
#pragma unroll
            for (int m = 0; m < 4; ++m) { const int row = row0 + ai * HALF + m * 16; const float rs = rsqrtf(ss[row] * (1.0f / 1024.0f) + NORM_EPS);
                bf16_t* rowp = U + (size_t)row * 4096 + c0;
#pragma unroll
                for (int bj = 0; bj < 2; ++bj) { float x[8];
#pragma unroll
                    for (int n = 0; n < 2; ++n)
#pragma unroll
                        for (int j = 0; j < 4; ++j) { const float a = fmaxf(acc[ai][bj][m][n][j] * rs, 0.0f); x[4 * n + j] = a * a; }
                    u32x4 w; w.x = pkbf(x[0], x[1]); w.y = pkbf(x[2], x[3]); w.z = pkbf(x[4], x[5]); w.w = pkbf(x[6], x[7]);
                    *(u32x4*)(rowp + bj * HALF) = w; } }
    }
};

struct EpiResid {
    static constexpr bool PERM = false, AFTER_DRAIN = false;
    const float* base0; const float* base1; float* X; bf16_t* Xb; float* ssq;
    __device__ __forceinline__ void operator()(const f32x4 (&acc)[2][2][4][2], const Unit& u, int wr, int wc, int fr, int fq) const {
        const int row0 = u.pm * BM + wr * 64 + fr, c0 = u.pn * BM + wc * 32 + 4 * fq;
        const float* bs = u.pm < 64 ? base0 : base1 - (size_t)16384 * 1024;
#pragma unroll
        for (int ai = 0; ai < 2; ++ai)
#pragma unroll
            for (int m = 0; m < 4; ++m) { const int row = row0 + ai * HALF + m * 16; const size_t off = (size_t)row * 1024 + c0; float s = 0.f;
#pragma unroll
                for (int bj = 0; bj < 2; ++bj)
#pragma unroll
                    for (int n = 0; n < 2; ++n) { const f32x4 b = *(const f32x4*)(bs + off + bj * HALF + n * 16); const f32x4 v = b + acc[ai][bj][m][n];
                        *(f32x4*)(X + off + bj * HALF + n * 16) = v; u32x2 w; w.x = pkbf(v[0], v[1]); w.y = pkbf(v[2], v[3]); *(u32x2*)(Xb + off + bj * HALF + n * 16) = w;
                        s += (v[0] * v[0] + v[1] * v[1]) + (v[2] * v[2] + v[3] * v[3]); }
                s += __shfl_xor(s, 16); s += __shfl_xor(s, 32);
                if (fq == 0) atomicAdd(ssq + row, s); }
    }
};
template <class Epi, class Sched, bool ALIGN_EPI = false, bool SP2 = false>
__device__ __forceinline__ void gemm_phase(PG8_LAS unsigned char* lds, const Gemm g, const Sched& S, const Epi& E) {
    const int tid = threadIdx.x, wid = __builtin_amdgcn_readfirstlane(tid >> 6), lane = tid & 63, wr = wid >> 2, wc = wid & 3, fr = lane & 15, fq = lane >> 4;
    const int K = g.K, nt = K / BK;
    unsigned voffA[2], voffB[2];
#pragma unroll
    for (int i = 0; i < 2; ++i) { int R, C; stage_rc(tid * 16 + i * 8192, R, C); const int Rb = Epi::PERM ? ((R & ~31) + perm32(R & 31)) : R;
        voffA[i] = (unsigned)(R * K + C) * 2u; voffB[i] = (unsigned)(Rb * K + C) * 2u; }
    const size_t kstep = (size_t)(BK * 2);
    const size_t hstep = (size_t)HALF * K * 2;
    const size_t tstep = 2 * hstep;
    const unsigned ldsw = (unsigned)wid * 1024u;
    const int aoff = lds_byte(wr * 64 + fr, fq * 8), boff = lds_byte(wc * 32 + fr, fq * 8);
#define PG8_SA(b, h) (((b) * 2 + (h)) * HTB)
#define PG8_SB(b, h) ((4 + (b) * 2 + (h)) * HTB)
#define PG8_STAGE(bufoff, gbase, voff) do { _Pragma("unroll") for (int _i = 0; _i < 2; ++_i) \
        __builtin_amdgcn_global_load_lds((const unsigned*)((const char*)(gbase) + (voff)[_i]), (PG8_LAS unsigned*)(lds + (bufoff) + ldsw + _i * 8192), 16, 0, 0); } while (0)
#define PG8_LDA(dst, b, h) do { _Pragma("unroll") for (int m = 0; m < 4; ++m) _Pragma("unroll") for (int k = 0; k < 2; ++k) dst[m][k] = *(const PG8_LAS bf16x8*)(lds + PG8_SA(b, h) + aoff + m * 2048 + k * 1024); } while (0)
#define PG8_LDB(dst, b, h) do { _Pragma("unroll") for (int n = 0; n < 2; ++n) _Pragma("unroll") for (int k = 0; k < 2; ++k) dst[n][k] = *(const PG8_LAS bf16x8*)(lds + PG8_SB(b, h) + boff + n * 2048 + k * 1024); } while (0)
#define PG8_MMA(ai, bj, At, Bt) do { __builtin_amdgcn_s_setprio(1); _Pragma("unroll") for (int m = 0; m < 4; ++m) _Pragma("unroll") for (int n = 0; n < 2; ++n) _Pragma("unroll") for (int k = 0; k < 2; ++k) \
        acc[ai][bj][m][n] = __builtin_amdgcn_mfma_f32_16x16x32_bf16(Bt[n][k], At[m][k], acc[ai][bj][m][n], 0, 0, 0); __builtin_amdgcn_s_setprio(0); } while (0)
#define PG8_WAIT_V(n) asm volatile("s_waitcnt vmcnt(" #n ")" ::: "memory")
#define PG8_WAIT_L(n) asm volatile("s_waitcnt lgkmcnt(" #n ")" ::: "memory")
#define PG8_BAR __builtin_amdgcn_s_barrier()
#define PG8_SCHED __builtin_amdgcn_sched_barrier(0)
    Unit cur, nxt; int ui = 0;
    if (!S.next(0, cur)) return;
    f32x4 acc[2][2][4][2];
#pragma unroll
    for (int a = 0; a < 2; ++a)
#pragma unroll
        for (int b = 0; b < 2; ++b)
#pragma unroll
            for (int m = 0; m < 4; ++m)
#pragma unroll
                for (int n = 0; n < 2; ++n) acc[a][b][m][n] = (f32x4){0.f, 0.f, 0.f, 0.f};
    bf16x8 At[4][2], B0[2][2], B1[2][2];
    const char* cA = (const char*)g.A + (size_t)cur.pm * tstep; const char* cB = (const char*)g.Bt + (size_t)cur.pn * tstep;
    S.a_ready(cur);
    if constexpr (SP2) {
        PG8_STAGE(PG8_SB(0, 0), cB, voffB); PG8_STAGE(PG8_SB(0, 1), cB + hstep, voffB); PG8_STAGE(PG8_SA(0, 0), cA, voffA); PG8_STAGE(PG8_SA(0, 1), cA + hstep, voffA);
        if (wr == 1) PG8_BAR;
        PG8_WAIT_V(2); PG8_BAR;
        PG8_STAGE(PG8_SB(1, 0), cB + kstep, voffB); PG8_STAGE(PG8_SA(1, 0), cA + kstep, voffA); PG8_STAGE(PG8_SB(1, 1), cB + hstep + kstep, voffB);
        PG8_WAIT_V(6); PG8_BAR;
    } else {
        PG8_STAGE(PG8_SB(0, 0), cB, voffB); PG8_STAGE(PG8_SA(0, 0), cA, voffA); PG8_STAGE(PG8_SB(0, 1), cB + hstep, voffB); PG8_STAGE(PG8_SA(0, 1), cA + hstep, voffA);
        if (wr == 1) PG8_BAR;
        PG8_WAIT_V(4); PG8_BAR;
        PG8_STAGE(PG8_SB(1, 0), cB + kstep, voffB); PG8_STAGE(PG8_SA(1, 0), cA + kstep, voffA); PG8_STAGE(PG8_SB(1, 1), cB + hstep + kstep, voffB);
        PG8_WAIT_V(6); PG8_BAR;
    }
    for (;;) {
        const bool has_next = S.next(ui + 1, nxt);
        const char* nA = has_next ? (const char*)g.A + (size_t)nxt.pm * tstep : cA; const char* nB = has_next ? (const char*)g.Bt + (size_t)nxt.pn * tstep : cB;
        for (int t = 0; t < nt; t += 2) {
            const bool last = (t == nt - 2);
            const char* a1 = cA + (size_t)(t + 1) * kstep;
            const char* a2 = last ? nA : cA + (size_t)(t + 2) * kstep; const char* b2 = last ? nB : cB + (size_t)(t + 2) * kstep;
            const char* a3 = a2 + kstep; const char* b3 = b2 + kstep;
            if (last && has_next) S.a_ready(nxt);
            if constexpr (SP2) {
            PG8_LDB(B0, 0, 0); PG8_LDB(B1, 0, 1); PG8_SCHED; PG8_LDA(At, 0, 0); PG8_STAGE(PG8_SA(1, 1), a1 + hstep, voffA);
            PG8_WAIT_V(8); PG8_WAIT_L(0); PG8_BAR; PG8_MMA(0, 0, At, B0); PG8_MMA(0, 1, At, B1); PG8_BAR; PG8_SCHED;
            PG8_LDA(At, 0, 1); PG8_STAGE(PG8_SB(0, 0), b2, voffB); PG8_STAGE(PG8_SB(0, 1), b2 + hstep, voffB); PG8_STAGE(PG8_SA(0, 0), a2, voffA);
            PG8_WAIT_V(8); PG8_WAIT_L(0); PG8_BAR; PG8_MMA(1, 0, At, B0); PG8_MMA(1, 1, At, B1); PG8_BAR; PG8_SCHED;
            PG8_LDB(B0, 1, 0); PG8_LDB(B1, 1, 1); PG8_SCHED; PG8_LDA(At, 1, 0); PG8_STAGE(PG8_SA(0, 1), a2 + hstep, voffA);
            PG8_WAIT_V(8); PG8_WAIT_L(0); PG8_BAR; PG8_MMA(0, 0, At, B0); PG8_MMA(0, 1, At, B1); PG8_BAR; PG8_SCHED;
            PG8_LDA(At, 1, 1); PG8_STAGE(PG8_SB(1, 0), b3, voffB); PG8_STAGE(PG8_SB(1, 1), b3 + hstep, voffB); PG8_STAGE(PG8_SA(1, 0), a3, voffA);
            PG8_WAIT_V(8); PG8_WAIT_L(0); PG8_BAR; PG8_MMA(1, 0, At, B0); PG8_MMA(1, 1, At, B1); PG8_BAR; PG8_SCHED;
            } else {
            PG8_LDB(B0, 0, 0); PG8_SCHED; PG8_LDA(At, 0, 0); PG8_STAGE(PG8_SA(1, 1), a1 + hstep, voffA);
            PG8_WAIT_L(8); PG8_BAR; PG8_WAIT_L(0); PG8_MMA(0, 0, At, B0); PG8_BAR; PG8_SCHED;
            PG8_LDB(B1, 0, 1); PG8_STAGE(PG8_SB(0, 0), b2, voffB);
            PG8_BAR; PG8_WAIT_L(0); PG8_MMA(0, 1, At, B1); PG8_BAR;
            PG8_LDA(At, 0, 1); PG8_STAGE(PG8_SA(0, 0), a2, voffA);
            PG8_BAR; PG8_WAIT_L(0); PG8_MMA(1, 0, At, B0); PG8_BAR; PG8_SCHED;
            PG8_STAGE(PG8_SB(0, 1), b2 + hstep, voffB);
            PG8_WAIT_V(6); PG8_BAR; PG8_MMA(1, 1, At, B1); PG8_BAR;
            PG8_LDB(B0, 1, 0); PG8_SCHED; PG8_LDA(At, 1, 0); PG8_STAGE(PG8_SA(0, 1), a2 + hstep, voffA);
            PG8_WAIT_L(8); PG8_BAR; PG8_WAIT_L(0); PG8_MMA(0, 0, At, B0); PG8_BAR; PG8_SCHED;
            PG8_LDB(B1, 1, 1); PG8_STAGE(PG8_SB(1, 0), b3, voffB);
            PG8_BAR; PG8_WAIT_L(0); PG8_MMA(0, 1, At, B1); PG8_BAR;
            PG8_LDA(At, 1, 1); PG8_STAGE(PG8_SA(1, 0), a3, voffA);
            PG8_BAR; PG8_WAIT_L(0); PG8_MMA(1, 0, At, B0); PG8_BAR; PG8_SCHED;
            PG8_STAGE(PG8_SB(1, 1), b3 + hstep, voffB);
            PG8_WAIT_V(6); PG8_BAR; PG8_MMA(1, 1, At, B1); PG8_BAR;
            }
        }
        if constexpr (ALIGN_EPI) { if (wr == 0) PG8_BAR; }
        if constexpr (!Epi::AFTER_DRAIN) { E(acc, cur, wr, wc, fr, fq); S.done(cur); }
        if (!has_next) break;
#pragma unroll
        for (int a = 0; a < 2; ++a)
#pragma unroll
            for (int b = 0; b < 2; ++b)
#pragma unroll
                for (int m = 0; m < 4; ++m)
#pragma unroll
                    for (int n = 0; n < 2; ++n) acc[a][b][m][n] = (f32x4){0.f, 0.f, 0.f, 0.f};
        cur = nxt; cA = nA; cB = nB; ++ui;
        if constexpr (ALIGN_EPI) { if (wr == 1) PG8_BAR; }
    }
    PG8_WAIT_V(0);
    if constexpr (!ALIGN_EPI) { if (wr == 0) PG8_BAR; }
    PG8_BAR;
    if constexpr (Epi::AFTER_DRAIN) { E.fused(acc, cur, wr, wc, fr, fq, lds, wid, lane); S.done(cur); }
#undef PG8_SA
#undef PG8_SB
#undef PG8_STAGE
#undef PG8_LDA
#undef PG8_LDB
#undef PG8_MMA
#undef PG8_WAIT_V
#undef PG8_WAIT_L
#undef PG8_BAR
#undef PG8_SCHED
}
}
constexpr int NWAVES = 8;
#ifndef MK_N_LAUNCHES
#define MK_N_LAUNCHES 1
#endif
constexpr int N_PHASES = 12;
constexpr int MROWS = 17408, MP = 16384, DM = 1024, DFF = 4096, NIN1 = 3088, NIN1P = 3328;
constexpr size_t MiB = 1u << 20;
constexpr size_t WS_CTL = 0, CTL_ZERO_BYTES = 1 * MiB;
constexpr size_t WS_SS = 128 * 1024;
constexpr size_t WS_LB = 1 * MiB;
constexpr size_t WS_WIN0 = 2 * MiB, WS_WOUT0 = 10 * MiB, WS_WUP0 = 12 * MiB, WS_WDN0 = 20 * MiB, WS_WIN1 = 28 * MiB, WS_WOUT1 = 35 * MiB, WS_WUP1 = 37 * MiB, WS_WDN1 = 45 * MiB;
constexpr size_t WS_XB = 53 * MiB;
constexpr size_t WS_ACT = 87 * MiB;
constexpr size_t ACT_T = (size_t)MROWS * 1024 * 2;
constexpr size_t WS_Q = WS_ACT, WS_LF = WS_ACT + ACT_T, WS_V = WS_ACT + 2 * ACT_T, WS_G = WS_ACT + 3 * ACT_T;
constexpr size_t WS_QM = WS_ACT, WS_KM = WS_ACT + ACT_T / 2, WS_VM = WS_ACT + ACT_T, WS_OM = WS_ACT + 2 * ACT_T, WS_GT = WS_ACT + 3 * ACT_T;
constexpr size_t WS_END = WS_ACT + 4 * ACT_T;
static_assert(WS_END <= 224 * MiB, "d_ws map");
constexpr int CW_BAR = 4096;
constexpr size_t OUT_Y = 0, OUT_SP = 17825792, OUT_CP = 18874368, OUT_NP = 19398656, OUT_MP = 19402752, OUT_SS = 19402816, OUT_CS = 36180032, OUT_NS = 44568640, OUT_MS = 44634176, OUT_END = 44635200;
constexpr int RING_BYTES = 131072, LDSCTL_OFF = RING_BYTES, MISC_OFF = LDSCTL_OFF + 320, LDS_BYTES = 147456;

#define GAS __attribute__((address_space(1)))
#define LAS __attribute__((address_space(3)))
typedef unsigned short bf16;
typedef unsigned v4u __attribute__((ext_vector_type(4)));
typedef unsigned v2u __attribute__((ext_vector_type(2)));
typedef float f32x4 __attribute__((ext_vector_type(4)));
typedef float f32x2 __attribute__((ext_vector_type(2)));
typedef short bf16x8 __attribute__((ext_vector_type(8)));
typedef GAS unsigned gu32;
#define RLX_AGENT __ATOMIC_RELAXED, __HIP_MEMORY_SCOPE_AGENT
#define LDS_WAIT() asm volatile("s_waitcnt lgkmcnt(0)" ::: "memory")
#define VM_WAIT() asm volatile("s_waitcnt vmcnt(0)" ::: "memory")
__device__ __forceinline__ unsigned f2bf(float f) { unsigned u = __builtin_bit_cast(unsigned, f); return (u + 0x7fffu + ((u >> 16) & 1u)) >> 16; }
__device__ __forceinline__ unsigned pk2(float lo, float hi) { return f2bf(lo) | (f2bf(hi) << 16); }
__device__ __forceinline__ float bflo(unsigned w) { return __builtin_bit_cast(float, w << 16); }
__device__ __forceinline__ float bfhi(unsigned w) { return __builtin_bit_cast(float, w & 0xffff0000u); }
__device__ __forceinline__ float bf1(unsigned short h) { return __builtin_bit_cast(float, (unsigned)h << 16); }
__device__ __forceinline__ float hlo(unsigned w) { return (float)__builtin_bit_cast(_Float16, (unsigned short)(w & 0xffffu)); }
__device__ __forceinline__ float hhi(unsigned w) { return (float)__builtin_bit_cast(_Float16, (unsigned short)(w >> 16)); }
__device__ __forceinline__ float h1(unsigned short h) { return (float)__builtin_bit_cast(_Float16, h); }

#define XB_TMO      128
#define XB_XCNT(j)  (256  + 64 * (j))
#define XB_XSUB(j)  (1280 + 64 * (j))
#define XB_XGEN(j)  (2304 + 64 * (j))
#define XB_TOP      3328
#define XB_TOPGEN   3392
#define XCD_BAR_WORDS 3456
#define XB_SPIN_CAP (1u << 18)
__device__ __forceinline__ unsigned xb_ld(unsigned* p)              { return __hip_atomic_load(p, __ATOMIC_RELAXED, __HIP_MEMORY_SCOPE_AGENT); }
__device__ __forceinline__ unsigned xb_add(unsigned* p, unsigned v) { return __hip_atomic_fetch_add(p, v, __ATOMIC_RELAXED, __HIP_MEMORY_SCOPE_AGENT); }
__device__ __forceinline__ unsigned xb_xcc_id() { return (unsigned)__builtin_amdgcn_s_getreg((3 << 11) | 20) & 0xFu; }
#define XB_SPIN(cond, bar) do { unsigned _sp = 0; while (cond) { __builtin_amdgcn_s_sleep(1); \
    if ((++_sp & 255u) == 0u) { if (xb_ld(&(bar)[XB_TMO])) break; if (_sp > XB_SPIN_CAP) { atomicAdd(&(bar)[XB_TMO], 1u); break; } } } } while (0)
struct XcdBarrier { unsigned* bar; unsigned x; volatile LAS unsigned* st; };
__device__ __forceinline__ XcdBarrier xcd_barrier_post(unsigned* bar, volatile LAS unsigned* st) {
    XcdBarrier b; b.bar = bar; b.x = xb_xcc_id(); b.st = st;
    if (threadIdx.x == 0) (void)xb_add(&bar[XB_XCNT(b.x)], 1u);
    return b;
}
__device__ __forceinline__ void xcd_barrier_complete(unsigned* bar, unsigned x, unsigned& nloc, unsigned& nx) {
    const unsigned G = gridDim.x * gridDim.y * gridDim.z;
    unsigned sum, cnt, mine, sp = 0u;
    for (;;) {
        sum = 0u; cnt = 0u; mine = 0u;
#pragma unroll
        for (unsigned j = 0; j < 16; ++j) { const unsigned c = xb_ld(&bar[XB_XCNT(j)]); sum += c; cnt += (c > 0u) ? 1u : 0u; mine = (j == x) ? c : mine; }
        if (sum == G) break;
        __builtin_amdgcn_s_sleep(1);
        if ((++sp & 255u) == 0u) { if (xb_ld(&bar[XB_TMO])) break; if (sp > XB_SPIN_CAP) { atomicAdd(&bar[XB_TMO], 1u); break; } }
    }
    nloc = mine > 0u ? mine : 1u; nx = cnt > 0u ? cnt : 1u;
}
__device__ __forceinline__ void xcd_barrier(const XcdBarrier& b) {
    asm volatile("s_waitcnt vmcnt(0)" ::: "memory");
    __syncthreads();
    if (threadIdx.x == 0) {
        unsigned* bar = b.bar;
        __builtin_amdgcn_s_waitcnt(0);
        unsigned nloc = b.st[0], nx = b.st[1];
        if (nloc == 0u) { xcd_barrier_complete(bar, b.x, nloc, nx); b.st[0] = nloc; b.st[1] = nx; }
        const unsigned old = xb_add(&bar[XB_XSUB(b.x)], 1u);
        const unsigned gen = old / nloc;
        if (old + 1u == (gen + 1u) * nloc) {
            __builtin_amdgcn_fence(__ATOMIC_RELEASE, "agent");
            asm volatile("s_waitcnt vmcnt(0)" ::: "memory");
            const unsigned og = xb_add(&bar[XB_TOP], 1u);
            const unsigned tg = og / nx;
            if (og + 1u == (tg + 1u) * nx) xb_add(&bar[XB_TOPGEN], 1u);
            else XB_SPIN(xb_ld(&bar[XB_TOPGEN]) == tg, bar);
            __builtin_amdgcn_fence(__ATOMIC_ACQUIRE, "agent");
            xb_add(&bar[XB_XGEN(b.x)], 1u);
            asm volatile("s_waitcnt vmcnt(0)" ::: "memory");
        } else {
            XB_SPIN(xb_ld(&bar[XB_XGEN(b.x)]) == gen, bar);
            __builtin_amdgcn_fence(__ATOMIC_ACQUIRE, "agent");
            asm volatile("s_waitcnt vmcnt(0)" ::: "memory");
        }
    }
    __syncthreads();
}

__device__ __forceinline__ float wave_sum(float v) {
#pragma unroll
    for (int o = 1; o < 64; o <<= 1) v += __shfl_xor(v, o);
    return v;
}
__device__ __forceinline__ void p0_transpose_item(const float* W, int K, int N, const float* sc, bf16* WT, LAS float* scr, int item, int lane) {
    const int nblk = (N + 31) / 32, kb = item / nblk, nb = item % nblk, k0 = 64 * kb, n0 = 32 * nb;
    const bool nok = (n0 + (lane & 31)) < N;
#pragma unroll 8
    for (int i = 0; i < 32; ++i) { const int kk = 2 * i + (lane >> 5); float v = nok ? W[(size_t)(k0 + kk) * N + n0 + (lane & 31)] : 0.f; if (sc) v *= sc[k0 + kk]; scr[kk * 33 + (lane & 31)] = v; }
    LDS_WAIT(); asm volatile("" ::: "memory");
    const int c = lane & 7;
#pragma unroll
    for (int j = 0; j < 4; ++j) { const int n = (lane >> 3) + 8 * j; const LAS float* s = scr + (8 * c) * 33 + n;
        v4u o; o.x = pk2(s[0 * 33], s[1 * 33]); o.y = pk2(s[2 * 33], s[3 * 33]); o.z = pk2(s[4 * 33], s[5 * 33]); o.w = pk2(s[6 * 33], s[7 * 33]);
        *(GAS v4u*)(WT + (size_t)(n0 + n) * K + k0 + 8 * c) = o; }
    LDS_WAIT(); asm volatile("" ::: "memory");
}
#define MFMA16(a, b, c) __builtin_amdgcn_mfma_f32_16x16x32_bf16((a), (b), (c), 0, 0, 0)
#define LDSV(T, off) (*(LAS T*)(lds + (off)))
#define LDSF(off) (*(const LAS bf16x8*)(lds + (off)))
namespace hg {
constexpr int QP = 0, KP = QP + 64 * 272, KPPT = KP + 64 * 272, VT = KPPT + 128 * 144, AM = VT + 128 * 144, ST = AM + 64 * 144, GT = ST + 128 * 272, DEC = GT + 8 * 128 * 4, NP = DEC + 512, END = NP + 512;
static_assert(END <= RING_BYTES, "hgrn LDS");
}
__device__ __forceinline__ void hgrn_prompt_item(LAS unsigned char* lds, int b, int h, const bf16* Qb, const bf16* LFb, const bf16* Vb, const bf16* Gb, bf16* Ob, const float* onw, float* S_out) {
    using namespace hg;
    const int tid = threadIdx.x, lane = tid & 63, w = __builtin_amdgcn_readfirstlane(tid >> 6), fr = lane & 15, fq = lane >> 4;
    const int tb = w & 3, wh = w >> 2;
    const size_t rowb = (size_t)b * 2048;
    const int colp = h * 128 + 2 * lane;
    __syncthreads();
    for (int i = tid; i < 128 * 272 / 4; i += 512) LDSV(unsigned, ST + 4 * i) = 0u;
    __syncthreads();
    f32x4 sacc[8];
#pragma unroll
    for (int j = 0; j < 8; ++j) sacc[j] = (f32x4){0.f, 0.f, 0.f, 0.f};
    f32x4 wn[4];
#pragma unroll
    for (int j = 0; j < 4; ++j) wn[j] = *(const f32x4*)(onw + h * 128 + (4 * wh + j) * 16 + 4 * fq);
    unsigned rq[8], rl[8], rv[8];
#pragma unroll
    for (int i = 0; i < 8; ++i) { const size_t e = (rowb + 8 * w + i) * 1024 + colp; rq[i] = *(const unsigned*)(Qb + e); rl[i] = *(const unsigned*)(LFb + e); rv[i] = *(const unsigned*)(Vb + e); }
    for (int c = 0; c < 32; ++c) {
        float c0[8], c1[8]; { float a0 = 0.f, a1 = 0.f;
#pragma unroll
            for (int i = 0; i < 8; ++i) { a0 += hlo(rl[i]); a1 += hhi(rl[i]); c0[i] = a0; c1[i] = a1; }
            LDSV(f32x2, GT + (w * 128 + 2 * lane) * 4) = (f32x2){a0, a1}; }
        __syncthreads();
        float pre0 = 0.f, pre1 = 0.f, tot0 = 0.f, tot1 = 0.f;
#pragma unroll
        for (int g = 0; g < 8; ++g) { const f32x2 x = LDSV(f32x2, GT + (g * 128 + 2 * lane) * 4); tot0 += x.x; tot1 += x.y; if (g < w) { pre0 += x.x; pre1 += x.y; } }
        if (w == 0) LDSV(f32x2, DEC + 2 * lane * 4) = (f32x2){__expf(tot0), __expf(tot1)};
        { unsigned kk0[4], kk1[4], vv0[4], vv1[4]; float pk0 = 0.f, pk1 = 0.f;
#pragma unroll
            for (int i = 0; i < 8; ++i) {
                const float b0 = pre0 + c0[i], b1 = pre1 + c1[i];
                const float k0 = 1.0f - __expf(hlo(rl[i])), k1 = 1.0f - __expf(hhi(rl[i]));
                const float e0 = __expf(b0), e1 = __expf(b1), n0 = __expf(-b0), n1 = __expf(-b1), l0 = __expf(tot0 - b0), l1 = __expf(tot1 - b1);
                LDSV(unsigned, QP + (8 * w + i) * 272 + 4 * lane) = pk2(bflo(rq[i]) * e0, bfhi(rq[i]) * e1);
                LDSV(unsigned, KP + (8 * w + i) * 272 + 4 * lane) = pk2(k0 * n0, k1 * n1);
                const float x0 = k0 * l0, x1 = k1 * l1;
                if (i & 1) { kk0[i >> 1] = pk2(pk0, x0); kk1[i >> 1] = pk2(pk1, x1); vv0[i >> 1] = (rv[i - 1] & 0xffffu) | (rv[i] << 16); vv1[i >> 1] = (rv[i - 1] >> 16) | (rv[i] & 0xffff0000u); }
                else { pk0 = x0; pk1 = x1; }
            }
            LDSV(v4u, KPPT + (2 * lane) * 144 + 16 * w) = (v4u){kk0[0], kk0[1], kk0[2], kk0[3]};
            LDSV(v4u, KPPT + (2 * lane + 1) * 144 + 16 * w) = (v4u){kk1[0], kk1[1], kk1[2], kk1[3]};
            LDSV(v4u, VT + (2 * lane) * 144 + 16 * w) = (v4u){vv0[0], vv0[1], vv0[2], vv0[3]};
            LDSV(v4u, VT + (2 * lane + 1) * 144 + 16 * w) = (v4u){vv1[0], vv1[1], vv1[2], vv1[3]}; }
        if (c + 1 < 32) {
#pragma unroll
            for (int i = 0; i < 8; ++i) { const size_t e = (rowb + (size_t)(c + 1) * 64 + 8 * w + i) * 1024 + colp; rq[i] = *(const unsigned*)(Qb + e); rl[i] = *(const unsigned*)(LFb + e); rv[i] = *(const unsigned*)(Vb + e); }
        }
        const size_t orow = (rowb + (size_t)c * 64 + tb * 16 + fr) * 1024 + h * 128 + 4 * fq;
        v2u rg[4];
#pragma unroll
        for (int j = 0; j < 4; ++j) rg[j] = *(const v2u*)(Gb + orow + (4 * wh + j) * 16);
        __syncthreads();
#pragma unroll
        for (int j = 0; j < 2; ++j) { const int sb = 2 * wh + j; f32x4 a = (f32x4){0.f, 0.f, 0.f, 0.f};
            if (sb <= tb) {
#pragma unroll
                for (int kk = 0; kk < 4; ++kk) a = MFMA16(LDSF(KP + (sb * 16 + fr) * 272 + kk * 64 + fq * 16), LDSF(QP + (tb * 16 + fr) * 272 + kk * 64 + fq * 16), a);
                const int t = tb * 16 + fr, s0 = sb * 16 + 4 * fq;
#pragma unroll
                for (int r = 0; r < 4; ++r) if (s0 + r > t) a[r] = 0.f;
            }
            LDSV(v2u, AM + (tb * 16 + fr) * 144 + (sb * 16 + 4 * fq) * 2) = (v2u){pk2(a[0], a[1]), pk2(a[2], a[3])}; }
        __syncthreads();
        f32x4 oacc[4];
        { bf16x8 bA[2], bQ[4];
#pragma unroll
            for (int kk = 0; kk < 2; ++kk) bA[kk] = LDSF(AM + (tb * 16 + fr) * 144 + kk * 64 + fq * 16);
#pragma unroll
            for (int kk = 0; kk < 4; ++kk) bQ[kk] = LDSF(QP + (tb * 16 + fr) * 272 + kk * 64 + fq * 16);
#pragma unroll
            for (int j = 0; j < 4; ++j) { const int dvb = 4 * wh + j; f32x4 a = (f32x4){0.f, 0.f, 0.f, 0.f};
#pragma unroll
                for (int kk = 0; kk < 2; ++kk) a = MFMA16(LDSF(VT + (dvb * 16 + fr) * 144 + kk * 64 + fq * 16), bA[kk], a);
#pragma unroll
                for (int kk = 0; kk < 4; ++kk) a = MFMA16(LDSF(ST + (dvb * 16 + fr) * 272 + kk * 64 + fq * 16), bQ[kk], a);
                oacc[j] = a; } }
        { float ss = 0.f;
#pragma unroll
            for (int j = 0; j < 4; ++j) ss += (oacc[j][0] * oacc[j][0] + oacc[j][1] * oacc[j][1]) + (oacc[j][2] * oacc[j][2] + oacc[j][3] * oacc[j][3]);
            ss += __shfl_xor(ss, 16); ss += __shfl_xor(ss, 32);
            if (fq == 0) LDSV(float, NP + ((tb * 16 + fr) * 2 + wh) * 4) = ss; }
        { const f32x4 dec = LDSV(f32x4, DEC + (16 * w + 4 * fq) * 4); bf16x8 aK[2];
#pragma unroll
            for (int kk = 0; kk < 2; ++kk) aK[kk] = LDSF(KPPT + (16 * w + fr) * 144 + kk * 64 + fq * 16);
#pragma unroll
            for (int j = 0; j < 8; ++j) { f32x4 a = sacc[j] * dec;
#pragma unroll
                for (int kk = 0; kk < 2; ++kk) a = MFMA16(aK[kk], LDSF(VT + (j * 16 + fr) * 144 + kk * 64 + fq * 16), a);
                sacc[j] = a; } }
        __syncthreads();
        { const f32x2 p = LDSV(f32x2, NP + (tb * 16 + fr) * 8); const float rstd = rsqrtf((p.x + p.y) * (1.0f / 128.0f) + 1e-6f);
#pragma unroll
            for (int j = 0; j < 4; ++j) { const f32x4 o = oacc[j] * rstd * wn[j];
                *(v2u*)(Ob + orow + (4 * wh + j) * 16) = (v2u){pk2(o[0] * bflo(rg[j].x), o[1] * bfhi(rg[j].x)), pk2(o[2] * bflo(rg[j].y), o[3] * bfhi(rg[j].y))}; } }
#pragma unroll
        for (int j = 0; j < 8; ++j) LDSV(v2u, ST + (j * 16 + fr) * 272 + (16 * w + 4 * fq) * 2) = (v2u){pk2(sacc[j][0], sacc[j][1]), pk2(sacc[j][2], sacc[j][3])};
    }
    float* so = S_out + (size_t)(b * 8 + h) * 128 * 128;
#pragma unroll
    for (int j = 0; j < 8; ++j)
#pragma unroll
        for (int r = 0; r < 4; ++r) so[(size_t)(16 * w + 4 * fq + r) * 128 + j * 16 + fr] = sacc[j][r];
}
__device__ __forceinline__ void hgrn_sample_item(LAS unsigned char* lds, int b, int h, const bf16* Qb, const bf16* LFb, const bf16* Vb, const bf16* Gb, bf16* Ob, const float* onw, const float* S_in, float* S_out) {
    constexpr int FKQ = 0, VS = 16384, RED = 20480;
    const int tid = threadIdx.x, lane = tid & 63, w = __builtin_amdgcn_readfirstlane(tid >> 6), c4 = tid & 31, dg = tid >> 5;
    const size_t rowb = (size_t)MP + (size_t)b * 8;
    __syncthreads();
#pragma unroll
    for (int e = tid; e < 1024; e += 512) { const int t = e >> 7, d = e & 127; const size_t g = (rowb + t) * 1024 + h * 128 + d;
        const float f = __expf(h1(LFb[g])); LDSV(f32x4, FKQ + e * 16) = (f32x4){f, 1.0f - f, bf1(Qb[g]), 0.f}; LDSV(float, VS + e * 4) = bf1(Vb[g]); }
    const size_t sbase = ((size_t)(b * 8 + h) * 128 + 8 * dg) * 128 + 4 * c4;
    f32x4 s[8], po[8];
#pragma unroll
    for (int i = 0; i < 8; ++i) s[i] = *(const f32x4*)(S_in + sbase + (size_t)i * 128);
    __syncthreads();
#pragma unroll
    for (int t = 0; t < 8; ++t) { const f32x4 vv = LDSV(f32x4, VS + (t * 128 + 4 * c4) * 4); f32x4 p = (f32x4){0.f, 0.f, 0.f, 0.f};
#pragma unroll
        for (int i = 0; i < 8; ++i) { const f32x4 x = LDSV(f32x4, FKQ + (t * 128 + 8 * dg + i) * 16); s[i] = s[i] * x[0] + vv * x[1]; p += s[i] * x[2]; }
        po[t] = p; }
#pragma unroll
    for (int t = 0; t < 8; ++t) LDSV(f32x4, RED + ((dg * 8 + t) * 128 + 4 * c4) * 4) = po[t];
#pragma unroll
    for (int i = 0; i < 8; ++i) *(f32x4*)(S_out + sbase + (size_t)i * 128) = s[i];
    __syncthreads();
    { const int t = w; float o0 = 0.f, o1 = 0.f;
#pragma unroll
        for (int g = 0; g < 16; ++g) { const f32x2 x = LDSV(f32x2, RED + ((g * 8 + t) * 128 + 2 * lane) * 4); o0 += x.x; o1 += x.y; }
        const float rstd = rsqrtf(wave_sum(o0 * o0 + o1 * o1) * (1.0f / 128.0f) + 1e-6f);
        const size_t g = (rowb + t) * 1024 + h * 128 + 2 * lane; const unsigned gg = *(const unsigned*)(Gb + g);
        *(unsigned*)(Ob + g) = pk2(o0 * rstd * onw[h * 128 + 2 * lane] * bflo(gg), o1 * rstd * onw[h * 128 + 2 * lane + 1] * bfhi(gg)); }
}
namespace ml {
constexpr int Q = 0, K = Q + 64 * 144, KWT = K + 64 * 144, AM = KWT + 64 * 144, VTE = AM + 64 * 144, CTE = VTE + 144 * 144, AS = CTE + 144 * 144, MT = AS + 256, WI = MT + 256, EM = WI + 256, WS = EM + 256, DEN = WS + 256, SC = DEN + 256, NP = SC + 16, END = NP + 512;
static_assert(END <= RING_BYTES, "mlstm LDS");
}
__device__ __forceinline__ void mlstm_prompt_item(LAS unsigned char* lds, int b, int h, const bf16* Qm, const bf16* Km, const bf16* Vm, const bf16* Om, const float* GTg, bf16* Hb, const float* onw, float* C_out, float* n_out, float* m_out) {
    using namespace ml;
    const int tid = threadIdx.x, lane = tid & 63, w = __builtin_amdgcn_readfirstlane(tid >> 6), fr = lane & 15, fq = lane >> 4;
    const int tb = w & 3, wh = w >> 2;
    const size_t rowb = (size_t)b * 2048;
    const int dp = tid & 31, tg4 = tid >> 5;
    __syncthreads();
    for (int i = tid; i < 144 * 144 / 4; i += 512) { LDSV(unsigned, CTE + 4 * i) = 0u; const int row = (4 * i) / 144; LDSV(unsigned, VTE + 4 * i) = row == 128 ? 0x3f803f80u : 0u; }
    __syncthreads();
    f32x4 cacc[5];
#pragma unroll
    for (int j = 0; j < 5; ++j) cacc[j] = (f32x4){0.f, 0.f, 0.f, 0.f};
    f32x4 wn[4];
#pragma unroll
    for (int j = 0; j < 4; ++j) wn[j] = *(const f32x4*)(onw + h * 128 + (4 * wh + j) * 16 + 4 * fq);
    float m_prev = 0.f;
    unsigned rq[4], rk[4], rv[8]; float gli = 0.f, glf = 0.f;
#pragma unroll
    for (int i = 0; i < 4; ++i) { const size_t e = (rowb + 4 * tg4 + i) * 512 + h * 64 + 2 * dp; rq[i] = *(const unsigned*)(Qm + e); rk[i] = *(const unsigned*)(Km + e); }
#pragma unroll
    for (int i = 0; i < 8; ++i) rv[i] = *(const unsigned*)(Vm + (rowb + 8 * w + i) * 1024 + h * 128 + 2 * lane);
    if (w == 0) { gli = GTg[(rowb + lane) * 16 + h]; glf = GTg[(rowb + lane) * 16 + 8 + h]; }
    for (int c = 0; c < 32; ++c) {
        if (w == 0) {
            float bs = glf;
#pragma unroll
            for (int o = 1; o < 64; o <<= 1) { const float x = __shfl_up(bs, o); if (lane >= o) bs += x; }
            const float a = gli - bs; float pm = a;
#pragma unroll
            for (int o = 1; o < 64; o <<= 1) { const float x = __shfl_up(pm, o); if (lane >= o) pm = fmaxf(pm, x); }
            const float Mt = fmaxf(m_prev, pm), M63 = __shfl(Mt, 63), b63 = __shfl(bs, 63);
            LDSV(float, AS + 4 * lane) = a; LDSV(float, MT + 4 * lane) = Mt; LDSV(float, WI + 4 * lane) = __expf(m_prev - Mt); LDSV(float, EM + 4 * lane) = __expf(-(bs + Mt)); LDSV(float, WS + 4 * lane) = __expf(a - M63);
            if (lane == 0) { LDSV(float, SC) = __expf(m_prev - M63); LDSV(float, SC + 4) = b63 + M63; }
        }
#pragma unroll
        for (int i = 0; i < 4; ++i) { LDSV(unsigned, Q + (4 * tg4 + i) * 144 + 4 * dp) = rq[i]; LDSV(unsigned, K + (4 * tg4 + i) * 144 + 4 * dp) = rk[i]; }
        LDSV(v4u, VTE + (2 * lane) * 144 + 16 * w) = (v4u){(rv[0] & 0xffffu) | (rv[1] << 16), (rv[2] & 0xffffu) | (rv[3] << 16), (rv[4] & 0xffffu) | (rv[5] << 16), (rv[6] & 0xffffu) | (rv[7] << 16)};
        LDSV(v4u, VTE + (2 * lane + 1) * 144 + 16 * w) = (v4u){(rv[0] >> 16) | (rv[1] & 0xffff0000u), (rv[2] >> 16) | (rv[3] & 0xffff0000u), (rv[4] >> 16) | (rv[5] & 0xffff0000u), (rv[6] >> 16) | (rv[7] & 0xffff0000u)};
        __syncthreads();
        { const f32x4 ws = LDSV(f32x4, WS + 16 * tg4);
            LDSV(v2u, KWT + (2 * dp) * 144 + 8 * tg4) = (v2u){pk2(bflo(rk[0]) * ws[0], bflo(rk[1]) * ws[1]), pk2(bflo(rk[2]) * ws[2], bflo(rk[3]) * ws[3])};
            LDSV(v2u, KWT + (2 * dp + 1) * 144 + 8 * tg4) = (v2u){pk2(bfhi(rk[0]) * ws[0], bfhi(rk[1]) * ws[1]), pk2(bfhi(rk[2]) * ws[2], bfhi(rk[3]) * ws[3])}; }
        const float wc = LDSV(float, SC), m_next = LDSV(float, SC + 4);
        if (c + 1 < 32) { const size_t r1 = rowb + (size_t)(c + 1) * 64;
#pragma unroll
            for (int i = 0; i < 4; ++i) { const size_t e = (r1 + 4 * tg4 + i) * 512 + h * 64 + 2 * dp; rq[i] = *(const unsigned*)(Qm + e); rk[i] = *(const unsigned*)(Km + e); }
#pragma unroll
            for (int i = 0; i < 8; ++i) rv[i] = *(const unsigned*)(Vm + (r1 + 8 * w + i) * 1024 + h * 128 + 2 * lane);
            if (w == 0) { gli = GTg[(r1 + lane) * 16 + h]; glf = GTg[(r1 + lane) * 16 + 8 + h]; }
        }
        const size_t orow = (rowb + (size_t)c * 64 + tb * 16 + fr) * 1024 + h * 128 + 4 * fq;
        v2u rg[4];
#pragma unroll
        for (int j = 0; j < 4; ++j) rg[j] = *(const v2u*)(Om + orow + (4 * wh + j) * 16);
        __syncthreads();
        { const float Mt = LDSV(float, MT + (tb * 16 + fr) * 4);
#pragma unroll
            for (int j = 0; j < 2; ++j) { const int sb = 2 * wh + j; f32x4 a = (f32x4){0.f, 0.f, 0.f, 0.f};
                if (sb <= tb) {
#pragma unroll
                    for (int kk = 0; kk < 2; ++kk) a = MFMA16(LDSF(K + (sb * 16 + fr) * 144 + kk * 64 + fq * 16), LDSF(Q + (tb * 16 + fr) * 144 + kk * 64 + fq * 16), a);
                    const int t = tb * 16 + fr, s0 = sb * 16 + 4 * fq; const f32x4 as = LDSV(f32x4, AS + s0 * 4);
#pragma unroll
                    for (int r = 0; r < 4; ++r) a[r] = (s0 + r > t) ? 0.f : a[r] * __expf(as[r] - Mt);
                }
                LDSV(v2u, AM + (tb * 16 + fr) * 144 + (sb * 16 + 4 * fq) * 2) = (v2u){pk2(a[0], a[1]), pk2(a[2], a[3])}; } }
        __syncthreads();
        f32x4 num[5];
        { bf16x8 bA[2], bQ[2]; const float wi = LDSV(float, WI + (tb * 16 + fr) * 4);
#pragma unroll
            for (int kk = 0; kk < 2; ++kk) { bA[kk] = LDSF(AM + (tb * 16 + fr) * 144 + kk * 64 + fq * 16); bQ[kk] = LDSF(Q + (tb * 16 + fr) * 144 + kk * 64 + fq * 16); }
#pragma unroll
            for (int j = 0; j < 5; ++j) { if (j == 4 && wh != 0) break; const int dvb = j == 4 ? 8 : 4 * wh + j; f32x4 a1 = (f32x4){0.f, 0.f, 0.f, 0.f}, a2 = a1;
#pragma unroll
                for (int kk = 0; kk < 2; ++kk) { a1 = MFMA16(LDSF(VTE + (dvb * 16 + fr) * 144 + kk * 64 + fq * 16), bA[kk], a1); a2 = MFMA16(LDSF(CTE + (dvb * 16 + fr) * 144 + kk * 64 + fq * 16), bQ[kk], a2); }
                num[j] = a1 + a2 * wi; }
            if (wh == 0 && fq == 0) LDSV(float, DEN + (tb * 16 + fr) * 4) = num[4][0]; }
        { bf16x8 aK[2];
#pragma unroll
            for (int kk = 0; kk < 2; ++kk) aK[kk] = LDSF(KWT + (16 * tb + fr) * 144 + kk * 64 + fq * 16);
#pragma unroll
            for (int j = 0; j < 5; ++j) { if (j == 4 && wh != 0) break; const int dvb = j == 4 ? 8 : 4 * wh + j; f32x4 a = cacc[j] * wc;
#pragma unroll
                for (int kk = 0; kk < 2; ++kk) a = MFMA16(aK[kk], LDSF(VTE + (dvb * 16 + fr) * 144 + kk * 64 + fq * 16), a);
                cacc[j] = a; } }
        __syncthreads();
        { const float dn = fmaxf(fabsf(LDSV(float, DEN + (tb * 16 + fr) * 4)), LDSV(float, EM + (tb * 16 + fr) * 4)); const float inv = 1.0f / dn; float ss = 0.f;
#pragma unroll
            for (int j = 0; j < 4; ++j) { num[j] = num[j] * inv; ss += (num[j][0] * num[j][0] + num[j][1] * num[j][1]) + (num[j][2] * num[j][2] + num[j][3] * num[j][3]); }
            ss += __shfl_xor(ss, 16); ss += __shfl_xor(ss, 32);
            if (fq == 0) LDSV(float, NP + ((tb * 16 + fr) * 2 + wh) * 4) = ss; }
        __syncthreads();
        { const f32x2 p = LDSV(f32x2, NP + (tb * 16 + fr) * 8); const float rstd = rsqrtf((p.x + p.y) * (1.0f / 128.0f) + 1e-6f);
#pragma unroll
            for (int j = 0; j < 4; ++j) { const f32x4 o = num[j] * rstd * wn[j];
                *(v2u*)(Hb + orow + (4 * wh + j) * 16) = (v2u){pk2(o[0] * bflo(rg[j].x), o[1] * bfhi(rg[j].x)), pk2(o[2] * bflo(rg[j].y), o[3] * bfhi(rg[j].y))}; } }
#pragma unroll
        for (int j = 0; j < 5; ++j) { if (j == 4 && wh != 0) break; const int dvb = j == 4 ? 8 : 4 * wh + j;
            LDSV(v2u, CTE + (dvb * 16 + fr) * 144 + (16 * tb + 4 * fq) * 2) = (v2u){pk2(cacc[j][0], cacc[j][1]), pk2(cacc[j][2], cacc[j][3])}; }
        m_prev = m_next;
    }
    float* co = C_out + (size_t)(b * 8 + h) * 64 * 128;
#pragma unroll
    for (int j = 0; j < 4; ++j)
#pragma unroll
        for (int r = 0; r < 4; ++r) co[(size_t)(16 * tb + 4 * fq + r) * 128 + (4 * wh + j) * 16 + fr] = cacc[j][r];
    if (wh == 0 && fr == 0) {
#pragma unroll
        for (int r = 0; r < 4; ++r) n_out[(size_t)(b * 8 + h) * 64 + 16 * tb + 4 * fq + r] = cacc[4][r]; }
    if (tid == 0) m_out[b * 8 + h] = m_prev;
}
__device__ __forceinline__ void mlstm_sample_item(LAS unsigned char* lds, int b, int h, const bf16* Qm, const bf16* Km, const bf16* Vm, const bf16* Om, const float* GTg, bf16* Hb, const float* onw,
                                                  const float* C_in, const float* n_in, const float* m_in, float* C_out, float* n_out, float* m_out) {
    constexpr int KQ = 0, VS = 4096, SCL = 8192, DENR = 8320, RED = 20480;
    const int tid = threadIdx.x, lane = tid & 63, w = __builtin_amdgcn_readfirstlane(tid >> 6), c4 = tid & 31, dg = tid >> 5;
    const size_t rowb = (size_t)MP + (size_t)b * 8;
    __syncthreads();
    { const int t = tid >> 6, d = tid & 63; const size_t g = (rowb + t) * 512 + h * 64 + d; LDSV(f32x2, KQ + tid * 8) = (f32x2){bf1(Km[g]), bf1(Qm[g])}; }
#pragma unroll
    for (int e = tid; e < 1024; e += 512) { const int t = e >> 7, d = e & 127; LDSV(float, VS + e * 4) = bf1(Vm[(rowb + t) * 1024 + h * 128 + d]); }
    if (tid == 0) { float m = m_in[b * 8 + h];
        for (int t = 0; t < 8; ++t) { const float li = GTg[(rowb + t) * 16 + h], lf = GTg[(rowb + t) * 16 + 8 + h]; const float mn = fmaxf(lf + m, li);
            LDSV(f32x4, SCL + t * 16) = (f32x4){__expf(lf + m - mn), __expf(li - mn), __expf(-mn), 0.f}; m = mn; }
        m_out[b * 8 + h] = m; }
    const size_t cbase = ((size_t)(b * 8 + h) * 64 + 4 * dg) * 128 + 4 * c4;
    f32x4 cc[4], pn[8]; float nn[4], pd[8];
#pragma unroll
    for (int i = 0; i < 4; ++i) { cc[i] = *(const f32x4*)(C_in + cbase + (size_t)i * 128); nn[i] = n_in[(size_t)(b * 8 + h) * 64 + 4 * dg + i]; }
    __syncthreads();
#pragma unroll
    for (int t = 0; t < 8; ++t) { const f32x4 vv = LDSV(f32x4, VS + (t * 128 + 4 * c4) * 4); const f32x4 sc = LDSV(f32x4, SCL + t * 16); f32x4 p = (f32x4){0.f, 0.f, 0.f, 0.f}; float d = 0.f;
#pragma unroll
        for (int i = 0; i < 4; ++i) { const f32x2 kq = LDSV(f32x2, KQ + (t * 64 + 4 * dg + i) * 8); const float ik = sc[1] * kq.x;
            cc[i] = cc[i] * sc[0] + vv * ik; p += cc[i] * kq.y; nn[i] = nn[i] * sc[0] + ik; d += nn[i] * kq.y; }
        pn[t] = p; pd[t] = d; }
#pragma unroll
    for (int t = 0; t < 8; ++t) { LDSV(f32x4, RED + ((dg * 8 + t) * 128 + 4 * c4) * 4) = pn[t]; if (c4 == 0) LDSV(float, DENR + (dg * 8 + t) * 4) = pd[t]; }
#pragma unroll
    for (int i = 0; i < 4; ++i) { *(f32x4*)(C_out + cbase + (size_t)i * 128) = cc[i]; if (c4 == 0) n_out[(size_t)(b * 8 + h) * 64 + 4 * dg + i] = nn[i]; }
    __syncthreads();
    { const int t = w; float o0 = 0.f, o1 = 0.f, dn = 0.f;
#pragma unroll
        for (int g = 0; g < 16; ++g) { const f32x2 x = LDSV(f32x2, RED + ((g * 8 + t) * 128 + 2 * lane) * 4); o0 += x.x; o1 += x.y; dn += LDSV(float, DENR + (g * 8 + t) * 4); }
        const float inv = 1.0f / fmaxf(fabsf(dn), LDSV(f32x4, SCL + t * 16)[2]); o0 *= inv; o1 *= inv;
        const float rstd = rsqrtf(wave_sum(o0 * o0 + o1 * o1) * (1.0f / 128.0f) + 1e-6f);
        const size_t g = (rowb + t) * 1024 + h * 128 + 2 * lane; const unsigned gg = *(const unsigned*)(Om + g);
        *(unsigned*)(Hb + g) = pk2(o0 * rstd * onw[h * 128 + 2 * lane] * bflo(gg), o1 * rstd * onw[h * 128 + 2 * lane + 1] * bfhi(gg)); }
}

__device__ __forceinline__ void small_unit_resid(LAS unsigned char* lds, const bf16* A, const bf16* Bt, int K, int R0, int C0, const float* basep, float* X, bf16* Xb, float* ssq) {
    const int tid = threadIdx.x, lane = tid & 63, w = __builtin_amdgcn_readfirstlane(tid >> 6), fr = lane & 15, fq = lane >> 4;
    const int kw = K >> 3;
    const bf16* ap = A + (size_t)(R0 + fr) * K + w * kw + 8 * fq;
    const bf16* bp = Bt + (size_t)(C0 + fr) * K + w * kw + 8 * fq;
    const size_t rs16 = (size_t)16 * K;
    f32x4 acc[4][4];
#pragma unroll
    for (int i = 0; i < 4; ++i)
#pragma unroll
        for (int j = 0; j < 4; ++j) acc[i][j] = (f32x4){0.f, 0.f, 0.f, 0.f};
    bf16x8 a0[4], b0[4], a1[4], b1[4];
#pragma unroll
    for (int i = 0; i < 4; ++i) { a0[i] = *(const bf16x8*)(ap + i * rs16); b0[i] = *(const bf16x8*)(bp + i * rs16); }
    for (int ks = 0; ks < kw; ks += 64) {
#pragma unroll
        for (int i = 0; i < 4; ++i) { a1[i] = *(const bf16x8*)(ap + i * rs16 + ks + 32); b1[i] = *(const bf16x8*)(bp + i * rs16 + ks + 32); }
#pragma unroll
        for (int i = 0; i < 4; ++i)
#pragma unroll
            for (int j = 0; j < 4; ++j) acc[i][j] = MFMA16(b0[j], a0[i], acc[i][j]);
        if (ks + 64 < kw) {
#pragma unroll
            for (int i = 0; i < 4; ++i) { a0[i] = *(const bf16x8*)(ap + i * rs16 + ks + 64); b0[i] = *(const bf16x8*)(bp + i * rs16 + ks + 64); }
        }
#pragma unroll
        for (int i = 0; i < 4; ++i)
#pragma unroll
            for (int j = 0; j < 4; ++j) acc[i][j] = MFMA16(b1[j], a1[i], acc[i][j]);
    }
    __syncthreads();
#pragma unroll
    for (int i = 0; i < 4; ++i)
#pragma unroll
        for (int j = 0; j < 4; ++j) LDSV(f32x4, w * 16384 + (16 * i + fr) * 256 + (((4 * j + fq) ^ fr) << 4)) = acc[i][j];
    __syncthreads();
    { const int row = tid >> 3, cg = tid & 7; f32x4 x0 = (f32x4){0.f, 0.f, 0.f, 0.f}, x1 = x0;
#pragma unroll
        for (int g = 0; g < 8; ++g) { x0 += LDSV(f32x4, g * 16384 + row * 256 + (((2 * cg) ^ (row & 15)) << 4)); x1 += LDSV(f32x4, g * 16384 + row * 256 + (((2 * cg + 1) ^ (row & 15)) << 4)); }
        const size_t off = (size_t)(R0 + row) * 1024 + C0 + 8 * cg;
        const f32x4 v0 = *(const f32x4*)(basep + off) + x0, v1 = *(const f32x4*)(basep + off + 4) + x1;
        *(f32x4*)(X + off) = v0; *(f32x4*)(X + off + 4) = v1;
        *(v4u*)(Xb + off) = (v4u){pk2(v0[0], v0[1]), pk2(v0[2], v0[3]), pk2(v1[0], v1[1]), pk2(v1[2], v1[3])};
        float sq = (v0[0] * v0[0] + v0[1] * v0[1]) + (v0[2] * v0[2] + v0[3] * v0[3]) + (v1[0] * v1[0] + v1[1] * v1[1]) + (v1[2] * v1[2] + v1[3] * v1[3]);
        sq += __shfl_xor(sq, 1); sq += __shfl_xor(sq, 2); sq += __shfl_xor(sq, 4);
        if (cg == 0) atomicAdd(ssq + R0 + row, sq); }
}
struct Args { const float* in[19]; float* out; unsigned char* ws; int ph_lo, ph_hi, li, pad; };
#ifndef PG8_SP2
#define PG8_SP2 true
#endif
#ifndef PG8_ALIGN
#define PG8_ALIGN true
#endif
__global__ void __launch_bounds__(NWAVES * 64, 2) trunk_fwd(Args args) {
    extern __shared__ __attribute__((aligned(16))) unsigned char lds_raw[];
    LAS unsigned char* lds = (LAS unsigned char*)lds_raw;
    volatile LAS unsigned* MISC = (volatile LAS unsigned*)(lds + MISC_OFF);
    const int tid = threadIdx.x, lane = tid & 63, wave = __builtin_amdgcn_readfirstlane(tid >> 6);
    const int G = gridDim.x, bx = blockIdx.x;
    unsigned char* ws = args.ws; float* out = args.out;
    gu32* ctl = (gu32*)(ws + WS_CTL);
    float* SS = (float*)(ws + WS_SS); float* LB = (float*)(ws + WS_LB);
    bf16* Win0 = (bf16*)(ws + WS_WIN0); bf16* Wout0 = (bf16*)(ws + WS_WOUT0); bf16* Wup0 = (bf16*)(ws + WS_WUP0); bf16* Wdn0 = (bf16*)(ws + WS_WDN0);
    bf16* Win1 = (bf16*)(ws + WS_WIN1); bf16* Wout1 = (bf16*)(ws + WS_WOUT1); bf16* Wup1 = (bf16*)(ws + WS_WUP1); bf16* Wdn1 = (bf16*)(ws + WS_WDN1);
    bf16* Xb = (bf16*)(ws + WS_XB); bf16* U = (bf16*)(ws + WS_ACT);
    bf16* Qb = (bf16*)(ws + WS_Q); bf16* LFb = (bf16*)(ws + WS_LF); bf16* Vb = (bf16*)(ws + WS_V); bf16* Gb = (bf16*)(ws + WS_G);
    bf16* Qm = (bf16*)(ws + WS_QM); bf16* Km = (bf16*)(ws + WS_KM); bf16* Vm = (bf16*)(ws + WS_VM); bf16* Om = (bf16*)(ws + WS_OM); float* GTg = (float*)(ws + WS_GT);
    float* X = out + OUT_Y;
    for (int u = tid; u < (LDS_BYTES - LDSCTL_OFF) / 4; u += NWAVES * 64) ((LAS unsigned*)(lds + LDSCTL_OFF))[u] = 0u;
    __syncthreads();
    XcdBarrier bar; bar.bar = (unsigned*)(ctl + CW_BAR); bar.x = 0; bar.st = nullptr;
    if (MK_N_LAUNCHES == 1) bar = xcd_barrier_post((unsigned*)(ctl + CW_BAR), MISC + 8);
    const int lo = args.ph_lo, hi = args.ph_hi;
#define IN(k) (lo <= (k) && (k) < hi)
#define SEAM(k) do { if (IN(k) && IN((k) + 1)) xcd_barrier(bar); } while (0)

    if (IN(0)) {
        LAS float* scr = (LAS float*)(lds + wave * 16384);
        const int gw = bx * NWAVES + wave, NGW = G * NWAVES;
        constexpr int I0 = 16 * 128, I1 = 16 * 32, I2 = 16 * 128, I3 = 64 * 32, I4 = 16 * 97, I5 = I1, I6 = I2, I7 = I3, NITEMS = I0 + I1 + I2 + I3 + I4 + I5 + I6 + I7;
        for (int it = gw; it < NITEMS; it += NGW) {
            int r = it;
            if (r < I0) { p0_transpose_item(args.in[8], 1024, 4096, args.in[6], Win0, scr, r, lane); continue; } r -= I0;
            if (r < I1) { p0_transpose_item(args.in[11], 1024, 1024, nullptr, Wout0, scr, r, lane); continue; } r -= I1;
            if (r < I2) { p0_transpose_item(args.in[16], 1024, 4096, args.in[7], Wup0, scr, r, lane); continue; } r -= I2;
            if (r < I3) { p0_transpose_item(args.in[17], 4096, 1024, nullptr, Wdn0, scr, r, lane); continue; } r -= I3;
            if (r < I4) { p0_transpose_item(args.in[12], 1024, NIN1, args.in[6] + 1024, Win1, scr, r, lane); continue; } r -= I4;
            if (r < I5) { p0_transpose_item(args.in[15], 1024, 1024, nullptr, Wout1, scr, r, lane); continue; } r -= I5;
            if (r < I6) { p0_transpose_item(args.in[16] + (size_t)1024 * 4096, 1024, 4096, args.in[7] + 1024, Wup1, scr, r, lane); continue; } r -= I6;
            p0_transpose_item(args.in[17] + (size_t)4096 * 1024, 4096, 1024, nullptr, Wdn1, scr, r, lane);
        }
        for (int m = gw; m < MROWS; m += NGW) {
            const float* xr = m < MP ? args.in[0] + (size_t)m * 1024 : args.in[1] + (size_t)(m - MP) * 1024;
            f32x4 v[4]; float s = 0.f;
#pragma unroll
            for (int j = 0; j < 4; ++j) { v[j] = *((const f32x4*)xr + lane + 64 * j); s += (v[j][0] * v[j][0] + v[j][1] * v[j][1]) + (v[j][2] * v[j][2] + v[j][3] * v[j][3]); }
            s = wave_sum(s); if (lane == 0) SS[m] = s;
#pragma unroll
            for (int j = 0; j < 4; ++j) *((v2u*)(Xb + (size_t)m * 1024) + lane + 64 * j) = (v2u){pk2(v[j][0], v[j][1]), pk2(v[j][2], v[j][3])};
        }
        if (bx == 0) for (int d = tid; d < 1024; d += NWAVES * 64) { const float l0 = args.in[9][d], l1 = args.in[9][1024 + d], l2 = args.in[9][2048 + d]; const float mx = fmaxf(l0, fmaxf(l1, l2));
            const float e0 = expf(l0 - mx), e1 = expf(l1 - mx), e2 = expf(l2 - mx); LB[d] = e0 / (e0 + e1 + e2); }
    }
    SEAM(0);
    if (IN(1)) { pg8::Gemm g{Xb, Win0, MROWS, 4096, 1024}; pg8::StaticOrder S; S.init(MROWS, 4096, G, bx);
        pg8::EpiHgrnIn E{Qb, LFb, Vb, Gb, SS, LB};
        pg8::gemm_phase<pg8::EpiHgrnIn, pg8::StaticOrder, PG8_ALIGN, PG8_SP2>(lds, g, S, E); }
    SEAM(1);
    if (IN(2)) {
        const int npb = G > 64 ? 64 : G;
#ifdef PROBE_DUP_REC
        if (bx < npb) for (int it = bx; it < 64; it += npb) hgrn_prompt_item(lds, it >> 3, it & 7, Qb, LFb, Vb, Gb, Xb, args.in[10], out + OUT_SP);
#endif
        if (bx < npb) for (int it = bx; it < 64; it += npb) hgrn_prompt_item(lds, it >> 3, it & 7, Qb, LFb, Vb, Gb, Qb, args.in[10], out + OUT_SP);
        const int first = G > 64 ? 64 : 0, nsb = G - first;
        if (bx >= first) for (int it = bx - first; it < 1024; it += nsb) hgrn_sample_item(lds, it >> 3, it & 7, Qb, LFb, Vb, Gb, Qb, args.in[10], args.in[2], out + OUT_SS);
    }
    SEAM(2);
    if (IN(3)) { pg8::Gemm g{Qb, Wout0, MP, 1024, 1024}; pg8::StaticOrder S; S.init(MP, 1024, G, bx);
        pg8::EpiResid E{args.in[0], args.in[1], X, Xb, SS + MROWS};
        pg8::gemm_phase<pg8::EpiResid, pg8::StaticOrder, PG8_ALIGN, PG8_SP2>(lds, g, S, E);
        for (int u = bx; u < 256; u += G) small_unit_resid(lds, Qb, Wout0, 1024, MP + 64 * (u >> 4), 64 * (u & 15), args.in[1] - (size_t)MP * 1024, X, Xb, SS + MROWS); }
    SEAM(3);
    if (IN(4)) { pg8::Gemm g{Xb, Wup0, MROWS, 4096, 1024}; pg8::StaticOrder S; S.init(MROWS, 4096, G, bx);
        pg8::EpiUp E{U, SS + MROWS};
        pg8::gemm_phase<pg8::EpiUp, pg8::StaticOrder, PG8_ALIGN, PG8_SP2>(lds, g, S, E); }
    SEAM(4);
    if (IN(5)) { pg8::Gemm g{U, Wdn0, MP, 1024, 4096}; pg8::StaticOrder S; S.init(MP, 1024, G, bx);
        pg8::EpiResid E{X, X + (size_t)MP * 1024, X, Xb, SS + 2 * MROWS};
        pg8::gemm_phase<pg8::EpiResid, pg8::StaticOrder, PG8_ALIGN, PG8_SP2>(lds, g, S, E);
        for (int u = bx; u < 256; u += G) small_unit_resid(lds, U, Wdn0, 4096, MP + 64 * (u >> 4), 64 * (u & 15), X, X, Xb, SS + 2 * MROWS); }
    SEAM(5);
    if (IN(6)) { pg8::Gemm g{Xb, Win1, MROWS, NIN1P, 1024}; pg8::StaticOrder S; S.init(MROWS, NIN1P, G, bx);
        pg8::EpiMlstmIn E{Qm, Km, Vm, Om, GTg, SS + 2 * MROWS, args.in[13]};
        pg8::gemm_phase<pg8::EpiMlstmIn, pg8::StaticOrder, PG8_ALIGN, PG8_SP2>(lds, g, S, E); }
    SEAM(6);
    if (IN(7)) {
        const int npb = G > 64 ? 64 : G;
#ifdef PROBE_DUP_REC
        if (bx < npb) for (int it = bx; it < 64; it += npb) mlstm_prompt_item(lds, it >> 3, it & 7, Qm, Km, Vm, Om, GTg, Xb, args.in[14], out + OUT_CP, out + OUT_NP, out + OUT_MP);
#endif
        if (bx < npb) for (int it = bx; it < 64; it += npb) mlstm_prompt_item(lds, it >> 3, it & 7, Qm, Km, Vm, Om, GTg, Vm, args.in[14], out + OUT_CP, out + OUT_NP, out + OUT_MP);
        const int first = G > 64 ? 64 : 0, nsb = G - first;
        if (bx >= first) for (int it = bx - first; it < 1024; it += nsb) mlstm_sample_item(lds, it >> 3, it & 7, Qm, Km, Vm, Om, GTg, Vm, args.in[14], args.in[3], args.in[4], args.in[5], out + OUT_CS, out + OUT_NS, out + OUT_MS);
    }
    SEAM(7);
    if (IN(8)) { pg8::Gemm g{Vm, Wout1, MP, 1024, 1024}; pg8::StaticOrder S; S.init(MP, 1024, G, bx);
        pg8::EpiResid E{X, X + (size_t)MP * 1024, X, Xb, SS + 3 * MROWS};
        pg8::gemm_phase<pg8::EpiResid, pg8::StaticOrder, PG8_ALIGN, PG8_SP2>(lds, g, S, E);
        for (int u = bx; u < 256; u += G) small_unit_resid(lds, Vm, Wout1, 1024, MP + 64 * (u >> 4), 64 * (u & 15), X, X, Xb, SS + 3 * MROWS); }
    SEAM(8);
    if (IN(9)) { pg8::Gemm g{Xb, Wup1, MROWS, 4096, 1024}; pg8::StaticOrder S; S.init(MROWS, 4096, G, bx);
        pg8::EpiUp E{U, SS + 3 * MROWS};
        pg8::gemm_phase<pg8::EpiUp, pg8::StaticOrder, PG8_ALIGN, PG8_SP2>(lds, g, S, E); }
    SEAM(9);
    if (IN(10)) { pg8::Gemm g{U, Wdn1, MP, 1024, 4096}; pg8::StaticOrder S; S.init(MP, 1024, G, bx);
        pg8::EpiResid E{X, X + (size_t)MP * 1024, X, Xb, SS + 4 * MROWS};
        pg8::gemm_phase<pg8::EpiResid, pg8::StaticOrder, PG8_ALIGN, PG8_SP2>(lds, g, S, E);
        for (int u = bx; u < 256; u += G) small_unit_resid(lds, U, Wdn1, 4096, MP + 64 * (u >> 4), 64 * (u & 15), X, X, Xb, SS + 4 * MROWS); }
    SEAM(10);
    if (IN(11)) {
        const int gw = bx * NWAVES + wave, NGW = G * NWAVES; const float* wf = args.in[18];
        f32x4 wv[4];
#pragma unroll
        for (int j = 0; j < 4; ++j) wv[j] = *((const f32x4*)wf + lane + 64 * j);
        for (int m = gw; m < MROWS; m += NGW) { const float rs = rsqrtf(SS[4 * MROWS + m] * (1.0f / 1024.0f) + 1e-6f); f32x4* xr = (f32x4*)(X + (size_t)m * 1024);
#pragma unroll
            for (int j = 0; j < 4; ++j) xr[lane + 64 * j] = xr[lane + 64 * j] * rs * wv[j]; }
    }
#undef IN
#undef SEAM
}

extern "C" void kernel_launch(void* const* d_in, const int* in_sizes, int n_in, void* d_out, int out_size, void* d_ws, size_t ws_size, hipStream_t stream) {
    static int grid = 0;
    if (grid == 0) {
        if (n_in != 19 || out_size != (int)OUT_END || ws_size < WS_END) { fprintf(stderr, "kernel_launch: unexpected shapes: n_in %d out %d ws %zu\n", n_in, out_size, ws_size); grid = -1; return; }
        int dev = 0, cus = 0, per_cu = 0;
        if (hipGetDevice(&dev) != hipSuccess || hipDeviceGetAttribute(&cus, hipDeviceAttributeMultiprocessorCount, dev) != hipSuccess) { grid = -1; return; }
        if (hipFuncSetAttribute((const void*)trunk_fwd, hipFuncAttributeMaxDynamicSharedMemorySize, LDS_BYTES) != hipSuccess) { fprintf(stderr, "kernel_launch: hipFuncSetAttribute failed\n"); grid = -1; return; }
        if (hipOccupancyMaxActiveBlocksPerMultiprocessor(&per_cu, (const void*)trunk_fwd, NWAVES * 64, LDS_BYTES) != hipSuccess || per_cu < 1) { fprintf(stderr, "kernel_launch: occupancy query says %d blocks per CU\n", per_cu); grid = -1; return; }
        (void)hipGetLastError();
        grid = cus;
    }
    if (grid < 0) return;
    (void)hipMemsetAsync((char*)d_ws + WS_CTL, 0, CTL_ZERO_BYTES, stream);
    Args a{};
    for (int i = 0; i < 19; ++i) a.in[i] = (const float*)d_in[i];
    a.out = (float*)d_out; a.ws = (unsigned char*)d_ws;
#if MK_N_LAUNCHES == 1
    a.ph_lo = 0; a.ph_hi = N_PHASES; a.li = 0;
    hipLaunchKernelGGL(trunk_fwd, dim3(grid), dim3(NWAVES * 64), LDS_BYTES, stream, a);
#else
    for (int li = 0; li < N_PHASES; ++li) { a.ph_lo = li; a.ph_hi = li + 1; a.li = li; hipLaunchKernelGGL(trunk_fwd, dim3(grid), dim3(NWAVES * 64), LDS_BYTES, stream, a); }
#endif
}
```

```cpp
#include <hip/hip_runtime.h>
#include <cstdio>
#include <cstdint>
#include <cmath>
namespace pg8 {
#define PG8_LAS __attribute__((address_space(3)))
typedef unsigned short bf16_t;
typedef short bf16x8 __attribute__((ext_vector_type(8)));
typedef float f32x4 __attribute__((ext_vector_type(4)));
typedef unsigned u32x4 __attribute__((ext_vector_type(4)));
constexpr int BM = 256, BK = 64, HALF = 128, HTB = HALF * BK * 2  , STAGE_BYTES = 8 * HTB, NXCD = 8, WGM = 8;

__host__ __device__ __forceinline__ int lds_byte(int r, int c) { const int st = (r >> 4) * 2 + (c >> 5), rr = r & 15, cc = c & 31, ob = rr * 64 + cc * 2; return st * 1024 + (ob ^ (((ob >> 9) & 1) << 5)); }
__host__ __device__ __forceinline__ void stage_rc(int b, int& R, int& C) { const int st = b / 1024, sb = b % 1024, swz = sb ^ (((sb >> 9) & 1) << 5); R = (st >> 1) * 16 + swz / 64; C = (st & 1) * 32 + (swz % 64) / 2; }
__host__ __device__ __forceinline__ int perm32(int rho) { const int n = rho >> 4, i = rho & 15; return 8 * (i >> 2) + 4 * n + (i & 3); }

struct Unit { int pm, pn; };
struct Gemm { const bf16_t* A; const bf16_t* Bt; int M, N, K; };

struct StaticOrder {
    int nM, nN, nwg, G, c;
    __host__ __device__ void init(int M, int N, int G_, int c_) { nM = M / BM; nN = N / BM; nwg = nM * nN; G = G_; c = c_; }
    __host__ __device__ bool next(int i, Unit& u) const {
        const long L = (long)i * G + c; if (L >= nwg) return false;
        int wgid = (int)L; { const int q = nwg / NXCD, r = nwg % NXCD, xcd = wgid % NXCD, off = wgid / NXCD; wgid = (xcd < r ? xcd * (q + 1) : r * (q + 1) + (xcd - r) * q) + off; }
        const int nig = WGM * nN, gid = wgid / nig, fm = gid * WGM, gsz = (nM - fm) < WGM ? (nM - fm) : WGM;
        u.pm = fm + ((wgid % nig) % gsz); u.pn = (wgid % nig) / gsz; return true;
    }
    __device__ __forceinline__ void a_ready(const Unit&) const {}
    __device__ __forceinline__ void done(const Unit&) const {}
};

typedef unsigned u32x2 __attribute__((ext_vector_type(2)));
__device__ __forceinline__ unsigned f2bf_(float f) { unsigned u = __builtin_bit_cast(unsigned, f); return (u + 0x7fffu + ((u >> 16) & 1u)) >> 16; }
typedef float f32x2c_ __attribute__((ext_vector_type(2))); typedef __bf16 bf16x2c_ __attribute__((ext_vector_type(2)));
__device__ __forceinline__ unsigned pkbf(float lo, float hi) { f32x2c_ v = {lo, hi}; bf16x2c_ b = __builtin_convertvector(v, bf16x2c_); return __builtin_bit_cast(unsigned, b); }
__device__ __forceinline__ unsigned pkh(float lo, float hi) { const _Float16 a = (_Float16)lo, b = (_Float16)hi; return (unsigned)__builtin_bit_cast(unsigned short, a) | ((unsigned)__builtin_bit_cast(unsigned short, b) << 16); }
__device__ __forceinline__ float sigm(float x) { return __builtin_amdgcn_rcpf(1.0f + __expf(-x)); }
constexpr float NORM_EPS = 1e-6f;
constexpr int XROW0 = 16384;

struct EpiHgrnIn {
    static constexpr bool PERM = true, AFTER_DRAIN = false;
    bf16_t* Q; bf16_t* LF; bf16_t* V; bf16_t* G; const float* ss; const float* lb;
    template <int GRP> __device__ __forceinline__ void run(const f32x4 (&acc)[2][2][4][2], const Unit& u, int wr, int wc, int fr, int fq) const {
        const int row0 = u.pm * BM + wr * 64 + fr, gc0 = (u.pn & 3) * BM + wc * 32 + 8 * fq;
        bf16_t* dst = GRP == 0 ? Q : GRP == 1 ? LF : GRP == 2 ? V : G;
        f32x4 lbv[2][2];
        if (GRP == 1) {
#pragma unroll
            for (int bj = 0; bj < 2; ++bj)
#pragma unroll
                for (int n = 0; n < 2; ++n) lbv[bj][n] = *(const f32x4*)(lb + gc0 + bj * HALF + 4 * n);
        }
#pragma unroll
        for (int ai = 0; ai < 2; ++ai)
#pragma unroll
            for (int m = 0; m < 4; ++m) { const int row = row0 + ai * HALF + m * 16; const float rs = rsqrtf(ss[row] * (1.0f / 1024.0f) + NORM_EPS);
                bf16_t* rowp = dst + (size_t)row * 1024 + gc0;
#pragma unroll
                for (int bj = 0; bj < 2; ++bj) { float x[8];
#pragma unroll
                    for (int n = 0; n < 2; ++n)
#pragma unroll
                        for (int j = 0; j < 4; ++j) x[4 * n + j] = acc[ai][bj][m][n][j] * rs;
                    u32x4 w;
                    if (GRP == 0 || GRP == 3) {
#pragma unroll
                        for (int j = 0; j < 8; ++j) x[j] = x[j] * sigm(x[j]);
                    }
                    if (GRP == 1) {
#pragma unroll
                        for (int j = 0; j < 8; ++j) { const float l = lbv[bj][j >> 2][j & 3]; x[j] = __logf(l + (1.0f - l) * sigm(x[j])); }
                        w.x = pkh(x[0], x[1]); w.y = pkh(x[2], x[3]); w.z = pkh(x[4], x[5]); w.w = pkh(x[6], x[7]);
                    } else { w.x = pkbf(x[0], x[1]); w.y = pkbf(x[2], x[3]); w.z = pkbf(x[4], x[5]); w.w = pkbf(x[6], x[7]); }
                    *(u32x4*)(rowp + bj * HALF) = w; } }
    }
    __device__ __forceinline__ void operator()(const f32x4 (&acc)[2][2][4][2], const Unit& u, int wr, int wc, int fr, int fq) const {
        const int grp = u.pn >> 2;
        if (grp == 0) run<0>(acc, u, wr, wc, fr, fq); else if (grp == 1) run<1>(acc, u, wr, wc, fr, fq); else if (grp == 2) run<2>(acc, u, wr, wc, fr, fq); else run<3>(acc, u, wr, wc, fr, fq);
    }
    __device__ __forceinline__ void extra(const f32x4 (&accE)[2], const Unit& u, int wr, int wc, int fr, int fq) const {
        const int grp = u.pn >> 2, row = XROW0 + 16 * u.pm + fr, gc0 = (u.pn & 3) * BM + wr * HALF + wc * 32 + 8 * fq;
        const float rs = rsqrtf(ss[row] * (1.0f / 1024.0f) + NORM_EPS);
        float x[8];
#pragma unroll
        for (int j = 0; j < 8; ++j) x[j] = accE[j >> 2][j & 3] * rs;
        bf16_t* dst = grp == 0 ? Q : grp == 1 ? LF : grp == 2 ? V : G;
        u32x4 w;
        if (grp == 0 || grp == 3) {
#pragma unroll
            for (int j = 0; j < 8; ++j) x[j] = x[j] * sigm(x[j]);
        }
        if (grp == 1) {
#pragma unroll
            for (int j = 0; j < 8; ++j) { const float l = lb[gc0 + j]; x[j] = __logf(l + (1.0f - l) * sigm(x[j])); }
            w.x = pkh(x[0], x[1]); w.y = pkh(x[2], x[3]); w.z = pkh(x[4], x[5]); w.w = pkh(x[6], x[7]);
        } else { w.x = pkbf(x[0], x[1]); w.y = pkbf(x[2], x[3]); w.z = pkbf(x[4], x[5]); w.w = pkbf(x[6], x[7]); }
        *(u32x4*)(dst + (size_t)row * 1024 + gc0) = w;
    }
};

struct EpiMlstmIn {
    static constexpr bool PERM = true, AFTER_DRAIN = false;
    bf16_t* Qm; bf16_t* Km; bf16_t* Vm; bf16_t* Om; float* GT; const float* ss; const float* gb;
    template <int GRP> __device__ __forceinline__ void run(const f32x4 (&acc)[2][2][4][2], const Unit& u, int wr, int wc, int fr, int fq) const {
        const int row0 = u.pm * BM + wr * 64 + fr;
        const int ld = GRP < 2 ? 512 : 1024;
        const int tb = GRP == 0 ? 0 : GRP == 1 ? 2 : GRP == 2 ? 4 : 8;
        const int gc0 = (u.pn - tb) * BM + wc * 32 + 8 * fq;
        bf16_t* dst = GRP == 0 ? Qm : GRP == 1 ? Km : GRP == 2 ? Vm : Om;
#pragma unroll
        for (int ai = 0; ai < 2; ++ai)
#pragma unroll
            for (int m = 0; m < 4; ++m) { const int row = row0 + ai * HALF + m * 16; const float rs = rsqrtf(ss[row] * (1.0f / 1024.0f) + NORM_EPS);
                bf16_t* rowp = dst + (size_t)row * ld + gc0;
#pragma unroll
                for (int bj = 0; bj < 2; ++bj) { float x[8];
#pragma unroll
                    for (int n = 0; n < 2; ++n)
#pragma unroll
                        for (int j = 0; j < 4; ++j) x[4 * n + j] = acc[ai][bj][m][n][j] * rs;
                    if (GRP == 0) {
#pragma unroll
                        for (int j = 0; j < 8; ++j) x[j] *= 0.125f;
                    }
                    if (GRP == 3) {
#pragma unroll
                        for (int j = 0; j < 8; ++j) x[j] = sigm(x[j]);
                    }
                    u32x4 w; w.x = pkbf(x[0], x[1]); w.y = pkbf(x[2], x[3]); w.z = pkbf(x[4], x[5]); w.w = pkbf(x[6], x[7]);
                    *(u32x4*)(rowp + bj * HALF) = w; } }
    }
    __device__ __forceinline__ void gates(const f32x4 (&acc)[2][2][4][2], const Unit& u, int wr, int wc, int fr, int fq) const {
        if (wc != 0 || fq >= 2) return;
        const int row0 = u.pm * BM + wr * 64 + fr;
#pragma unroll
        for (int ai = 0; ai < 2; ++ai)
#pragma unroll
            for (int m = 0; m < 4; ++m) { const int row = row0 + ai * HALF + m * 16; const float rs = rsqrtf(ss[row] * (1.0f / 1024.0f) + NORM_EPS);
                float x[8];
#pragma unroll
                for (int n = 0; n < 2; ++n)
#pragma unroll
                    for (int j = 0; j < 4; ++j) x[4 * n + j] = acc[ai][0][m][n][j] * rs;
#pragma unroll
                for (int j = 0; j < 8; ++j) { const float y2 = (x[j] + gb[8 * fq + j]) * (2.0f / 15.0f); const float z = 15.0f - 30.0f * __builtin_amdgcn_rcpf(__expf(y2) + 1.0f); x[j] = fq == 0 ? z : -__logf(1.0f + __expf(-z)); }
                float* o = GT + (size_t)row * 16 + 8 * fq;
                *(f32x4*)o = (f32x4){x[0], x[1], x[2], x[3]}; *(f32x4*)(o + 4) = (f32x4){x[4], x[5], x[6], x[7]}; }
    }
    __device__ __forceinline__ void operator()(const f32x4 (&acc)[2][2][4][2], const Unit& u, int wr, int wc, int fr, int fq) const {
        const int pn = u.pn;
        if (pn < 2) run<0>(acc, u, wr, wc, fr, fq); else if (pn < 4) run<1>(acc, u, wr, wc, fr, fq); else if (pn < 8) run<2>(acc, u, wr, wc, fr, fq); else if (pn < 12) run<3>(acc, u, wr, wc, fr, fq); else gates(acc, u, wr, wc, fr, fq);
    }
    __device__ __forceinline__ void extra(const f32x4 (&accE)[2], const Unit& u, int wr, int wc, int fr, int fq) const {
        const int pn = u.pn, row = XROW0 + 16 * u.pm + fr;
        const float rs = rsqrtf(ss[row] * (1.0f / 1024.0f) + NORM_EPS);
        float x[8];
#pragma unroll
        for (int j = 0; j < 8; ++j) x[j] = accE[j >> 2][j & 3] * rs;
        if (pn == 12) {
            if (wr != 0 || wc != 0 || fq >= 2) return;
#pragma unroll
            for (int j = 0; j < 8; ++j) { const float y2 = (x[j] + gb[8 * fq + j]) * (2.0f / 15.0f); const float z = 15.0f - 30.0f * __builtin_amdgcn_rcpf(__expf(y2) + 1.0f); x[j] = fq == 0 ? z : -__logf(1.0f + __expf(-z)); }
            float* o = GT + (size_t)row * 16 + 8 * fq;
            *(f32x4*)o = (f32x4){x[0], x[1], x[2], x[3]}; *(f32x4*)(o + 4) = (f32x4){x[4], x[5], x[6], x[7]};
            return;
        }
        const int grp = pn < 2 ? 0 : pn < 4 ? 1 : pn < 8 ? 2 : 3, tb = grp == 0 ? 0 : grp == 1 ? 2 : grp == 2 ? 4 : 8, ld = grp < 2 ? 512 : 1024;
        const int gc0 = (pn - tb) * BM + wr * HALF + wc * 32 + 8 * fq;
        bf16_t* dst = grp == 0 ? Qm : grp == 1 ? Km : grp == 2 ? Vm : Om;
        if (grp == 0) {
#pragma unroll
            for (int j = 0; j < 8; ++j) x[j] *= 0.125f;
        }
        if (grp == 3) {
#pragma unroll
            for (int j = 0; j < 8; ++j) x[j] = sigm(x[j]);
        }
        u32x4 w; w.x = pkbf(x[0], x[1]); w.y = pkbf(x[2], x[3]); w.z = pkbf(x[4], x[5]); w.w = pkbf(x[6], x[7]);
        *(u32x4*)(dst + (size_t)row * ld + gc0) = w;
    }
};

struct EpiUp {
    static constexpr bool PERM = true, AFTER_DRAIN = false;
    bf16_t* U; const float* ss;
    __device__ __forceinline__ void operator()(const f32x4 (&acc)[2][2][4][2], const Unit& u, int wr, int wc, int fr, int fq) const {
        const int row0 = u.pm * BM + wr * 64 + fr, c0 = u.pn * BM + wc * 32 + 8 * fq;
#pragma unroll
        for (int ai = 0; ai < 2; ++ai)
#pragma unroll
            for (int m = 0; m < 4; ++m) { const int row = row0 + ai * HALF + m * 16; const float rs = rsqrtf(ss[row] * (1.0f / 1024.0f) + NORM_EPS);
                bf16_t* rowp = U + (size_t)row * 4096 + c0;
#pragma unroll
                for (int bj = 0; bj < 2; ++bj) { float x[8];
#pragma unroll
                    for (int n = 0; n < 2; ++n)
#pragma unroll
                        for (int j = 0; j < 4; ++j) { const float a = fmaxf(acc[ai][bj][m][n][j] * rs, 0.0f); x[4 * n + j] = a * a; }
                    u32x4 w; w.x = pkbf(x[0], x[1]); w.y = pkbf(x[2], x[3]); w.z = pkbf(x[4], x[5]); w.w = pkbf(x[6], x[7]);
                    *(u32x4*)(rowp + bj * HALF) = w; } }
    }
    __device__ __forceinline__ void extra(const f32x4 (&accE)[2], const Unit& u, int wr, int wc, int fr, int fq) const {
        const int row = XROW0 + 16 * u.pm + fr, c0 = u.pn * BM + wr * HALF + wc * 32 + 8 * fq;
        const float rs = rsqrtf(ss[row] * (1.0f / 1024.0f) + NORM_EPS);
        float x[8];
#pragma unroll
        for (int j = 0; j < 8; ++j) { const float a = fmaxf(accE[j >> 2][j & 3] * rs, 0.0f); x[j] = a * a; }
        u32x4 w; w.x = pkbf(x[0], x[1]); w.y = pkbf(x[2], x[3]); w.z = pkbf(x[4], x[5]); w.w = pkbf(x[6], x[7]);
        *(u32x4*)(U + (size_t)row * 4096 + c0) = w;
    }
};

struct EpiResid {
    static constexpr bool PERM = false, AFTER_DRAIN = false;
    const float* base0; const float* base1; float* X; bf16_t* Xb; float* ssq;
    __device__ __forceinline__ void operator()(const f32x4 (&acc)[2][2][4][2], const Unit& u, int wr, int wc, int fr, int fq) const {
        const int row0 = u.pm * BM + wr * 64 + fr, c0 = u.pn * BM + wc * 32 + 4 * fq;
        const float* bs = u.pm < 64 ? base0 : base1 - (size_t)16384 * 1024;
#pragma unroll
        for (int ai = 0; ai < 2; ++ai)
#pragma unroll
            for (int m = 0; m < 4; ++m) { const int row = row0 + ai * HALF + m * 16; const size_t off = (size_t)row * 1024 + c0; float s = 0.f;
#pragma unroll
                for (int bj = 0; bj < 2; ++bj)
#pragma unroll
                    for (int n = 0; n < 2; ++n) { const f32x4 b = *(const f32x4*)(bs + off + bj * HALF + n * 16); const f32x4 v = b + acc[ai][bj][m][n];
                        *(f32x4*)(X + off + bj * HALF + n * 16) = v; u32x2 w; w.x = pkbf(v[0], v[1]); w.y = pkbf(v[2], v[3]); *(u32x2*)(Xb + off + bj * HALF + n * 16) = w;
                        s += (v[0] * v[0] + v[1] * v[1]) + (v[2] * v[2] + v[3] * v[3]); }
                s += __shfl_xor(s, 16); s += __shfl_xor(s, 32);
                if (fq == 0) atomicAdd(ssq + row, s); }
    }
    __device__ __forceinline__ void extra(const f32x4 (&accE)[2], const Unit& u, int wr, int wc, int fr, int fq) const {
        const int row = XROW0 + 16 * u.pm + fr, c0 = u.pn * BM + wr * HALF + wc * 32 + 4 * fq;
        const float* bs = base1 - (size_t)XROW0 * 1024; const size_t off = (size_t)row * 1024 + c0; float s = 0.f;
#pragma unroll
        for (int n = 0; n < 2; ++n) { const f32x4 b = *(const f32x4*)(bs + off + n * 16); const f32x4 v = b + accE[n];
            *(f32x4*)(X + off + n * 16) = v; u32x2 w; w.x = pkbf(v[0], v[1]); w.y = pkbf(v[2], v[3]); *(u32x2*)(Xb + off + n * 16) = w;
            s += (v[0] * v[0] + v[1] * v[1]) + (v[2] * v[2] + v[3] * v[3]); }
        s += __shfl_xor(s, 16); s += __shfl_xor(s, 32);
        if (fq == 0) atomicAdd(ssq + row, s);
    }
};
template <class Epi, class Sched, bool ALIGN_EPI = false, bool SP2 = false>
__device__ __forceinline__ void gemm_phase(PG8_LAS unsigned char* lds, const Gemm g, const Sched& S, const Epi& E) {
    const int tid = threadIdx.x, wid = __builtin_amdgcn_readfirstlane(tid >> 6), lane = tid & 63, wr = wid >> 2, wc = wid & 3, fr = lane & 15, fq = lane >> 4;
    const int K = g.K, nt = K / BK;
    unsigned voffA[2], voffB[2];
#pragma unroll
    for (int i = 0; i < 2; ++i) { int R, C; stage_rc(tid * 16 + i * 8192, R, C); const int Rb = Epi::PERM ? ((R & ~31) + perm32(R & 31)) : R;
        voffA[i] = (unsigned)(R * K + C) * 2u; voffB[i] = (unsigned)(Rb * K + C) * 2u; }
    const size_t kstep = (size_t)(BK * 2);
    const size_t hstep = (size_t)HALF * K * 2;
    const size_t tstep = 2 * hstep;
    const unsigned ldsw = (unsigned)wid * 1024u;
    const int aoff = lds_byte(wr * 64 + fr, fq * 8), boff = lds_byte(wc * 32 + fr, fq * 8);
#define PG8_SA(b, h) (((b) * 2 + (h)) * HTB)
#define PG8_SB(b, h) ((4 + (b) * 2 + (h)) * HTB)
#define PG8_STAGE(bufoff, gbase, voff) do { _Pragma("unroll") for (int _i = 0; _i < 2; ++_i) \
        __builtin_amdgcn_global_load_lds((const unsigned*)((const char*)(gbase) + (voff)[_i]), (PG8_LAS unsigned*)(lds + (bufoff) + ldsw + _i * 8192), 16, 0, 0); } while (0)
#define PG8_LDA(dst, b, h) do { _Pragma("unroll") for (int m = 0; m < 4; ++m) _Pragma("unroll") for (int k = 0; k < 2; ++k) dst[m][k] = *(const PG8_LAS bf16x8*)(lds + PG8_SA(b, h) + aoff + m * 2048 + k * 1024); } while (0)
#define PG8_LDB(dst, b, h) do { _Pragma("unroll") for (int n = 0; n < 2; ++n) _Pragma("unroll") for (int k = 0; k < 2; ++k) dst[n][k] = *(const PG8_LAS bf16x8*)(lds + PG8_SB(b, h) + boff + n * 2048 + k * 1024); } while (0)
#define PG8_MMA(ai, bj, At, Bt) do { __builtin_amdgcn_s_setprio(1); _Pragma("unroll") for (int m = 0; m < 4; ++m) _Pragma("unroll") for (int n = 0; n < 2; ++n) _Pragma("unroll") for (int k = 0; k < 2; ++k) \
        acc[ai][bj][m][n] = __builtin_amdgcn_mfma_f32_16x16x32_bf16(Bt[n][k], At[m][k], acc[ai][bj][m][n], 0, 0, 0); __builtin_amdgcn_s_setprio(0); } while (0)
#define PG8_WAIT_V(n) asm volatile("s_waitcnt vmcnt(" #n ")" ::: "memory")
#define PG8_WAIT_L(n) asm volatile("s_waitcnt lgkmcnt(" #n ")" ::: "memory")
#define PG8_BAR __builtin_amdgcn_s_barrier()
#define PG8_SCHED __builtin_amdgcn_sched_barrier(0)
    Unit cur, nxt; int ui = 0;
    if (!S.next(0, cur)) return;
    f32x4 acc[2][2][4][2];
#pragma unroll
    for (int a = 0; a < 2; ++a)
#pragma unroll
        for (int b = 0; b < 2; ++b)
#pragma unroll
            for (int m = 0; m < 4; ++m)
#pragma unroll
                for (int n = 0; n < 2; ++n) acc[a][b][m][n] = (f32x4){0.f, 0.f, 0.f, 0.f};
    bf16x8 At[4][2], B0[2][2], B1[2][2];
    const char* cA = (const char*)g.A + (size_t)cur.pm * tstep; const char* cB = (const char*)g.Bt + (size_t)cur.pn * tstep;
    S.a_ready(cur);
    if constexpr (SP2) {
        PG8_STAGE(PG8_SB(0, 0), cB, voffB); PG8_STAGE(PG8_SB(0, 1), cB + hstep, voffB); PG8_STAGE(PG8_SA(0, 0), cA, voffA); PG8_STAGE(PG8_SA(0, 1), cA + hstep, voffA);
        if (wr == 1) PG8_BAR;
        PG8_WAIT_V(2); PG8_BAR;
        PG8_STAGE(PG8_SB(1, 0), cB + kstep, voffB); PG8_STAGE(PG8_SA(1, 0), cA + kstep, voffA); PG8_STAGE(PG8_SB(1, 1), cB + hstep + kstep, voffB);
        PG8_WAIT_V(6); PG8_BAR;
    } else {
        PG8_STAGE(PG8_SB(0, 0), cB, voffB); PG8_STAGE(PG8_SA(0, 0), cA, voffA); PG8_STAGE(PG8_SB(0, 1), cB + hstep, voffB); PG8_STAGE(PG8_SA(0, 1), cA + hstep, voffA);
        if (wr == 1) PG8_BAR;
        PG8_WAIT_V(4); PG8_BAR;
        PG8_STAGE(PG8_SB(1, 0), cB + kstep, voffB); PG8_STAGE(PG8_SA(1, 0), cA + kstep, voffA); PG8_STAGE(PG8_SB(1, 1), cB + hstep + kstep, voffB);
        PG8_WAIT_V(6); PG8_BAR;
    }
    for (;;) {
        const bool has_next = S.next(ui + 1, nxt);
        const char* nA = has_next ? (const char*)g.A + (size_t)nxt.pm * tstep : cA; const char* nB = has_next ? (const char*)g.Bt + (size_t)nxt.pn * tstep : cB;
        for (int t = 0; t < nt; t += 2) {
            const bool last = (t == nt - 2);
            const char* a1 = cA + (size_t)(t + 1) * kstep;
            const char* a2 = last ? nA : cA + (size_t)(t + 2) * kstep; const char* b2 = last ? nB : cB + (size_t)(t + 2) * kstep;
            const char* a3 = a2 + kstep; const char* b3 = b2 + kstep;
            if (last && has_next) S.a_ready(nxt);
            if constexpr (SP2) {
            PG8_LDB(B0, 0, 0); PG8_LDB(B1, 0, 1); PG8_SCHED; PG8_LDA(At, 0, 0); PG8_STAGE(PG8_SA(1, 1), a1 + hstep, voffA);
            PG8_WAIT_V(8); PG8_WAIT_L(0); PG8_BAR; PG8_MMA(0, 0, At, B0); PG8_MMA(0, 1, At, B1); PG8_BAR; PG8_SCHED;
            PG8_LDA(At, 0, 1); PG8_STAGE(PG8_SB(0, 0), b2, voffB); PG8_STAGE(PG8_SB(0, 1), b2 + hstep, voffB); PG8_STAGE(PG8_SA(0, 0), a2, voffA);
            PG8_WAIT_V(8); PG8_WAIT_L(0); PG8_BAR; PG8_MMA(1, 0, At, B0); PG8_MMA(1, 1, At, B1); PG8_BAR; PG8_SCHED;
            PG8_LDB(B0, 1, 0); PG8_LDB(B1, 1, 1); PG8_SCHED; PG8_LDA(At, 1, 0); PG8_STAGE(PG8_SA(0, 1), a2 + hstep, voffA);
            PG8_WAIT_V(8); PG8_WAIT_L(0); PG8_BAR; PG8_MMA(0, 0, At, B0); PG8_MMA(0, 1, At, B1); PG8_BAR; PG8_SCHED;
            PG8_LDA(At, 1, 1); PG8_STAGE(PG8_SB(1, 0), b3, voffB); PG8_STAGE(PG8_SB(1, 1), b3 + hstep, voffB); PG8_STAGE(PG8_SA(1, 0), a3, voffA);
            PG8_WAIT_V(8); PG8_WAIT_L(0); PG8_BAR; PG8_MMA(1, 0, At, B0); PG8_MMA(1, 1, At, B1); PG8_BAR; PG8_SCHED;
            } else {
            PG8_LDB(B0, 0, 0); PG8_SCHED; PG8_LDA(At, 0, 0); PG8_STAGE(PG8_SA(1, 1), a1 + hstep, voffA);
            PG8_WAIT_L(8); PG8_BAR; PG8_WAIT_L(0); PG8_MMA(0, 0, At, B0); PG8_BAR; PG8_SCHED;
            PG8_LDB(B1, 0, 1); PG8_STAGE(PG8_SB(0, 0), b2, voffB);
            PG8_BAR; PG8_WAIT_L(0); PG8_MMA(0, 1, At, B1); PG8_BAR;
            PG8_LDA(At, 0, 1); PG8_STAGE(PG8_SA(0, 0), a2, voffA);
            PG8_BAR; PG8_WAIT_L(0); PG8_MMA(1, 0, At, B0); PG8_BAR; PG8_SCHED;
            PG8_STAGE(PG8_SB(0, 1), b2 + hstep, voffB);
            PG8_WAIT_V(6); PG8_BAR; PG8_MMA(1, 1, At, B1); PG8_BAR;
            PG8_LDB(B0, 1, 0); PG8_SCHED; PG8_LDA(At, 1, 0); PG8_STAGE(PG8_SA(0, 1), a2 + hstep, voffA);
            PG8_WAIT_L(8); PG8_BAR; PG8_WAIT_L(0); PG8_MMA(0, 0, At, B0); PG8_BAR; PG8_SCHED;
            PG8_LDB(B1, 1, 1); PG8_STAGE(PG8_SB(1, 0), b3, voffB);
            PG8_BAR; PG8_WAIT_L(0); PG8_MMA(0, 1, At, B1); PG8_BAR;
            PG8_LDA(At, 1, 1); PG8_STAGE(PG8_SA(1, 0), a3, voffA);
            PG8_BAR; PG8_WAIT_L(0); PG8_MMA(1, 0, At, B0); PG8_BAR; PG8_SCHED;
            PG8_STAGE(PG8_SB(1, 1), b3 + hstep, voffB);
            PG8_WAIT_V(6); PG8_BAR; PG8_MMA(1, 1, At, B1); PG8_BAR;
            }
        }
        if constexpr (ALIGN_EPI) { if (wr == 0) PG8_BAR; }
        if constexpr (!Epi::AFTER_DRAIN) { E(acc, cur, wr, wc, fr, fq); S.done(cur); }
        if (!has_next) break;
#pragma unroll
        for (int a = 0; a < 2; ++a)
#pragma unroll
            for (int b = 0; b < 2; ++b)
#pragma unroll
                for (int m = 0; m < 4; ++m)
#pragma unroll
                    for (int n = 0; n < 2; ++n) acc[a][b][m][n] = (f32x4){0.f, 0.f, 0.f, 0.f};
        cur = nxt; cA = nA; cB = nB; ++ui;
        if constexpr (ALIGN_EPI) { if (wr == 1) PG8_BAR; }
    }
    PG8_WAIT_V(0);
    if constexpr (!ALIGN_EPI) { if (wr == 0) PG8_BAR; }
    PG8_BAR;
    if constexpr (Epi::AFTER_DRAIN) { E.fused(acc, cur, wr, wc, fr, fq, lds, wid, lane); S.done(cur); }
#undef PG8_SA
#undef PG8_SB
#undef PG8_STAGE
#undef PG8_LDA
#undef PG8_LDB
#undef PG8_MMA
#undef PG8_WAIT_V
#undef PG8_WAIT_L
#undef PG8_BAR
#undef PG8_SCHED
}
template <class Epi, class Sched>
__device__ __forceinline__ void gemm_phase_x(PG8_LAS unsigned char* lds, const Gemm g, const int Mx, const Sched& S, const Epi& E) {
    const int tid = threadIdx.x, wid = __builtin_amdgcn_readfirstlane(tid >> 6), lane = tid & 63, wr = wid >> 2, wc = wid & 3, fr = lane & 15, fq = lane >> 4;
    const int K = g.K, nt = K / BK;
    unsigned voffA, voffB, voffE;
    { int R, C; stage_rc(tid * 16, R, C); const int Rb = Epi::PERM ? ((R & ~31) + perm32(R & 31)) : R;
        voffA = (unsigned)(R * K + C) * 2u; voffB = (unsigned)(Rb * K + C) * 2u; }
    { const int b = tid * 4; int R, C; stage_rc(b & ~15, R, C); C += (b & 15) >> 1; voffE = (unsigned)(R * K + C) * 2u; }
    const size_t kstep = (size_t)(BK * 2);
    const size_t hstep = (size_t)HALF * K * 2;
    const size_t tstep = 2 * hstep;
    const size_t qstep = (size_t)64 * K * 2;
    const size_t estep = (size_t)16 * K * 2;
    const unsigned ldsw = (unsigned)wid * 1024u;
    const int aoff = lds_byte(wr * 64 + fr, fq * 8), boff = lds_byte(wc * 32 + fr, fq * 8), eoff = lds_byte(fr, fq * 8);
    constexpr int ES0 = 135168;
#define PG8_SA(b, h) (((b) * 2 + (h)) * HTB)
#define PG8_SB(b, h) ((4 + (b) * 2 + (h)) * HTB)
#define PG8_STAGE(bufoff, gbase, voff) do { _Pragma("unroll") for (int _i = 0; _i < 2; ++_i) \
        __builtin_amdgcn_global_load_lds((const unsigned*)((const char*)(gbase) + (size_t)_i * qstep + (voff)), (PG8_LAS unsigned*)(lds + (bufoff) + ldsw + _i * 8192), 16, 0, 0); } while (0)
#define PG8_STAGE_E(b, gbase) __builtin_amdgcn_global_load_lds((const unsigned*)((const char*)(gbase) + voffE), (PG8_LAS unsigned*)(lds + ES0 + (b) * 2048 + wid * 256), 4, 0, 0)
#define PG8_LDA(dst, b, h) do { _Pragma("unroll") for (int m = 0; m < 4; ++m) _Pragma("unroll") for (int k = 0; k < 2; ++k) dst[m][k] = *(const PG8_LAS bf16x8*)(lds + PG8_SA(b, h) + aoff + m * 2048 + k * 1024); } while (0)
#define PG8_LDB(dst, b, h) do { _Pragma("unroll") for (int n = 0; n < 2; ++n) _Pragma("unroll") for (int k = 0; k < 2; ++k) dst[n][k] = *(const PG8_LAS bf16x8*)(lds + PG8_SB(b, h) + boff + n * 2048 + k * 1024); } while (0)
#define PG8_LDE(dst, b) do { _Pragma("unroll") for (int k = 0; k < 2; ++k) dst[k] = *(const PG8_LAS bf16x8*)(lds + ES0 + (b) * 2048 + eoff + k * 1024); } while (0)
#define PG8_MMA(ai, bj, At, Bt) do { __builtin_amdgcn_s_setprio(1); _Pragma("unroll") for (int m = 0; m < 4; ++m) _Pragma("unroll") for (int n = 0; n < 2; ++n) _Pragma("unroll") for (int k = 0; k < 2; ++k) \
        acc[ai][bj][m][n] = __builtin_amdgcn_mfma_f32_16x16x32_bf16(Bt[n][k], At[m][k], acc[ai][bj][m][n], 0, 0, 0); __builtin_amdgcn_s_setprio(0); } while (0)
#define PG8_MMA_E(Bt) do { _Pragma("unroll") for (int n = 0; n < 2; ++n) _Pragma("unroll") for (int k = 0; k < 2; ++k) accE[n] = __builtin_amdgcn_mfma_f32_16x16x32_bf16(Bt[n][k], Et[k], accE[n], 0, 0, 0); } while (0)
#define PG8_WAIT_V(n) asm volatile("s_waitcnt vmcnt(" #n ")" ::: "memory")
#define PG8_WAIT_L(n) asm volatile("s_waitcnt lgkmcnt(" #n ")" ::: "memory")
#define PG8_BAR __builtin_amdgcn_s_barrier()
#define PG8_SCHED __builtin_amdgcn_sched_barrier(0)
    Unit cur, nxt; int ui = 0;
    if (!S.next(0, cur)) return;
    f32x4 acc[2][2][4][2], accE[2];
#pragma unroll
    for (int a = 0; a < 2; ++a)
#pragma unroll
        for (int b = 0; b < 2; ++b)
#pragma unroll
            for (int m = 0; m < 4; ++m)
#pragma unroll
                for (int n = 0; n < 2; ++n) acc[a][b][m][n] = (f32x4){0.f, 0.f, 0.f, 0.f};
    accE[0] = (f32x4){0.f, 0.f, 0.f, 0.f}; accE[1] = accE[0];
    bf16x8 At[4][2], B0[2][2], B1[2][2], Et[2];
    const char* cA = (const char*)g.A + (size_t)cur.pm * tstep; const char* cB = (const char*)g.Bt + (size_t)cur.pn * tstep;
    const char* cE = (const char*)g.A + (size_t)Mx * K * 2 + (size_t)cur.pm * estep;
    S.a_ready(cur);
    PG8_STAGE(PG8_SB(0, 0), cB, voffB); PG8_STAGE(PG8_SB(0, 1), cB + hstep, voffB); PG8_STAGE(PG8_SA(0, 0), cA, voffA); PG8_STAGE_E(0, cE); PG8_STAGE(PG8_SA(0, 1), cA + hstep, voffA);
    if (wr == 1) PG8_BAR;
    PG8_WAIT_V(2); PG8_BAR;
    PG8_STAGE(PG8_SB(1, 0), cB + kstep, voffB); PG8_STAGE(PG8_SA(1, 0), cA + kstep, voffA); PG8_STAGE(PG8_SB(1, 1), cB + hstep + kstep, voffB);
    PG8_WAIT_V(6); PG8_BAR;
    for (;;) {
        const bool has_next = S.next(ui + 1, nxt);
        const char* nA = has_next ? (const char*)g.A + (size_t)nxt.pm * tstep : cA; const char* nB = has_next ? (const char*)g.Bt + (size_t)nxt.pn * tstep : cB;
        const char* nE = has_next ? (const char*)g.A + (size_t)Mx * K * 2 + (size_t)nxt.pm * estep : cE;
        for (int t = 0; t < nt; t += 2) {
            const bool last = (t == nt - 2);
            const char* a1 = cA + (size_t)(t + 1) * kstep;
            const char* a2 = last ? nA : cA + (size_t)(t + 2) * kstep; const char* b2 = last ? nB : cB + (size_t)(t + 2) * kstep; const char* e2 = last ? nE : cE + (size_t)(t + 2) * kstep;
            const char* a3 = a2 + kstep; const char* b3 = b2 + kstep; const char* e1 = cE + (size_t)(t + 1) * kstep;
            if (last && has_next) S.a_ready(nxt);
            PG8_LDB(B0, 0, 0); PG8_LDB(B1, 0, 1); PG8_SCHED; PG8_LDA(At, 0, 0); PG8_STAGE_E(1, e1); PG8_STAGE(PG8_SA(1, 1), a1 + hstep, voffA);
            PG8_WAIT_V(9); PG8_WAIT_L(0); PG8_BAR; PG8_MMA(0, 0, At, B0); PG8_MMA(0, 1, At, B1); PG8_SCHED; PG8_LDE(Et, 0); PG8_WAIT_L(0); if (wr == 0) PG8_MMA_E(B0); else PG8_MMA_E(B1); PG8_BAR; PG8_SCHED;
            PG8_LDA(At, 0, 1); PG8_STAGE(PG8_SB(0, 0), b2, voffB); PG8_STAGE(PG8_SB(0, 1), b2 + hstep, voffB); PG8_STAGE(PG8_SA(0, 0), a2, voffA);
            PG8_WAIT_V(8); PG8_WAIT_L(0); PG8_BAR; PG8_MMA(1, 0, At, B0); PG8_MMA(1, 1, At, B1); PG8_BAR; PG8_SCHED;
            PG8_LDB(B0, 1, 0); PG8_LDB(B1, 1, 1); PG8_SCHED; PG8_LDA(At, 1, 0); PG8_STAGE_E(0, e2); PG8_STAGE(PG8_SA(0, 1), a2 + hstep, voffA);
            PG8_WAIT_V(9); PG8_WAIT_L(0); PG8_BAR; PG8_MMA(0, 0, At, B0); PG8_MMA(0, 1, At, B1); PG8_SCHED; PG8_LDE(Et, 1); PG8_WAIT_L(0); if (wr == 0) PG8_MMA_E(B0); else PG8_MMA_E(B1); PG8_BAR; PG8_SCHED;
            PG8_LDA(At, 1, 1); PG8_STAGE(PG8_SB(1, 0), b3, voffB); PG8_STAGE(PG8_SB(1, 1), b3 + hstep, voffB); PG8_STAGE(PG8_SA(1, 0), a3, voffA);
            PG8_WAIT_V(8); PG8_WAIT_L(0); PG8_BAR; PG8_MMA(1, 0, At, B0); PG8_MMA(1, 1, At, B1); PG8_BAR; PG8_SCHED;
        }
        if (wr == 0) PG8_BAR;
        E(acc, cur, wr, wc, fr, fq); E.extra(accE, cur, wr, wc, fr, fq); S.done(cur);
        if (!has_next) break;
#pragma unroll
        for (int a = 0; a < 2; ++a)
#pragma unroll
            for (int b = 0; b < 2; ++b)
#pragma unroll
                for (int m = 0; m < 4; ++m)
#pragma unroll
                    for (int n = 0; n < 2; ++n) acc[a][b][m][n] = (f32x4){0.f, 0.f, 0.f, 0.f};
        accE[0] = (f32x4){0.f, 0.f, 0.f, 0.f}; accE[1] = accE[0];
        cur = nxt; cA = nA; cB = nB; cE = nE; ++ui;
        if (wr == 1) PG8_BAR;
    }
    PG8_WAIT_V(0);
    PG8_BAR;
#undef PG8_SA
#undef PG8_SB
#undef PG8_STAGE
#undef PG8_STAGE_E
#undef PG8_LDA
#undef PG8_LDB
#undef PG8_LDE
#undef PG8_MMA
#undef PG8_MMA_E
#undef PG8_WAIT_V
#undef PG8_WAIT_L
#undef PG8_BAR
#undef PG8_SCHED
}
}
constexpr int NWAVES = 8;
#ifndef MK_N_LAUNCHES
#define MK_N_LAUNCHES 1
#endif
constexpr int N_PHASES = 12;
constexpr int MROWS = 17408, MP = 16384, DM = 1024, DFF = 4096, NIN1 = 3088, NIN1P = 3328;
constexpr size_t MiB = 1u << 20;
constexpr size_t WS_CTL = 0, CTL_ZERO_BYTES = 1 * MiB;
constexpr size_t WS_SS = 128 * 1024;
constexpr size_t WS_LB = 1 * MiB;
constexpr size_t WS_WIN0 = 2 * MiB, WS_WOUT0 = 10 * MiB, WS_WUP0 = 12 * MiB, WS_WDN0 = 20 * MiB, WS_WIN1 = 28 * MiB, WS_WOUT1 = 35 * MiB, WS_WUP1 = 37 * MiB, WS_WDN1 = 45 * MiB;
constexpr size_t WS_XB = 53 * MiB;
constexpr size_t WS_ACT = 87 * MiB;
constexpr size_t ACT_T = (size_t)MROWS * 1024 * 2;
constexpr size_t WS_Q = WS_ACT, WS_LF = WS_ACT + ACT_T, WS_V = WS_ACT + 2 * ACT_T, WS_G = WS_ACT + 3 * ACT_T;
constexpr size_t WS_QM = WS_ACT, WS_KM = WS_ACT + ACT_T / 2, WS_VM = WS_ACT + ACT_T, WS_OM = WS_ACT + 2 * ACT_T, WS_GT = WS_ACT + 3 * ACT_T;
constexpr size_t WS_END = WS_ACT + 4 * ACT_T;
static_assert(WS_END <= 224 * MiB, "d_ws map");
constexpr int CW_BAR = 4096;
constexpr size_t OUT_Y = 0, OUT_SP = 17825792, OUT_CP = 18874368, OUT_NP = 19398656, OUT_MP = 19402752, OUT_SS = 19402816, OUT_CS = 36180032, OUT_NS = 44568640, OUT_MS = 44634176, OUT_END = 44635200;
constexpr int RING_BYTES = 131072, LDSCTL_OFF = RING_BYTES, MISC_OFF = LDSCTL_OFF + 320, LDS_BYTES = 147456;

#define GAS __attribute__((address_space(1)))
#define LAS __attribute__((address_space(3)))
typedef unsigned short bf16;
typedef unsigned v4u __attribute__((ext_vector_type(4)));
typedef unsigned v2u __attribute__((ext_vector_type(2)));
typedef float f32x4 __attribute__((ext_vector_type(4)));
typedef float f32x2 __attribute__((ext_vector_type(2)));
typedef short bf16x8 __attribute__((ext_vector_type(8)));
typedef GAS unsigned gu32;
#define RLX_AGENT __ATOMIC_RELAXED, __HIP_MEMORY_SCOPE_AGENT
#define LDS_WAIT() asm volatile("s_waitcnt lgkmcnt(0)" ::: "memory")
#define VM_WAIT() asm volatile("s_waitcnt vmcnt(0)" ::: "memory")
__device__ __forceinline__ unsigned f2bf(float f) { unsigned u = __builtin_bit_cast(unsigned, f); return (u + 0x7fffu + ((u >> 16) & 1u)) >> 16; }
typedef __bf16 bf16x2c __attribute__((ext_vector_type(2)));
__device__ __forceinline__ unsigned pk2(float lo, float hi) { f32x2 v = {lo, hi}; bf16x2c b = __builtin_convertvector(v, bf16x2c); return __builtin_bit_cast(unsigned, b); }
__device__ __forceinline__ float bflo(unsigned w) { return __builtin_bit_cast(float, w << 16); }
__device__ __forceinline__ float bfhi(unsigned w) { return __builtin_bit_cast(float, w & 0xffff0000u); }
__device__ __forceinline__ float bf1(unsigned short h) { return __builtin_bit_cast(float, (unsigned)h << 16); }
__device__ __forceinline__ float hlo(unsigned w) { return (float)__builtin_bit_cast(_Float16, (unsigned short)(w & 0xffffu)); }
__device__ __forceinline__ float hhi(unsigned w) { return (float)__builtin_bit_cast(_Float16, (unsigned short)(w >> 16)); }
__device__ __forceinline__ float h1(unsigned short h) { return (float)__builtin_bit_cast(_Float16, h); }

#define XB_TMO      128
#define XB_XCNT(j)  (256  + 64 * (j))
#define XB_XSUB(j)  (1280 + 64 * (j))
#define XB_XGEN(j)  (2304 + 64 * (j))
#define XB_TOP      3328
#define XB_TOPGEN   3392
#define XCD_BAR_WORDS 3456
#define XB_SPIN_CAP (1u << 18)
__device__ __forceinline__ unsigned xb_ld(unsigned* p)              { return __hip_atomic_load(p, __ATOMIC_RELAXED, __HIP_MEMORY_SCOPE_AGENT); }
__device__ __forceinline__ unsigned xb_add(unsigned* p, unsigned v) { return __hip_atomic_fetch_add(p, v, __ATOMIC_RELAXED, __HIP_MEMORY_SCOPE_AGENT); }
__device__ __forceinline__ unsigned xb_xcc_id() { return (unsigned)__builtin_amdgcn_s_getreg((3 << 11) | 20) & 0xFu; }
#define XB_SPIN(cond, bar) do { unsigned _sp = 0; while (cond) { __builtin_amdgcn_s_sleep(1); \
    if ((++_sp & 255u) == 0u) { if (xb_ld(&(bar)[XB_TMO])) break; if (_sp > XB_SPIN_CAP) { atomicAdd(&(bar)[XB_TMO], 1u); break; } } } } while (0)
struct XcdBarrier { unsigned* bar; unsigned x; volatile LAS unsigned* st; };
__device__ __forceinline__ XcdBarrier xcd_barrier_post(unsigned* bar, volatile LAS unsigned* st) {
    XcdBarrier b; b.bar = bar; b.x = xb_xcc_id(); b.st = st;
    if (threadIdx.x == 0) (void)xb_add(&bar[XB_XCNT(b.x)], 1u);
    return b;
}
__device__ __forceinline__ void xcd_barrier_complete(unsigned* bar, unsigned x, unsigned& nloc, unsigned& nx) {
    const unsigned G = gridDim.x * gridDim.y * gridDim.z;
    unsigned sum, cnt, mine, sp = 0u;
    for (;;) {
        sum = 0u; cnt = 0u; mine = 0u;
#pragma unroll
        for (unsigned j = 0; j < 16; ++j) { const unsigned c = xb_ld(&bar[XB_XCNT(j)]); sum += c; cnt += (c > 0u) ? 1u : 0u; mine = (j == x) ? c : mine; }
        if (sum == G) break;
        __builtin_amdgcn_s_sleep(1);
        if ((++sp & 255u) == 0u) { if (xb_ld(&bar[XB_TMO])) break; if (sp > XB_SPIN_CAP) { atomicAdd(&bar[XB_TMO], 1u); break; } }
    }
    nloc = mine > 0u ? mine : 1u; nx = cnt > 0u ? cnt : 1u;
}
__device__ __forceinline__ void xcd_barrier(const XcdBarrier& b) {
    asm volatile("s_waitcnt vmcnt(0)" ::: "memory");
    __syncthreads();
    if (threadIdx.x == 0) {
        unsigned* bar = b.bar;
        __builtin_amdgcn_s_waitcnt(0);
        unsigned nloc = b.st[0], nx = b.st[1];
        if (nloc == 0u) { xcd_barrier_complete(bar, b.x, nloc, nx); b.st[0] = nloc; b.st[1] = nx; }
        const unsigned old = xb_add(&bar[XB_XSUB(b.x)], 1u);
        const unsigned gen = old / nloc;
        if (old + 1u == (gen + 1u) * nloc) {
            __builtin_amdgcn_fence(__ATOMIC_RELEASE, "agent");
            asm volatile("s_waitcnt vmcnt(0)" ::: "memory");
            const unsigned og = xb_add(&bar[XB_TOP], 1u);
            const unsigned tg = og / nx;
            if (og + 1u == (tg + 1u) * nx) xb_add(&bar[XB_TOPGEN], 1u);
            else XB_SPIN(xb_ld(&bar[XB_TOPGEN]) == tg, bar);
            __builtin_amdgcn_fence(__ATOMIC_ACQUIRE, "agent");
            xb_add(&bar[XB_XGEN(b.x)], 1u);
            asm volatile("s_waitcnt vmcnt(0)" ::: "memory");
        } else {
            XB_SPIN(xb_ld(&bar[XB_XGEN(b.x)]) == gen, bar);
            __builtin_amdgcn_fence(__ATOMIC_ACQUIRE, "agent");
            asm volatile("s_waitcnt vmcnt(0)" ::: "memory");
        }
    }
    __syncthreads();
}

__device__ __forceinline__ float wave_sum(float v) {
#pragma unroll
    for (int o = 1; o < 64; o <<= 1) v += __shfl_xor(v, o);
    return v;
}
__device__ __forceinline__ void p0_transpose_item(const float* W, int K, int N, const float* sc, bf16* WT, LAS float* scr, int item, int lane) {
    const int nblk = (N + 31) / 32, kb = item / nblk, nb = item % nblk, k0 = 64 * kb, n0 = 32 * nb;
    const bool nok = (n0 + (lane & 31)) < N;
#pragma unroll 8
    for (int i = 0; i < 32; ++i) { const int kk = 2 * i + (lane >> 5); float v = nok ? W[(size_t)(k0 + kk) * N + n0 + (lane & 31)] : 0.f; if (sc) v *= sc[k0 + kk]; scr[kk * 33 + (lane & 31)] = v; }
    LDS_WAIT(); asm volatile("" ::: "memory");
    const int c = lane & 7;
#pragma unroll
    for (int j = 0; j < 4; ++j) { const int n = (lane >> 3) + 8 * j; const LAS float* s = scr + (8 * c) * 33 + n;
        v4u o; o.x = pk2(s[0 * 33], s[1 * 33]); o.y = pk2(s[2 * 33], s[3 * 33]); o.z = pk2(s[4 * 33], s[5 * 33]); o.w = pk2(s[6 * 33], s[7 * 33]);
        *(GAS v4u*)(WT + (size_t)(n0 + n) * K + k0 + 8 * c) = o; }
    LDS_WAIT(); asm volatile("" ::: "memory");
}
#define MFMA16(a, b, c) __builtin_amdgcn_mfma_f32_16x16x32_bf16((a), (b), (c), 0, 0, 0)
#define LDSV(T, off) (*(LAS T*)(lds + (off)))
#define LDSF(off) (*(const LAS bf16x8*)(lds + (off)))
#define BAR_LDS() do { asm volatile("s_waitcnt lgkmcnt(0)" ::: "memory"); __builtin_amdgcn_s_barrier(); asm volatile("" ::: "memory"); } while (0)
namespace hg {
constexpr int QP = 0, KP = QP + 64 * 272, KPPT = KP + 64 * 272, VT = KPPT + 128 * 144, AM = VT + 128 * 144, ST = AM + 64 * 144, GT = ST + 128 * 272, DEC = GT + 8 * 128 * 4, NP = DEC + 512, END = NP + 512;
static_assert(END <= RING_BYTES, "hgrn LDS");
}
__device__ __forceinline__ void hgrn_prompt_item(LAS unsigned char* lds, int b, int h, const bf16* Qb, const bf16* LFb, const bf16* Vb, const bf16* Gb, bf16* Ob, const float* onw, float* S_out) {
    using namespace hg;
    const int tid = threadIdx.x, lane = tid & 63, w = __builtin_amdgcn_readfirstlane(tid >> 6), fr = lane & 15, fq = lane >> 4;
    const int tb = w & 3, wh = w >> 2;
    const size_t rowb = (size_t)b * 2048;
    const int colp = h * 128 + 2 * lane;
    __syncthreads();
    for (int i = tid; i < 128 * 272 / 4; i += 512) LDSV(unsigned, ST + 4 * i) = 0u;
    __syncthreads();
    f32x4 sacc[8];
#pragma unroll
    for (int j = 0; j < 8; ++j) sacc[j] = (f32x4){0.f, 0.f, 0.f, 0.f};
    f32x4 wn[4];
#pragma unroll
    for (int j = 0; j < 4; ++j) wn[j] = *(const f32x4*)(onw + h * 128 + (4 * wh + j) * 16 + 4 * fq);
    unsigned rq[8], rl[8], rv[8];
#pragma unroll
    for (int i = 0; i < 8; ++i) { const size_t e = (rowb + 8 * w + i) * 1024 + colp; rq[i] = *(const unsigned*)(Qb + e); rl[i] = *(const unsigned*)(LFb + e); rv[i] = *(const unsigned*)(Vb + e); }
    for (int c = 0; c < 32; ++c) {
        float c0[8], c1[8]; { float a0 = 0.f, a1 = 0.f;
#pragma unroll
            for (int i = 0; i < 8; ++i) { a0 += hlo(rl[i]); a1 += hhi(rl[i]); c0[i] = a0; c1[i] = a1; }
            LDSV(f32x2, GT + (w * 128 + 2 * lane) * 4) = (f32x2){a0, a1}; }
        BAR_LDS();
        float pre0 = 0.f, pre1 = 0.f, tot0 = 0.f, tot1 = 0.f;
#pragma unroll
        for (int g = 0; g < 8; ++g) { const f32x2 x = LDSV(f32x2, GT + (g * 128 + 2 * lane) * 4); tot0 += x.x; tot1 += x.y; if (g < w) { pre0 += x.x; pre1 += x.y; } }
        if (w == 0) LDSV(f32x2, DEC + 2 * lane * 4) = (f32x2){__expf(tot0), __expf(tot1)};
        { unsigned kk0[4], kk1[4], vv0[4], vv1[4]; float pk0 = 0.f, pk1 = 0.f;
#pragma unroll
            for (int i = 0; i < 8; ++i) {
                const float b0 = pre0 + c0[i], b1 = pre1 + c1[i];
                const float k0 = 1.0f - __expf(hlo(rl[i])), k1 = 1.0f - __expf(hhi(rl[i]));
                const float e0 = __expf(b0), e1 = __expf(b1), n0 = __expf(-b0), n1 = __expf(-b1), l0 = __expf(tot0 - b0), l1 = __expf(tot1 - b1);
                LDSV(unsigned, QP + (8 * w + i) * 272 + 4 * lane) = pk2(bflo(rq[i]) * e0, bfhi(rq[i]) * e1);
                LDSV(unsigned, KP + (8 * w + i) * 272 + 4 * lane) = pk2(k0 * n0, k1 * n1);
                const float x0 = k0 * l0, x1 = k1 * l1;
                if (i & 1) { kk0[i >> 1] = pk2(pk0, x0); kk1[i >> 1] = pk2(pk1, x1); vv0[i >> 1] = (rv[i - 1] & 0xffffu) | (rv[i] << 16); vv1[i >> 1] = (rv[i - 1] >> 16) | (rv[i] & 0xffff0000u); }
                else { pk0 = x0; pk1 = x1; }
            }
            LDSV(v4u, KPPT + (2 * lane) * 144 + 16 * w) = (v4u){kk0[0], kk0[1], kk0[2], kk0[3]};
            LDSV(v4u, KPPT + (2 * lane + 1) * 144 + 16 * w) = (v4u){kk1[0], kk1[1], kk1[2], kk1[3]};
            LDSV(v4u, VT + (2 * lane) * 144 + 16 * w) = (v4u){vv0[0], vv0[1], vv0[2], vv0[3]};
            LDSV(v4u, VT + (2 * lane + 1) * 144 + 16 * w) = (v4u){vv1[0], vv1[1], vv1[2], vv1[3]}; }
        const size_t orow = (rowb + (size_t)c * 64 + tb * 16 + fr) * 1024 + h * 128 + 4 * fq;
        v2u rg[4];
#pragma unroll
        for (int j = 0; j < 4; ++j) rg[j] = *(const v2u*)(Gb + orow + (4 * wh + j) * 16);
        if (c + 1 < 32) {
#pragma unroll
            for (int i = 0; i < 8; ++i) { const size_t e = (rowb + (size_t)(c + 1) * 64 + 8 * w + i) * 1024 + colp; rq[i] = *(const unsigned*)(Qb + e); rl[i] = *(const unsigned*)(LFb + e); rv[i] = *(const unsigned*)(Vb + e); }
        }
        BAR_LDS();
#pragma unroll
        for (int j = 0; j < 2; ++j) { const int sb = 2 * wh + j; f32x4 a = (f32x4){0.f, 0.f, 0.f, 0.f};
            if (sb <= tb) {
#pragma unroll
                for (int kk = 0; kk < 4; ++kk) a = MFMA16(LDSF(KP + (sb * 16 + fr) * 272 + kk * 64 + fq * 16), LDSF(QP + (tb * 16 + fr) * 272 + kk * 64 + fq * 16), a);
                const int t = tb * 16 + fr, s0 = sb * 16 + 4 * fq;
#pragma unroll
                for (int r = 0; r < 4; ++r) if (s0 + r > t) a[r] = 0.f;
            }
            LDSV(v2u, AM + (tb * 16 + fr) * 144 + (sb * 16 + 4 * fq) * 2) = (v2u){pk2(a[0], a[1]), pk2(a[2], a[3])}; }
        BAR_LDS();
        f32x4 oacc[4];
        { bf16x8 bA[2], bQ[4];
#pragma unroll
            for (int kk = 0; kk < 2; ++kk) bA[kk] = LDSF(AM + (tb * 16 + fr) * 144 + kk * 64 + fq * 16);
#pragma unroll
            for (int kk = 0; kk < 4; ++kk) bQ[kk] = LDSF(QP + (tb * 16 + fr) * 272 + kk * 64 + fq * 16);
#pragma unroll
            for (int j = 0; j < 4; ++j) { const int dvb = 4 * wh + j; f32x4 a = (f32x4){0.f, 0.f, 0.f, 0.f};
#pragma unroll
                for (int kk = 0; kk < 2; ++kk) a = MFMA16(LDSF(VT + (dvb * 16 + fr) * 144 + kk * 64 + fq * 16), bA[kk], a);
#pragma unroll
                for (int kk = 0; kk < 4; ++kk) a = MFMA16(LDSF(ST + (dvb * 16 + fr) * 272 + kk * 64 + fq * 16), bQ[kk], a);
                oacc[j] = a; } }
        { float ss = 0.f;
#pragma unroll
            for (int j = 0; j < 4; ++j) ss += (oacc[j][0] * oacc[j][0] + oacc[j][1] * oacc[j][1]) + (oacc[j][2] * oacc[j][2] + oacc[j][3] * oacc[j][3]);
            ss += __shfl_xor(ss, 16); ss += __shfl_xor(ss, 32);
            if (fq == 0) LDSV(float, NP + ((tb * 16 + fr) * 2 + wh) * 4) = ss; }
        { const f32x4 dec = LDSV(f32x4, DEC + (16 * w + 4 * fq) * 4); bf16x8 aK[2];
#pragma unroll
            for (int kk = 0; kk < 2; ++kk) aK[kk] = LDSF(KPPT + (16 * w + fr) * 144 + kk * 64 + fq * 16);
#pragma unroll
            for (int j = 0; j < 8; ++j) { f32x4 a = sacc[j] * dec;
#pragma unroll
                for (int kk = 0; kk < 2; ++kk) a = MFMA16(aK[kk], LDSF(VT + (j * 16 + fr) * 144 + kk * 64 + fq * 16), a);
                sacc[j] = a; } }
        BAR_LDS();
        { const f32x2 p = LDSV(f32x2, NP + (tb * 16 + fr) * 8); const float rstd = rsqrtf((p.x + p.y) * (1.0f / 128.0f) + 1e-6f);
#pragma unroll
            for (int j = 0; j < 4; ++j) { const f32x4 o = oacc[j] * rstd * wn[j];
                *(v2u*)(Ob + orow + (4 * wh + j) * 16) = (v2u){pk2(o[0] * bflo(rg[j].x), o[1] * bfhi(rg[j].x)), pk2(o[2] * bflo(rg[j].y), o[3] * bfhi(rg[j].y))}; } }
#pragma unroll
        for (int j = 0; j < 8; ++j) LDSV(v2u, ST + (j * 16 + fr) * 272 + (16 * w + 4 * fq) * 2) = (v2u){pk2(sacc[j][0], sacc[j][1]), pk2(sacc[j][2], sacc[j][3])};
    }
    float* so = S_out + (size_t)(b * 8 + h) * 128 * 128;
#pragma unroll
    for (int j = 0; j < 8; ++j)
#pragma unroll
        for (int r = 0; r < 4; ++r) so[(size_t)(16 * w + 4 * fq + r) * 128 + j * 16 + fr] = sacc[j][r];
}
__device__ __forceinline__ void hgrn_sample_item(LAS unsigned char* lds, int b, int h, const bf16* Qb, const bf16* LFb, const bf16* Vb, const bf16* Gb, bf16* Ob, const float* onw, const float* S_in, float* S_out) {
    constexpr int FKQ = 0, VS = 16384, RED = 20480;
    const int tid = threadIdx.x, lane = tid & 63, w = __builtin_amdgcn_readfirstlane(tid >> 6), c4 = tid & 31, dg = tid >> 5;
    const size_t rowb = (size_t)MP + (size_t)b * 8;
    __syncthreads();
#pragma unroll
    for (int e = tid; e < 1024; e += 512) { const int t = e >> 7, d = e & 127; const size_t g = (rowb + t) * 1024 + h * 128 + d;
        const float f = __expf(h1(LFb[g])); LDSV(f32x4, FKQ + e * 16) = (f32x4){f, 1.0f - f, bf1(Qb[g]), 0.f}; LDSV(float, VS + e * 4) = bf1(Vb[g]); }
    const size_t sbase = ((size_t)(b * 8 + h) * 128 + 8 * dg) * 128 + 4 * c4;
    f32x4 s[8], po[8];
#pragma unroll
    for (int i = 0; i < 8; ++i) s[i] = *(const f32x4*)(S_in + sbase + (size_t)i * 128);
    __syncthreads();
#pragma unroll
    for (int t = 0; t < 8; ++t) { const f32x4 vv = LDSV(f32x4, VS + (t * 128 + 4 * c4) * 4); f32x4 p = (f32x4){0.f, 0.f, 0.f, 0.f};
#pragma unroll
        for (int i = 0; i < 8; ++i) { const f32x4 x = LDSV(f32x4, FKQ + (t * 128 + 8 * dg + i) * 16); s[i] = s[i] * x[0] + vv * x[1]; p += s[i] * x[2]; }
        po[t] = p; }
#pragma unroll
    for (int t = 0; t < 8; ++t) LDSV(f32x4, RED + ((dg * 8 + t) * 128 + 4 * c4) * 4) = po[t];
#pragma unroll
    for (int i = 0; i < 8; ++i) *(f32x4*)(S_out + sbase + (size_t)i * 128) = s[i];
    __syncthreads();
    { const int t = w; float o0 = 0.f, o1 = 0.f;
#pragma unroll
        for (int g = 0; g < 16; ++g) { const f32x2 x = LDSV(f32x2, RED + ((g * 8 + t) * 128 + 2 * lane) * 4); o0 += x.x; o1 += x.y; }
        const float rstd = rsqrtf(wave_sum(o0 * o0 + o1 * o1) * (1.0f / 128.0f) + 1e-6f);
        const size_t g = (rowb + t) * 1024 + h * 128 + 2 * lane; const unsigned gg = *(const unsigned*)(Gb + g);
        *(unsigned*)(Ob + g) = pk2(o0 * rstd * onw[h * 128 + 2 * lane] * bflo(gg), o1 * rstd * onw[h * 128 + 2 * lane + 1] * bfhi(gg)); }
}
namespace ml {
constexpr int Q = 0, K = Q + 64 * 144, KWT = K + 64 * 144, AM = KWT + 64 * 144, VTE = AM + 64 * 144, CTE = VTE + 144 * 144, AS = CTE + 144 * 144, MT = AS + 256, WI = MT + 256, EM = WI + 256, WS = EM + 256, DEN = WS + 256, SC = DEN + 256, NP = SC + 16, END = NP + 512;
static_assert(END <= RING_BYTES, "mlstm LDS");
}
__device__ __forceinline__ void mlstm_prompt_item(LAS unsigned char* lds, int b, int h, const bf16* Qm, const bf16* Km, const bf16* Vm, const bf16* Om, const float* GTg, bf16* Hb, const float* onw, float* C_out, float* n_out, float* m_out) {
    using namespace ml;
    const int tid = threadIdx.x, lane = tid & 63, w = __builtin_amdgcn_readfirstlane(tid >> 6), fr = lane & 15, fq = lane >> 4;
    const int tb = w & 3, wh = w >> 2;
    const size_t rowb = (size_t)b * 2048;
    const int dp = tid & 31, tg4 = tid >> 5;
    __syncthreads();
    for (int i = tid; i < 144 * 144 / 4; i += 512) { LDSV(unsigned, CTE + 4 * i) = 0u; const int row = (4 * i) / 144; LDSV(unsigned, VTE + 4 * i) = row == 128 ? 0x3f803f80u : 0u; }
    __syncthreads();
    f32x4 cacc[5];
#pragma unroll
    for (int j = 0; j < 5; ++j) cacc[j] = (f32x4){0.f, 0.f, 0.f, 0.f};
    f32x4 wn[4];
#pragma unroll
    for (int j = 0; j < 4; ++j) wn[j] = *(const f32x4*)(onw + h * 128 + (4 * wh + j) * 16 + 4 * fq);
    float m_prev = 0.f;
    unsigned rq[4], rk[4], rv[8]; float gli = 0.f, glf = 0.f;
#pragma unroll
    for (int i = 0; i < 4; ++i) { const size_t e = (rowb + 4 * tg4 + i) * 512 + h * 64 + 2 * dp; rq[i] = *(const unsigned*)(Qm + e); rk[i] = *(const unsigned*)(Km + e); }
#pragma unroll
    for (int i = 0; i < 8; ++i) rv[i] = *(const unsigned*)(Vm + (rowb + 8 * w + i) * 1024 + h * 128 + 2 * lane);
    if (w == 0) { gli = GTg[(rowb + lane) * 16 + h]; glf = GTg[(rowb + lane) * 16 + 8 + h]; }
    for (int c = 0; c < 32; ++c) {
        if (w == 0) {
            float bs = glf;
#pragma unroll
            for (int o = 1; o < 64; o <<= 1) { const float x = __shfl_up(bs, o); if (lane >= o) bs += x; }
            const float a = gli - bs; float pm = a;
#pragma unroll
            for (int o = 1; o < 64; o <<= 1) { const float x = __shfl_up(pm, o); if (lane >= o) pm = fmaxf(pm, x); }
            const float Mt = fmaxf(m_prev, pm), M63 = __shfl(Mt, 63), b63 = __shfl(bs, 63);
            LDSV(float, AS + 4 * lane) = a; LDSV(float, MT + 4 * lane) = Mt; LDSV(float, WI + 4 * lane) = __expf(m_prev - Mt); LDSV(float, EM + 4 * lane) = __expf(-(bs + Mt)); LDSV(float, WS + 4 * lane) = __expf(a - M63);
            if (lane == 0) { LDSV(float, SC) = __expf(m_prev - M63); LDSV(float, SC + 4) = b63 + M63; }
        }
#pragma unroll
        for (int i = 0; i < 4; ++i) { LDSV(unsigned, Q + (4 * tg4 + i) * 144 + 4 * dp) = rq[i]; LDSV(unsigned, K + (4 * tg4 + i) * 144 + 4 * dp) = rk[i]; }
        LDSV(v4u, VTE + (2 * lane) * 144 + 16 * w) = (v4u){(rv[0] & 0xffffu) | (rv[1] << 16), (rv[2] & 0xffffu) | (rv[3] << 16), (rv[4] & 0xffffu) | (rv[5] << 16), (rv[6] & 0xffffu) | (rv[7] << 16)};
        LDSV(v4u, VTE + (2 * lane + 1) * 144 + 16 * w) = (v4u){(rv[0] >> 16) | (rv[1] & 0xffff0000u), (rv[2] >> 16) | (rv[3] & 0xffff0000u), (rv[4] >> 16) | (rv[5] & 0xffff0000u), (rv[6] >> 16) | (rv[7] & 0xffff0000u)};
        BAR_LDS();
        { const f32x4 ws = LDSV(f32x4, WS + 16 * tg4);
            LDSV(v2u, KWT + (2 * dp) * 144 + 8 * tg4) = (v2u){pk2(bflo(rk[0]) * ws[0], bflo(rk[1]) * ws[1]), pk2(bflo(rk[2]) * ws[2], bflo(rk[3]) * ws[3])};
            LDSV(v2u, KWT + (2 * dp + 1) * 144 + 8 * tg4) = (v2u){pk2(bfhi(rk[0]) * ws[0], bfhi(rk[1]) * ws[1]), pk2(bfhi(rk[2]) * ws[2], bfhi(rk[3]) * ws[3])}; }
        const float wc = LDSV(float, SC), m_next = LDSV(float, SC + 4);
        const size_t orow = (rowb + (size_t)c * 64 + tb * 16 + fr) * 1024 + h * 128 + 4 * fq;
        v2u rg[4];
#pragma unroll
        for (int j = 0; j < 4; ++j) rg[j] = *(const v2u*)(Om + orow + (4 * wh + j) * 16);
        if (c + 1 < 32) { const size_t r1 = rowb + (size_t)(c + 1) * 64;
#pragma unroll
            for (int i = 0; i < 4; ++i) { const size_t e = (r1 + 4 * tg4 + i) * 512 + h * 64 + 2 * dp; rq[i] = *(const unsigned*)(Qm + e); rk[i] = *(const unsigned*)(Km + e); }
#pragma unroll
            for (int i = 0; i < 8; ++i) rv[i] = *(const unsigned*)(Vm + (r1 + 8 * w + i) * 1024 + h * 128 + 2 * lane);
            if (w == 0) { gli = GTg[(r1 + lane) * 16 + h]; glf = GTg[(r1 + lane) * 16 + 8 + h]; }
        }
        BAR_LDS();
        { const float Mt = LDSV(float, MT + (tb * 16 + fr) * 4);
#pragma unroll
            for (int j = 0; j < 2; ++j) { const int sb = 2 * wh + j; f32x4 a = (f32x4){0.f, 0.f, 0.f, 0.f};
                if (sb <= tb) {
#pragma unroll
                    for (int kk = 0; kk < 2; ++kk) a = MFMA16(LDSF(K + (sb * 16 + fr) * 144 + kk * 64 + fq * 16), LDSF(Q + (tb * 16 + fr) * 144 + kk * 64 + fq * 16), a);
                    const int t = tb * 16 + fr, s0 = sb * 16 + 4 * fq; const f32x4 as = LDSV(f32x4, AS + s0 * 4);
#pragma unroll
                    for (int r = 0; r < 4; ++r) a[r] = (s0 + r > t) ? 0.f : a[r] * __expf(as[r] - Mt);
                }
                LDSV(v2u, AM + (tb * 16 + fr) * 144 + (sb * 16 + 4 * fq) * 2) = (v2u){pk2(a[0], a[1]), pk2(a[2], a[3])}; } }
        BAR_LDS();
        f32x4 num[5];
        { bf16x8 bA[2], bQ[2]; const float wi = LDSV(float, WI + (tb * 16 + fr) * 4);
#pragma unroll
            for (int kk = 0; kk < 2; ++kk) { bA[kk] = LDSF(AM + (tb * 16 + fr) * 144 + kk * 64 + fq * 16); bQ[kk] = LDSF(Q + (tb * 16 + fr) * 144 + kk * 64 + fq * 16); }
#pragma unroll
            for (int j = 0; j < 5; ++j) { if (j == 4 && wh != 0) break; const int dvb = j == 4 ? 8 : 4 * wh + j; f32x4 a1 = (f32x4){0.f, 0.f, 0.f, 0.f}, a2 = a1;
#pragma unroll
                for (int kk = 0; kk < 2; ++kk) { a1 = MFMA16(LDSF(VTE + (dvb * 16 + fr) * 144 + kk * 64 + fq * 16), bA[kk], a1); a2 = MFMA16(LDSF(CTE + (dvb * 16 + fr) * 144 + kk * 64 + fq * 16), bQ[kk], a2); }
                num[j] = a1 + a2 * wi; }
            if (wh == 0 && fq == 0) LDSV(float, DEN + (tb * 16 + fr) * 4) = num[4][0]; }
        { bf16x8 aK[2];
#pragma unroll
            for (int kk = 0; kk < 2; ++kk) aK[kk] = LDSF(KWT + (16 * tb + fr) * 144 + kk * 64 + fq * 16);
#pragma unroll
            for (int j = 0; j < 5; ++j) { if (j == 4 && wh != 0) break; const int dvb = j == 4 ? 8 : 4 * wh + j; f32x4 a = cacc[j] * wc;
#pragma unroll
                for (int kk = 0; kk < 2; ++kk) a = MFMA16(aK[kk], LDSF(VTE + (dvb * 16 + fr) * 144 + kk * 64 + fq * 16), a);
                cacc[j] = a; } }
        BAR_LDS();
        { const float dn = fmaxf(fabsf(LDSV(float, DEN + (tb * 16 + fr) * 4)), LDSV(float, EM + (tb * 16 + fr) * 4)); const float inv = 1.0f / dn; float ss = 0.f;
#pragma unroll
            for (int j = 0; j < 4; ++j) { num[j] = num[j] * inv; ss += (num[j][0] * num[j][0] + num[j][1] * num[j][1]) + (num[j][2] * num[j][2] + num[j][3] * num[j][3]); }
            ss += __shfl_xor(ss, 16); ss += __shfl_xor(ss, 32);
            if (fq == 0) LDSV(float, NP + ((tb * 16 + fr) * 2 + wh) * 4) = ss; }
        BAR_LDS();
        { const f32x2 p = LDSV(f32x2, NP + (tb * 16 + fr) * 8); const float rstd = rsqrtf((p.x + p.y) * (1.0f / 128.0f) + 1e-6f);
#pragma unroll
            for (int j = 0; j < 4; ++j) { const f32x4 o = num[j] * rstd * wn[j];
                *(v2u*)(Hb + orow + (4 * wh + j) * 16) = (v2u){pk2(o[0] * bflo(rg[j].x), o[1] * bfhi(rg[j].x)), pk2(o[2] * bflo(rg[j].y), o[3] * bfhi(rg[j].y))}; } }
#pragma unroll
        for (int j = 0; j < 5; ++j) { if (j == 4 && wh != 0) break; const int dvb = j == 4 ? 8 : 4 * wh + j;
            LDSV(v2u, CTE + (dvb * 16 + fr) * 144 + (16 * tb + 4 * fq) * 2) = (v2u){pk2(cacc[j][0], cacc[j][1]), pk2(cacc[j][2], cacc[j][3])}; }
        m_prev = m_next;
    }
    float* co = C_out + (size_t)(b * 8 + h) * 64 * 128;
#pragma unroll
    for (int j = 0; j < 4; ++j)
#pragma unroll
        for (int r = 0; r < 4; ++r) co[(size_t)(16 * tb + 4 * fq + r) * 128 + (4 * wh + j) * 16 + fr] = cacc[j][r];
    if (wh == 0 && fr == 0) {
#pragma unroll
        for (int r = 0; r < 4; ++r) n_out[(size_t)(b * 8 + h) * 64 + 16 * tb + 4 * fq + r] = cacc[4][r]; }
    if (tid == 0) m_out[b * 8 + h] = m_prev;
}
__device__ __forceinline__ void mlstm_sample_item(LAS unsigned char* lds, int b, int h, const bf16* Qm, const bf16* Km, const bf16* Vm, const bf16* Om, const float* GTg, bf16* Hb, const float* onw,
                                                  const float* C_in, const float* n_in, const float* m_in, float* C_out, float* n_out, float* m_out) {
    constexpr int KQ = 0, VS = 4096, SCL = 8192, DENR = 8320, RED = 20480;
    const int tid = threadIdx.x, lane = tid & 63, w = __builtin_amdgcn_readfirstlane(tid >> 6), c4 = tid & 31, dg = tid >> 5;
    const size_t rowb = (size_t)MP + (size_t)b * 8;
    __syncthreads();
    { const int t = tid >> 6, d = tid & 63; const size_t g = (rowb + t) * 512 + h * 64 + d; LDSV(f32x2, KQ + tid * 8) = (f32x2){bf1(Km[g]), bf1(Qm[g])}; }
#pragma unroll
    for (int e = tid; e < 1024; e += 512) { const int t = e >> 7, d = e & 127; LDSV(float, VS + e * 4) = bf1(Vm[(rowb + t) * 1024 + h * 128 + d]); }
    if (tid == 0) { float m = m_in[b * 8 + h];
        for (int t = 0; t < 8; ++t) { const float li = GTg[(rowb + t) * 16 + h], lf = GTg[(rowb + t) * 16 + 8 + h]; const float mn = fmaxf(lf + m, li);
            LDSV(f32x4, SCL + t * 16) = (f32x4){__expf(lf + m - mn), __expf(li - mn), __expf(-mn), 0.f}; m = mn; }
        m_out[b * 8 + h] = m; }
    const size_t cbase = ((size_t)(b * 8 + h) * 64 + 4 * dg) * 128 + 4 * c4;
    f32x4 cc[4], pn[8]; float nn[4], pd[8];
#pragma unroll
    for (int i = 0; i < 4; ++i) { cc[i] = *(const f32x4*)(C_in + cbase + (size_t)i * 128); nn[i] = n_in[(size_t)(b * 8 + h) * 64 + 4 * dg + i]; }
    __syncthreads();
#pragma unroll
    for (int t = 0; t < 8; ++t) { const f32x4 vv = LDSV(f32x4, VS + (t * 128 + 4 * c4) * 4); const f32x4 sc = LDSV(f32x4, SCL + t * 16); f32x4 p = (f32x4){0.f, 0.f, 0.f, 0.f}; float d = 0.f;
#pragma unroll
        for (int i = 0; i < 4; ++i) { const f32x2 kq = LDSV(f32x2, KQ + (t * 64 + 4 * dg + i) * 8); const float ik = sc[1] * kq.x;
            cc[i] = cc[i] * sc[0] + vv * ik; p += cc[i] * kq.y; nn[i] = nn[i] * sc[0] + ik; d += nn[i] * kq.y; }
        pn[t] = p; pd[t] = d; }
#pragma unroll
    for (int t = 0; t < 8; ++t) { LDSV(f32x4, RED + ((dg * 8 + t) * 128 + 4 * c4) * 4) = pn[t]; if (c4 == 0) LDSV(float, DENR + (dg * 8 + t) * 4) = pd[t]; }
#pragma unroll
    for (int i = 0; i < 4; ++i) { *(f32x4*)(C_out + cbase + (size_t)i * 128) = cc[i]; if (c4 == 0) n_out[(size_t)(b * 8 + h) * 64 + 4 * dg + i] = nn[i]; }
    __syncthreads();
    { const int t = w; float o0 = 0.f, o1 = 0.f, dn = 0.f;
#pragma unroll
        for (int g = 0; g < 16; ++g) { const f32x2 x = LDSV(f32x2, RED + ((g * 8 + t) * 128 + 2 * lane) * 4); o0 += x.x; o1 += x.y; dn += LDSV(float, DENR + (g * 8 + t) * 4); }
        const float inv = 1.0f / fmaxf(fabsf(dn), LDSV(f32x4, SCL + t * 16)[2]); o0 *= inv; o1 *= inv;
        const float rstd = rsqrtf(wave_sum(o0 * o0 + o1 * o1) * (1.0f / 128.0f) + 1e-6f);
        const size_t g = (rowb + t) * 1024 + h * 128 + 2 * lane; const unsigned gg = *(const unsigned*)(Om + g);
        *(unsigned*)(Hb + g) = pk2(o0 * rstd * onw[h * 128 + 2 * lane] * bflo(gg), o1 * rstd * onw[h * 128 + 2 * lane + 1] * bfhi(gg)); }
}

__device__ __forceinline__ void small_unit_resid(LAS unsigned char* lds, const bf16* A, const bf16* Bt, int K, int R0, int C0, const float* basep, float* X, bf16* Xb, float* ssq) {
    const int tid = threadIdx.x, lane = tid & 63, w = __builtin_amdgcn_readfirstlane(tid >> 6), fr = lane & 15, fq = lane >> 4;
    const int kw = K >> 3;
    const bf16* ap = A + (size_t)(R0 + fr) * K + w * kw + 8 * fq;
    const bf16* bp = Bt + (size_t)(C0 + fr) * K + w * kw + 8 * fq;
    const size_t rs16 = (size_t)16 * K;
    f32x4 acc[4][4];
#pragma unroll
    for (int i = 0; i < 4; ++i)
#pragma unroll
        for (int j = 0; j < 4; ++j) acc[i][j] = (f32x4){0.f, 0.f, 0.f, 0.f};
    bf16x8 a0[4], b0[4], a1[4], b1[4];
#pragma unroll
    for (int i = 0; i < 4; ++i) { a0[i] = *(const bf16x8*)(ap + i * rs16); b0[i] = *(const bf16x8*)(bp + i * rs16); }
    for (int ks = 0; ks < kw; ks += 64) {
#pragma unroll
        for (int i = 0; i < 4; ++i) { a1[i] = *(const bf16x8*)(ap + i * rs16 + ks + 32); b1[i] = *(const bf16x8*)(bp + i * rs16 + ks + 32); }
#pragma unroll
        for (int i = 0; i < 4; ++i)
#pragma unroll
            for (int j = 0; j < 4; ++j) acc[i][j] = MFMA16(b0[j], a0[i], acc[i][j]);
        if (ks + 64 < kw) {
#pragma unroll
            for (int i = 0; i < 4; ++i) { a0[i] = *(const bf16x8*)(ap + i * rs16 + ks + 64); b0[i] = *(const bf16x8*)(bp + i * rs16 + ks + 64); }
        }
#pragma unroll
        for (int i = 0; i < 4; ++i)
#pragma unroll
            for (int j = 0; j < 4; ++j) acc[i][j] = MFMA16(b1[j], a1[i], acc[i][j]);
    }
    __syncthreads();
#pragma unroll
    for (int i = 0; i < 4; ++i)
#pragma unroll
        for (int j = 0; j < 4; ++j) LDSV(f32x4, w * 16384 + (16 * i + fr) * 256 + (((4 * j + fq) ^ fr) << 4)) = acc[i][j];
    __syncthreads();
    { const int row = tid >> 3, cg = tid & 7; f32x4 x0 = (f32x4){0.f, 0.f, 0.f, 0.f}, x1 = x0;
#pragma unroll
        for (int g = 0; g < 8; ++g) { x0 += LDSV(f32x4, g * 16384 + row * 256 + (((2 * cg) ^ (row & 15)) << 4)); x1 += LDSV(f32x4, g * 16384 + row * 256 + (((2 * cg + 1) ^ (row & 15)) << 4)); }
        const size_t off = (size_t)(R0 + row) * 1024 + C0 + 8 * cg;
        const f32x4 v0 = *(const f32x4*)(basep + off) + x0, v1 = *(const f32x4*)(basep + off + 4) + x1;
        *(f32x4*)(X + off) = v0; *(f32x4*)(X + off + 4) = v1;
        *(v4u*)(Xb + off) = (v4u){pk2(v0[0], v0[1]), pk2(v0[2], v0[3]), pk2(v1[0], v1[1]), pk2(v1[2], v1[3])};
        float sq = (v0[0] * v0[0] + v0[1] * v0[1]) + (v0[2] * v0[2] + v0[3] * v0[3]) + (v1[0] * v1[0] + v1[1] * v1[1]) + (v1[2] * v1[2] + v1[3] * v1[3]);
        sq += __shfl_xor(sq, 1); sq += __shfl_xor(sq, 2); sq += __shfl_xor(sq, 4);
        if (cg == 0) atomicAdd(ssq + R0 + row, sq); }
}
struct Args { const float* in[19]; float* out; unsigned char* ws; int ph_lo, ph_hi, li, pad; };
#ifndef PG8_SP2
#define PG8_SP2 true
#endif
#ifndef PG8_ALIGN
#define PG8_ALIGN true
#endif
__global__ void __launch_bounds__(NWAVES * 64, 2) trunk_fwd(Args args) {
    extern __shared__ __attribute__((aligned(16))) unsigned char lds_raw[];
    LAS unsigned char* lds = (LAS unsigned char*)lds_raw;
    volatile LAS unsigned* MISC = (volatile LAS unsigned*)(lds + MISC_OFF);
    const int tid = threadIdx.x, lane = tid & 63, wave = __builtin_amdgcn_readfirstlane(tid >> 6);
    const int G = gridDim.x, bx = blockIdx.x;
    unsigned char* ws = args.ws; float* out = args.out;
    gu32* ctl = (gu32*)(ws + WS_CTL);
    float* SS = (float*)(ws + WS_SS); float* LB = (float*)(ws + WS_LB);
    bf16* Win0 = (bf16*)(ws + WS_WIN0); bf16* Wout0 = (bf16*)(ws + WS_WOUT0); bf16* Wup0 = (bf16*)(ws + WS_WUP0); bf16* Wdn0 = (bf16*)(ws + WS_WDN0);
    bf16* Win1 = (bf16*)(ws + WS_WIN1); bf16* Wout1 = (bf16*)(ws + WS_WOUT1); bf16* Wup1 = (bf16*)(ws + WS_WUP1); bf16* Wdn1 = (bf16*)(ws + WS_WDN1);
    bf16* Xb = (bf16*)(ws + WS_XB); bf16* U = (bf16*)(ws + WS_ACT);
    bf16* Qb = (bf16*)(ws + WS_Q); bf16* LFb = (bf16*)(ws + WS_LF); bf16* Vb = (bf16*)(ws + WS_V); bf16* Gb = (bf16*)(ws + WS_G);
    bf16* Qm = (bf16*)(ws + WS_QM); bf16* Km = (bf16*)(ws + WS_KM); bf16* Vm = (bf16*)(ws + WS_VM); bf16* Om = (bf16*)(ws + WS_OM); float* GTg = (float*)(ws + WS_GT);
    float* X = out + OUT_Y;
    for (int u = tid; u < (LDS_BYTES - LDSCTL_OFF) / 4; u += NWAVES * 64) ((LAS unsigned*)(lds + LDSCTL_OFF))[u] = 0u;
    __syncthreads();
    XcdBarrier bar; bar.bar = (unsigned*)(ctl + CW_BAR); bar.x = 0; bar.st = nullptr;
    if (MK_N_LAUNCHES == 1) bar = xcd_barrier_post((unsigned*)(ctl + CW_BAR), MISC + 8);
    const int lo = args.ph_lo, hi = args.ph_hi;
#define IN(k) (lo <= (k) && (k) < hi)
#define SEAM(k) do { if (IN(k) && IN((k) + 1)) xcd_barrier(bar); } while (0)

    if (IN(0)) {
        LAS float* scr = (LAS float*)(lds + wave * 16384);
        const int gw = bx * NWAVES + wave, NGW = G * NWAVES;
        constexpr int I0 = 16 * 128, I1 = 16 * 32, I2 = 16 * 128, I3 = 64 * 32, I4 = 16 * 97, I5 = I1, I6 = I2, I7 = I3, NITEMS = I0 + I1 + I2 + I3 + I4 + I5 + I6 + I7;
        for (int it = gw; it < NITEMS; it += NGW) {
            int r = it;
            if (r < I0) { p0_transpose_item(args.in[8], 1024, 4096, args.in[6], Win0, scr, r, lane); continue; } r -= I0;
            if (r < I1) { p0_transpose_item(args.in[11], 1024, 1024, nullptr, Wout0, scr, r, lane); continue; } r -= I1;
            if (r < I2) { p0_transpose_item(args.in[16], 1024, 4096, args.in[7], Wup0, scr, r, lane); continue; } r -= I2;
            if (r < I3) { p0_transpose_item(args.in[17], 4096, 1024, nullptr, Wdn0, scr, r, lane); continue; } r -= I3;
            if (r < I4) { p0_transpose_item(args.in[12], 1024, NIN1, args.in[6] + 1024, Win1, scr, r, lane); continue; } r -= I4;
            if (r < I5) { p0_transpose_item(args.in[15], 1024, 1024, nullptr, Wout1, scr, r, lane); continue; } r -= I5;
            if (r < I6) { p0_transpose_item(args.in[16] + (size_t)1024 * 4096, 1024, 4096, args.in[7] + 1024, Wup1, scr, r, lane); continue; } r -= I6;
            p0_transpose_item(args.in[17] + (size_t)4096 * 1024, 4096, 1024, nullptr, Wdn1, scr, r, lane);
        }
        for (int m = gw; m < MROWS; m += NGW) {
            const float* xr = m < MP ? args.in[0] + (size_t)m * 1024 : args.in[1] + (size_t)(m - MP) * 1024;
            f32x4 v[4]; float s = 0.f;
#pragma unroll
            for (int j = 0; j < 4; ++j) { v[j] = *((const f32x4*)xr + lane + 64 * j); s += (v[j][0] * v[j][0] + v[j][1] * v[j][1]) + (v[j][2] * v[j][2] + v[j][3] * v[j][3]); }
            s = wave_sum(s); if (lane == 0) SS[m] = s;
#pragma unroll
            for (int j = 0; j < 4; ++j) *((v2u*)(Xb + (size_t)m * 1024) + lane + 64 * j) = (v2u){pk2(v[j][0], v[j][1]), pk2(v[j][2], v[j][3])};
        }
        if (bx == 0) for (int d = tid; d < 1024; d += NWAVES * 64) { const float l0 = args.in[9][d], l1 = args.in[9][1024 + d], l2 = args.in[9][2048 + d]; const float mx = fmaxf(l0, fmaxf(l1, l2));
            const float e0 = expf(l0 - mx), e1 = expf(l1 - mx), e2 = expf(l2 - mx); LB[d] = e0 / (e0 + e1 + e2); }
    }
    SEAM(0);
    if (IN(1)) { pg8::Gemm g{Xb, Win0, MP, 4096, 1024}; pg8::StaticOrder S; S.init(MP, 4096, G, bx);
        pg8::EpiHgrnIn E{Qb, LFb, Vb, Gb, SS, LB};
        pg8::gemm_phase_x<pg8::EpiHgrnIn, pg8::StaticOrder>(lds, g, MP, S, E); }
    SEAM(1);
    if (IN(2)) {
        const int npb = G > 64 ? 64 : G;
#ifdef PROBE_DUP_REC
        if (bx < npb) for (int it = bx; it < 64; it += npb) hgrn_prompt_item(lds, it >> 3, it & 7, Qb, LFb, Vb, Gb, Xb, args.in[10], out + OUT_SP);
#endif
        if (bx < npb) for (int it = bx; it < 64; it += npb) hgrn_prompt_item(lds, it >> 3, it & 7, Qb, LFb, Vb, Gb, Qb, args.in[10], out + OUT_SP);
        const int first = G > 64 ? 64 : 0, nsb = G - first;
        if (bx >= first) for (int it = bx - first; it < 1024; it += nsb) hgrn_sample_item(lds, it >> 3, it & 7, Qb, LFb, Vb, Gb, Qb, args.in[10], args.in[2], out + OUT_SS);
    }
    SEAM(2);
    if (IN(3)) { pg8::Gemm g{Qb, Wout0, MP, 1024, 1024}; pg8::StaticOrder S; S.init(MP, 1024, G, bx);
        pg8::EpiResid E{args.in[0], args.in[1], X, Xb, SS + MROWS};
        pg8::gemm_phase_x<pg8::EpiResid, pg8::StaticOrder>(lds, g, MP, S, E); }
    SEAM(3);
    if (IN(4)) { pg8::Gemm g{Xb, Wup0, MP, 4096, 1024}; pg8::StaticOrder S; S.init(MP, 4096, G, bx);
        pg8::EpiUp E{U, SS + MROWS};
        pg8::gemm_phase_x<pg8::EpiUp, pg8::StaticOrder>(lds, g, MP, S, E); }
    SEAM(4);
    if (IN(5)) { pg8::Gemm g{U, Wdn0, MP, 1024, 4096}; pg8::StaticOrder S; S.init(MP, 1024, G, bx);
        pg8::EpiResid E{X, X + (size_t)MP * 1024, X, Xb, SS + 2 * MROWS};
        pg8::gemm_phase_x<pg8::EpiResid, pg8::StaticOrder>(lds, g, MP, S, E); }
    SEAM(5);
    if (IN(6)) { pg8::Gemm g{Xb, Win1, MP, NIN1P, 1024}; pg8::StaticOrder S; S.init(MP, NIN1P, G, bx);
        pg8::EpiMlstmIn E{Qm, Km, Vm, Om, GTg, SS + 2 * MROWS, args.in[13]};
        pg8::gemm_phase_x<pg8::EpiMlstmIn, pg8::StaticOrder>(lds, g, MP, S, E); }
    SEAM(6);
    if (IN(7)) {
        const int npb = G > 64 ? 64 : G;
#ifdef PROBE_DUP_REC
        if (bx < npb) for (int it = bx; it < 64; it += npb) mlstm_prompt_item(lds, it >> 3, it & 7, Qm, Km, Vm, Om, GTg, Xb, args.in[14], out + OUT_CP, out + OUT_NP, out + OUT_MP);
#endif
        if (bx < npb) for (int it = bx; it < 64; it += npb) mlstm_prompt_item(lds, it >> 3, it & 7, Qm, Km, Vm, Om, GTg, Vm, args.in[14], out + OUT_CP, out + OUT_NP, out + OUT_MP);
        const int first = G > 64 ? 64 : 0, nsb = G - first;
        if (bx >= first) for (int it = bx - first; it < 1024; it += nsb) mlstm_sample_item(lds, it >> 3, it & 7, Qm, Km, Vm, Om, GTg, Vm, args.in[14], args.in[3], args.in[4], args.in[5], out + OUT_CS, out + OUT_NS, out + OUT_MS);
    }
    SEAM(7);
    if (IN(8)) { pg8::Gemm g{Vm, Wout1, MP, 1024, 1024}; pg8::StaticOrder S; S.init(MP, 1024, G, bx);
        pg8::EpiResid E{X, X + (size_t)MP * 1024, X, Xb, SS + 3 * MROWS};
        pg8::gemm_phase_x<pg8::EpiResid, pg8::StaticOrder>(lds, g, MP, S, E); }
    SEAM(8);
    if (IN(9)) { pg8::Gemm g{Xb, Wup1, MP, 4096, 1024}; pg8::StaticOrder S; S.init(MP, 4096, G, bx);
        pg8::EpiUp E{U, SS + 3 * MROWS};
        pg8::gemm_phase_x<pg8::EpiUp, pg8::StaticOrder>(lds, g, MP, S, E); }
    SEAM(9);
    if (IN(10)) { pg8::Gemm g{U, Wdn1, MP, 1024, 4096}; pg8::StaticOrder S; S.init(MP, 1024, G, bx);
        pg8::EpiResid E{X, X + (size_t)MP * 1024, X, Xb, SS + 4 * MROWS};
        pg8::gemm_phase_x<pg8::EpiResid, pg8::StaticOrder>(lds, g, MP, S, E); }
    SEAM(10);
    if (IN(11)) {
        const int gw = bx * NWAVES + wave, NGW = G * NWAVES; const float* wf = args.in[18];
        f32x4 wv[4];
#pragma unroll
        for (int j = 0; j < 4; ++j) wv[j] = *((const f32x4*)wf + lane + 64 * j);
        for (int m = gw; m < MROWS; m += NGW) { const float rs = rsqrtf(SS[4 * MROWS + m] * (1.0f / 1024.0f) + 1e-6f); f32x4* xr = (f32x4*)(X + (size_t)m * 1024);
#pragma unroll
            for (int j = 0; j < 4; ++j) xr[lane + 64 * j] = xr[lane + 64 * j] * rs * wv[j]; }
    }
#undef IN
#undef SEAM
}

extern "C" void kernel_launch(void* const* d_in, const int* in_sizes, int n_in, void* d_out, int out_size, void* d_ws, size_t ws_size, hipStream_t stream) {
    static int grid = 0;
    if (grid == 0) {
        if (n_in != 19 || out_size != (int)OUT_END || ws_size < WS_END) { fprintf(stderr, "kernel_launch: unexpected shapes: n_in %d out %d ws %zu\n", n_in, out_size, ws_size); grid = -1; return; }
        int dev = 0, cus = 0, per_cu = 0;
        if (hipGetDevice(&dev) != hipSuccess || hipDeviceGetAttribute(&cus, hipDeviceAttributeMultiprocessorCount, dev) != hipSuccess) { grid = -1; return; }
        if (hipFuncSetAttribute((const void*)trunk_fwd, hipFuncAttributeMaxDynamicSharedMemorySize, LDS_BYTES) != hipSuccess) { fprintf(stderr, "kernel_launch: hipFuncSetAttribute failed\n"); grid = -1; return; }
        if (hipOccupancyMaxActiveBlocksPerMultiprocessor(&per_cu, (const void*)trunk_fwd, NWAVES * 64, LDS_BYTES) != hipSuccess || per_cu < 1) { fprintf(stderr, "kernel_launch: occupancy query says %d blocks per CU\n", per_cu); grid = -1; return; }
        (void)hipGetLastError();
        grid = cus;
    }
    if (grid < 0) return;
    (void)hipMemsetAsync((char*)d_ws + WS_CTL, 0, CTL_ZERO_BYTES, stream);
    Args a{};
    for (int i = 0; i < 19; ++i) a.in[i] = (const float*)d_in[i];
    a.out = (float*)d_out; a.ws = (unsigned char*)d_ws;
#if MK_N_LAUNCHES == 1
    a.ph_lo = 0; a.ph_hi = N_PHASES; a.li = 0;
    hipLaunchKernelGGL(trunk_fwd, dim3(grid), dim3(NWAVES * 64), LDS_BYTES, stream, a);
#else
    for (int li = 0; li < N_PHASES; ++li) { a.ph_lo = li; a.ph_hi = li + 1; a.li = li; hipLaunchKernelGGL(trunk_fwd, dim3(grid), dim3(NWAVES * 64), LDS_BYTES, stream, a); }
#endif
}
```

```cpp
#include <hip/hip_runtime.h>
#include <cstdio>
#include <cstdint>
#include <cmath>
namespace pg8 {
#define PG8_LAS __attribute__((address_space(3)))
typedef unsigned short bf16_t;
typedef short bf16x8 __attribute__((ext_vector_type(8)));
typedef float f32x4 __attribute__((ext_vector_type(4)));
typedef unsigned u32x4 __attribute__((ext_vector_type(4)));
constexpr int BM = 256, BK = 64, HALF = 128, HTB = HALF * BK * 2  , STAGE_BYTES = 8 * HTB, NXCD = 8, WGM = 8;

__host__ __device__ __forceinline__ int lds_byte(int r, int c) { const int st = (r >> 4) * 2 + (c >> 5), rr = r & 15, cc = c & 31, ob = rr * 64 + cc * 2; return st * 1024 + (ob ^ (((ob >> 9) & 1) << 5)); }
__host__ __device__ __forceinline__ void stage_rc(int b, int& R, int& C) { const int st = b / 1024, sb = b % 1024, swz = sb ^ (((sb >> 9) & 1) << 5); R = (st >> 1) * 16 + swz / 64; C = (st & 1) * 32 + (swz % 64) / 2; }
__host__ __device__ __forceinline__ int perm32(int rho) { const int n = rho >> 4, i = rho & 15; return 8 * (i >> 2) + 4 * n + (i & 3); }

struct Unit { int pm, pn; };
struct Gemm { const bf16_t* A; const bf16_t* Bt; int M, N, K; };

struct StaticOrder {
    int nM, nN, nwg, G, c;
    __host__ __device__ void init(int M, int N, int G_, int c_) { nM = M / BM; nN = N / BM; nwg = nM * nN; G = G_; c = c_; }
    __host__ __device__ bool next(int i, Unit& u) const {
        const long L = (long)i * G + c; if (L >= nwg) return false;
        int wgid = (int)L; { const int q = nwg / NXCD, r = nwg % NXCD, xcd = wgid % NXCD, off = wgid / NXCD; wgid = (xcd < r ? xcd * (q + 1) : r * (q + 1) + (xcd - r) * q) + off; }
        const int nig = WGM * nN, gid = wgid / nig, fm = gid * WGM, gsz = (nM - fm) < WGM ? (nM - fm) : WGM;
        u.pm = fm + ((wgid % nig) % gsz); u.pn = (wgid % nig) / gsz; return true;
    }
    __device__ __forceinline__ void a_ready(const Unit&) const {}
    __device__ __forceinline__ void done(const Unit&) const {}
};

typedef unsigned u32x2 __attribute__((ext_vector_type(2)));
__device__ __forceinline__ unsigned f2bf_(float f) { unsigned u = __builtin_bit_cast(unsigned, f); return (u + 0x7fffu + ((u >> 16) & 1u)) >> 16; }
typedef float f32x2c_ __attribute__((ext_vector_type(2))); typedef __bf16 bf16x2c_ __attribute__((ext_vector_type(2)));
__device__ __forceinline__ unsigned pkbf(float lo, float hi) { f32x2c_ v = {lo, hi}; bf16x2c_ b = __builtin_convertvector(v, bf16x2c_); return __builtin_bit_cast(unsigned, b); }
__device__ __forceinline__ unsigned pkh(float lo, float hi) { const _Float16 a = (_Float16)lo, b = (_Float16)hi; return (unsigned)__builtin_bit_cast(unsigned short, a) | ((unsigned)__builtin_bit_cast(unsigned short, b) << 16); }
__device__ __forceinline__ float sigm(float x) { return __builtin_amdgcn_rcpf(1.0f + __expf(-x)); }
constexpr float NORM_EPS = 1e-6f;
constexpr int XROW0 = 16384;

struct EpiHgrnIn {
    static constexpr bool PERM = true, AFTER_DRAIN = false;
    bf16_t* Q; bf16_t* LF; bf16_t* V; bf16_t* G; const float* ss; const float* lb;
    template <int GRP> __device__ __forceinline__ void run(const f32x4 (&acc)[2][2][4][2], const Unit& u, int wr, int wc, int fr, int fq) const {
        const int row0 = u.pm * BM + wr * 64 + fr, gc0 = (u.pn & 3) * BM + wc * 32 + 8 * fq;
        bf16_t* dst = GRP == 0 ? Q : GRP == 1 ? LF : GRP == 2 ? V : G;
        f32x4 lbv[2][2];
        if (GRP == 1) {
#pragma unroll
            for (int bj = 0; bj < 2; ++bj)
#pragma unroll
                for (int n = 0; n < 2; ++n) lbv[bj][n] = *(const f32x4*)(lb + gc0 + bj * HALF + 4 * n);
        }
#pragma unroll
        for (int ai = 0; ai < 2; ++ai)
#pragma unroll
            for (int m = 0; m < 4; ++m) { const int row = row0 + ai * HALF + m * 16; const float rs = rsqrtf(ss[row] * (1.0f / 1024.0f) + NORM_EPS);
                bf16_t* rowp = dst + (size_t)row * 1024 + gc0;
#pragma unroll
                for (int bj = 0; bj < 2; ++bj) { float x[8];
#pragma unroll
                    for (int n = 0; n < 2; ++n)
#pragma unroll
                        for (int j = 0; j < 4; ++j) x[4 * n + j] = acc[ai][bj][m][n][j] * rs;
                    u32x4 w;
                    if (GRP == 0 || GRP == 3) {
#pragma unroll
                        for (int j = 0; j < 8; ++j) x[j] = x[j] * sigm(x[j]);
                    }
                    if (GRP == 1) {
#pragma unroll
                        for (int j = 0; j < 8; ++j) { const float l = lbv[bj][j >> 2][j & 3]; x[j] = __logf(l + (1.0f - l) * sigm(x[j])); }
                        w.x = pkh(x[0], x[1]); w.y = pkh(x[2], x[3]); w.z = pkh(x[4], x[5]); w.w = pkh(x[6], x[7]);
                    } else { w.x = pkbf(x[0], x[1]); w.y = pkbf(x[2], x[3]); w.z = pkbf(x[4], x[5]); w.w = pkbf(x[6], x[7]); }
                    *(u32x4*)(rowp + bj * HALF) = w; } }
    }
    __device__ __forceinline__ void operator()(const f32x4 (&acc)[2][2][4][2], const Unit& u, int wr, int wc, int fr, int fq) const {
        const int grp = u.pn >> 2;
        if (grp == 0) run<0>(acc, u, wr, wc, fr, fq); else if (grp == 1) run<1>(acc, u, wr, wc, fr, fq); else if (grp == 2) run<2>(acc, u, wr, wc, fr, fq); else run<3>(acc, u, wr, wc, fr, fq);
    }
    __device__ __forceinline__ void extra(const f32x4 (&accE)[2], const Unit& u, int wr, int wc, int fr, int fq) const {
        const int grp = u.pn >> 2, row = XROW0 + 16 * u.pm + fr, gc0 = (u.pn & 3) * BM + wr * HALF + wc * 32 + 8 * fq;
        const float rs = rsqrtf(ss[row] * (1.0f / 1024.0f) + NORM_EPS);
        float x[8];
#pragma unroll
        for (int j = 0; j < 8; ++j) x[j] = accE[j >> 2][j & 3] * rs;
        bf16_t* dst = grp == 0 ? Q : grp == 1 ? LF : grp == 2 ? V : G;
        u32x4 w;
        if (grp == 0 || grp == 3) {
#pragma unroll
            for (int j = 0; j < 8; ++j) x[j] = x[j] * sigm(x[j]);
        }
        if (grp == 1) {
#pragma unroll
            for (int j = 0; j < 8; ++j) { const float l = lb[gc0 + j]; x[j] = __logf(l + (1.0f - l) * sigm(x[j])); }
            w.x = pkh(x[0], x[1]); w.y = pkh(x[2], x[3]); w.z = pkh(x[4], x[5]); w.w = pkh(x[6], x[7]);
        } else { w.x = pkbf(x[0], x[1]); w.y = pkbf(x[2], x[3]); w.z = pkbf(x[4], x[5]); w.w = pkbf(x[6], x[7]); }
        *(u32x4*)(dst + (size_t)row * 1024 + gc0) = w;
    }
};

struct EpiMlstmIn {
    static constexpr bool PERM = true, AFTER_DRAIN = false;
    bf16_t* Qm; bf16_t* Km; bf16_t* Vm; bf16_t* Om; float* GT; const float* ss; const float* gb;
    template <int GRP> __device__ __forceinline__ void run(const f32x4 (&acc)[2][2][4][2], const Unit& u, int wr, int wc, int fr, int fq) const {
        const int row0 = u.pm * BM + wr * 64 + fr;
        const int ld = GRP < 2 ? 512 : 1024;
        const int tb = GRP == 0 ? 0 : GRP == 1 ? 2 : GRP == 2 ? 4 : 8;
        const int gc0 = (u.pn - tb) * BM + wc * 32 + 8 * fq;
        bf16_t* dst = GRP == 0 ? Qm : GRP == 1 ? Km : GRP == 2 ? Vm : Om;
#pragma unroll
        for (int ai = 0; ai < 2; ++ai)
#pragma unroll
            for (int m = 0; m < 4; ++m) { const int row = row0 + ai * HALF + m * 16; const float rs = rsqrtf(ss[row] * (1.0f / 1024.0f) + NORM_EPS);
                bf16_t* rowp = dst + (size_t)row * ld + gc0;
#pragma unroll
                for (int bj = 0; bj < 2; ++bj) { float x[8];
#pragma unroll
                    for (int n = 0; n < 2; ++n)
#pragma unroll
                        for (int j = 0; j < 4; ++j) x[4 * n + j] = acc[ai][bj][m][n][j] * rs;
                    if (GRP == 0) {
#pragma unroll
                        for (int j = 0; j < 8; ++j) x[j] *= 0.125f;
                    }
                    if (GRP == 3) {
#pragma unroll
                        for (int j = 0; j < 8; ++j) x[j] = sigm(x[j]);
                    }
                    u32x4 w; w.x = pkbf(x[0], x[1]); w.y = pkbf(x[2], x[3]); w.z = pkbf(x[4], x[5]); w.w = pkbf(x[6], x[7]);
                    *(u32x4*)(rowp + bj * HALF) = w; } }
    }
    __device__ __forceinline__ void gates(const f32x4 (&acc)[2][2][4][2], const Unit& u, int wr, int wc, int fr, int fq) const {
        if (wc != 0 || fq >= 2) return;
        const int row0 = u.pm * BM + wr * 64 + fr;
#pragma unroll
        for (int ai = 0; ai < 2; ++ai)
#pragma unroll
            for (int m = 0; m < 4; ++m) { const int row = row0 + ai * HALF + m * 16; const float rs = rsqrtf(ss[row] * (1.0f / 1024.0f) + NORM_EPS);
                float x[8];
#pragma unroll
                for (int n = 0; n < 2; ++n)
#pragma unroll
                    for (int j = 0; j < 4; ++j) x[4 * n + j] = acc[ai][0][m][n][j] * rs;
#pragma unroll
                for (int j = 0; j < 8; ++j) { const float y2 = (x[j] + gb[8 * fq + j]) * (2.0f / 15.0f); const float z = 15.0f - 30.0f * __builtin_amdgcn_rcpf(__expf(y2) + 1.0f); x[j] = fq == 0 ? z : -__logf(1.0f + __expf(-z)); }
                float* o = GT + (size_t)row * 16 + 8 * fq;
                *(f32x4*)o = (f32x4){x[0], x[1], x[2], x[3]}; *(f32x4*)(o + 4) = (f32x4){x[4], x[5], x[6], x[7]}; }
    }
    __device__ __forceinline__ void operator()(const f32x4 (&acc)[2][2][4][2], const Unit& u, int wr, int wc, int fr, int fq) const {
        const int pn = u.pn;
        if (pn < 2) run<0>(acc, u, wr, wc, fr, fq); else if (pn < 4) run<1>(acc, u, wr, wc, fr, fq); else if (pn < 8) run<2>(acc, u, wr, wc, fr, fq); else if (pn < 12) run<3>(acc, u, wr, wc, fr, fq); else gates(acc, u, wr, wc, fr, fq);
    }
    __device__ __forceinline__ void extra(const f32x4 (&accE)[2], const Unit& u, int wr, int wc, int fr, int fq) const {
        const int pn = u.pn, row = XROW0 + 16 * u.pm + fr;
        const float rs = rsqrtf(ss[row] * (1.0f / 1024.0f) + NORM_EPS);
        float x[8];
#pragma unroll
        for (int j = 0; j < 8; ++j) x[j] = accE[j >> 2][j & 3] * rs;
        if (pn == 12) {
            if (wr != 0 || wc != 0 || fq >= 2) return;
#pragma unroll
            for (int j = 0; j < 8; ++j) { const float y2 = (x[j] + gb[8 * fq + j]) * (2.0f / 15.0f); const float z = 15.0f - 30.0f * __builtin_amdgcn_rcpf(__expf(y2) + 1.0f); x[j] = fq == 0 ? z : -__logf(1.0f + __expf(-z)); }
            float* o = GT + (size_t)row * 16 + 8 * fq;
            *(f32x4*)o = (f32x4){x[0], x[1], x[2], x[3]}; *(f32x4*)(o + 4) = (f32x4){x[4], x[5], x[6], x[7]};
            return;
        }
        const int grp = pn < 2 ? 0 : pn < 4 ? 1 : pn < 8 ? 2 : 3, tb = grp == 0 ? 0 : grp == 1 ? 2 : grp == 2 ? 4 : 8, ld = grp < 2 ? 512 : 1024;
        const int gc0 = (pn - tb) * BM + wr * HALF + wc * 32 + 8 * fq;
        bf16_t* dst = grp == 0 ? Qm : grp == 1 ? Km : grp == 2 ? Vm : Om;
        if (grp == 0) {
#pragma unroll
            for (int j = 0; j < 8; ++j) x[j] *= 0.125f;
        }
        if (grp == 3) {
#pragma unroll
            for (int j = 0; j < 8; ++j) x[j] = sigm(x[j]);
        }
        u32x4 w; w.x = pkbf(x[0], x[1]); w.y = pkbf(x[2], x[3]); w.z = pkbf(x[4], x[5]); w.w = pkbf(x[6], x[7]);
        *(u32x4*)(dst + (size_t)row * ld + gc0) = w;
    }
};

struct EpiUp {
    static constexpr bool PERM = true, AFTER_DRAIN = false;
    bf16_t* U; const float* ss;
    __device__ __forceinline__ void operator()(const f32x4 (&acc)[2][2][4][2], const Unit& u, int wr, int wc, int fr, int fq) const {
        const int row0 = u.pm * BM + wr * 64 + fr, c0 = u.pn * BM + wc * 32 + 8 * fq;
#pragma unroll
        for (int ai = 0; ai < 2; ++ai)
#pragma unroll
            for (int m = 0; m < 4; ++m) { const int row = row0 + ai * HALF + m * 16; const float rs = rsqrtf(ss[row] * (1.0f / 1024.0f) + NORM_EPS);
                bf16_t* rowp = U + (size_t)row * 4096 + c0;
#pragma unroll
                for (int bj = 0; bj < 2; ++bj) { float x[8];
#pragma unroll
                    for (int n = 0; n < 2; ++n)
#pragma unroll
                        for (int j = 0; j < 4; ++j) { const float a = fmaxf(acc[ai][bj][m][n][j] * rs, 0.0f); x[4 * n + j] = a * a; }
                    u32x4 w; w.x = pkbf(x[0], x[1]); w.y = pkbf(x[2], x[3]); w.z = pkbf(x[4], x[5]); w.w = pkbf(x[6], x[7]);
                    *(u32x4*)(rowp + bj * HALF) = w; } }
    }
    __device__ __forceinline__ void extra(const f32x4 (&accE)[2], const Unit& u, int wr, int wc, int fr, int fq) const {
        const int row = XROW0 + 16 * u.pm + fr, c0 = u.pn * BM + wr * HALF + wc * 32 + 8 * fq;
        const float rs = rsqrtf(ss[row] * (1.0f / 1024.0f) + NORM_EPS);
        float x[8];
#pragma unroll
        for (int j = 0; j < 8; ++j) { const float a = fmaxf(accE[j >> 2][j & 3] * rs, 0.0f); x[j] = a * a; }
        u32x4 w; w.x = pkbf(x[0], x[1]); w.y = pkbf(x[2], x[3]); w.z = pkbf(x[4], x[5]); w.w = pkbf(x[6], x[7]);
        *(u32x4*)(U + (size_t)row * 4096 + c0) = w;
    }
};

struct EpiDummy {
    static constexpr bool PERM = true, AFTER_DRAIN = false;
    bf16_t* O;
    __device__ __forceinline__ void operator()(const f32x4 (&acc)[2][2][4][2], const Unit& u, int wr, int wc, int fr, int fq) const {
        const int row0 = u.pm * BM + wr * 64 + fr, c0 = u.pn * BM + wc * 32 + 8 * fq;
#pragma unroll
        for (int ai = 0; ai < 2; ++ai)
#pragma unroll
            for (int m = 0; m < 4; ++m) { bf16_t* rowp = O + (size_t)(row0 + ai * HALF + m * 16) * 1024 + c0;
#pragma unroll
                for (int bj = 0; bj < 2; ++bj) { u32x4 w; w.x = pkbf(acc[ai][bj][m][0][0], acc[ai][bj][m][0][1]); w.y = pkbf(acc[ai][bj][m][0][2], acc[ai][bj][m][0][3]); w.z = pkbf(acc[ai][bj][m][1][0], acc[ai][bj][m][1][1]); w.w = pkbf(acc[ai][bj][m][1][2], acc[ai][bj][m][1][3]);
                    *(u32x4*)(rowp + bj * HALF) = w; } }
    }
    __device__ __forceinline__ void extra(const f32x4 (&accE)[2], const Unit& u, int wr, int wc, int fr, int fq) const {
        const int row = XROW0 + 16 * u.pm + fr, c0 = u.pn * BM + wr * HALF + wc * 32 + 8 * fq;
        u32x4 w; w.x = pkbf(accE[0][0], accE[0][1]); w.y = pkbf(accE[0][2], accE[0][3]); w.z = pkbf(accE[1][0], accE[1][1]); w.w = pkbf(accE[1][2], accE[1][3]);
        *(u32x4*)(O + (size_t)row * 1024 + c0) = w;
    }
};
struct EpiResid {
    static constexpr bool PERM = false, AFTER_DRAIN = false;
    const float* base0; const float* base1; float* X; bf16_t* Xb; float* ssq;
    __device__ __forceinline__ void operator()(const f32x4 (&acc)[2][2][4][2], const Unit& u, int wr, int wc, int fr, int fq) const {
        const int row0 = u.pm * BM + wr * 64 + fr, c0 = u.pn * BM + wc * 32 + 4 * fq;
        const float* bs = u.pm < 64 ? base0 : base1 - (size_t)16384 * 1024;
#pragma unroll
        for (int ai = 0; ai < 2; ++ai)
#pragma unroll
            for (int m = 0; m < 4; ++m) { const int row = row0 + ai * HALF + m * 16; const size_t off = (size_t)row * 1024 + c0; float s = 0.f;
#pragma unroll
                for (int bj = 0; bj < 2; ++bj)
#pragma unroll
                    for (int n = 0; n < 2; ++n) { const f32x4 b = *(const f32x4*)(bs + off + bj * HALF + n * 16); const f32x4 v = b + acc[ai][bj][m][n];
                        *(f32x4*)(X + off + bj * HALF + n * 16) = v; u32x2 w; w.x = pkbf(v[0], v[1]); w.y = pkbf(v[2], v[3]); *(u32x2*)(Xb + off + bj * HALF + n * 16) = w;
                        s += (v[0] * v[0] + v[1] * v[1]) + (v[2] * v[2] + v[3] * v[3]); }
                s += __shfl_xor(s, 16); s += __shfl_xor(s, 32);
                if (fq == 0) atomicAdd(ssq + row, s); }
    }
    __device__ __forceinline__ void extra(const f32x4 (&accE)[2], const Unit& u, int wr, int wc, int fr, int fq) const {
        const int row = XROW0 + 16 * u.pm + fr, c0 = u.pn * BM + wr * HALF + wc * 32 + 4 * fq;
        const float* bs = base1 - (size_t)XROW0 * 1024; const size_t off = (size_t)row * 1024 + c0; float s = 0.f;
#pragma unroll
        for (int n = 0; n < 2; ++n) { const f32x4 b = *(const f32x4*)(bs + off + n * 16); const f32x4 v = b + accE[n];
            *(f32x4*)(X + off + n * 16) = v; u32x2 w; w.x = pkbf(v[0], v[1]); w.y = pkbf(v[2], v[3]); *(u32x2*)(Xb + off + n * 16) = w;
            s += (v[0] * v[0] + v[1] * v[1]) + (v[2] * v[2] + v[3] * v[3]); }
        s += __shfl_xor(s, 16); s += __shfl_xor(s, 32);
        if (fq == 0) atomicAdd(ssq + row, s);
    }
};
template <class Epi, class Sched, bool ALIGN_EPI = false, bool SP2 = false>
__device__ __forceinline__ void gemm_phase(PG8_LAS unsigned char* lds, const Gemm g, const Sched& S, const Epi& E) {
    const int tid = threadIdx.x, wid = __builtin_amdgcn_readfirstlane(tid >> 6), lane = tid & 63, wr = wid >> 2, wc = wid & 3, fr = lane & 15, fq = lane >> 4;
    const int K = g.K, nt = K / BK;
    unsigned voffA[2], voffB[2];
#pragma unroll
    for (int i = 0; i < 2; ++i) { int R, C; stage_rc(tid * 16 + i * 8192, R, C); const int Rb = Epi::PERM ? ((R & ~31) + perm32(R & 31)) : R;
        voffA[i] = (unsigned)(R * K + C) * 2u; voffB[i] = (unsigned)(Rb * K + C) * 2u; }
    const size_t kstep = (size_t)(BK * 2);
    const size_t hstep = (size_t)HALF * K * 2;
    const size_t tstep = 2 * hstep;
    const unsigned ldsw = (unsigned)wid * 1024u;
    const int aoff = lds_byte(wr * 64 + fr, fq * 8), boff = lds_byte(wc * 32 + fr, fq * 8);
#define PG8_SA(b, h) (((b) * 2 + (h)) * HTB)
#define PG8_SB(b, h) ((4 + (b) * 2 + (h)) * HTB)
#define PG8_STAGE(bufoff, gbase, voff) do { _Pragma("unroll") for (int _i = 0; _i < 2; ++_i) \
        __builtin_amdgcn_global_load_lds((const unsigned*)((const char*)(gbase) + (voff)[_i]), (PG8_LAS unsigned*)(lds + (bufoff) + ldsw + _i * 8192), 16, 0, 0); } while (0)
#define PG8_LDA(dst, b, h) do { _Pragma("unroll") for (int m = 0; m < 4; ++m) _Pragma("unroll") for (int k = 0; k < 2; ++k) dst[m][k] = *(const PG8_LAS bf16x8*)(lds + PG8_SA(b, h) + aoff + m * 2048 + k * 1024); } while (0)
#define PG8_LDB(dst, b, h) do { _Pragma("unroll") for (int n = 0; n < 2; ++n) _Pragma("unroll") for (int k = 0; k < 2; ++k) dst[n][k] = *(const PG8_LAS bf16x8*)(lds + PG8_SB(b, h) + boff + n * 2048 + k * 1024); } while (0)
#define PG8_MMA(ai, bj, At, Bt) do { __builtin_amdgcn_s_setprio(1); _Pragma("unroll") for (int m = 0; m < 4; ++m) _Pragma("unroll") for (int n = 0; n < 2; ++n) _Pragma("unroll") for (int k = 0; k < 2; ++k) \
        acc[ai][bj][m][n] = __builtin_amdgcn_mfma_f32_16x16x32_bf16(Bt[n][k], At[m][k], acc[ai][bj][m][n], 0, 0, 0); __builtin_amdgcn_s_setprio(0); } while (0)
#define PG8_WAIT_V(n) asm volatile("s_waitcnt vmcnt(" #n ")" ::: "memory")
#define PG8_WAIT_L(n) asm volatile("s_waitcnt lgkmcnt(" #n ")" ::: "memory")
#define PG8_BAR __builtin_amdgcn_s_barrier()
#define PG8_SCHED __builtin_amdgcn_sched_barrier(0)
    Unit cur, nxt; int ui = 0;
    if (!S.next(0, cur)) return;
    f32x4 acc[2][2][4][2];
#pragma unroll
    for (int a = 0; a < 2; ++a)
#pragma unroll
        for (int b = 0; b < 2; ++b)
#pragma unroll
            for (int m = 0; m < 4; ++m)
#pragma unroll
                for (int n = 0; n < 2; ++n) acc[a][b][m][n] = (f32x4){0.f, 0.f, 0.f, 0.f};
    bf16x8 At[4][2], B0[2][2], B1[2][2];
    const char* cA = (const char*)g.A + (size_t)cur.pm * tstep; const char* cB = (const char*)g.Bt + (size_t)cur.pn * tstep;
    S.a_ready(cur);
    if constexpr (SP2) {
        PG8_STAGE(PG8_SB(0, 0), cB, voffB); PG8_STAGE(PG8_SB(0, 1), cB + hstep, voffB); PG8_STAGE(PG8_SA(0, 0), cA, voffA); PG8_STAGE(PG8_SA(0, 1), cA + hstep, voffA);
        if (wr == 1) PG8_BAR;
        PG8_WAIT_V(2); PG8_BAR;
        PG8_STAGE(PG8_SB(1, 0), cB + kstep, voffB); PG8_STAGE(PG8_SA(1, 0), cA + kstep, voffA); PG8_STAGE(PG8_SB(1, 1), cB + hstep + kstep, voffB);
        PG8_WAIT_V(6); PG8_BAR;
    } else {
        PG8_STAGE(PG8_SB(0, 0), cB, voffB); PG8_STAGE(PG8_SA(0, 0), cA, voffA); PG8_STAGE(PG8_SB(0, 1), cB + hstep, voffB); PG8_STAGE(PG8_SA(0, 1), cA + hstep, voffA);
        if (wr == 1) PG8_BAR;
        PG8_WAIT_V(4); PG8_BAR;
        PG8_STAGE(PG8_SB(1, 0), cB + kstep, voffB); PG8_STAGE(PG8_SA(1, 0), cA + kstep, voffA); PG8_STAGE(PG8_SB(1, 1), cB + hstep + kstep, voffB);
        PG8_WAIT_V(6); PG8_BAR;
    }
    for (;;) {
        const bool has_next = S.next(ui + 1, nxt);
        const char* nA = has_next ? (const char*)g.A + (size_t)nxt.pm * tstep : cA; const char* nB = has_next ? (const char*)g.Bt + (size_t)nxt.pn * tstep : cB;
        for (int t = 0; t < nt; t += 2) {
            const bool last = (t == nt - 2);
            const char* a1 = cA + (size_t)(t + 1) * kstep;
            const char* a2 = last ? nA : cA + (size_t)(t + 2) * kstep; const char* b2 = last ? nB : cB + (size_t)(t + 2) * kstep;
            const char* a3 = a2 + kstep; const char* b3 = b2 + kstep;
            if (last && has_next) S.a_ready(nxt);
            if constexpr (SP2) {
            PG8_LDB(B0, 0, 0); PG8_LDB(B1, 0, 1); PG8_SCHED; PG8_LDA(At, 0, 0); PG8_STAGE(PG8_SA(1, 1), a1 + hstep, voffA);
            PG8_WAIT_V(8); PG8_WAIT_L(0); PG8_BAR; PG8_MMA(0, 0, At, B0); PG8_MMA(0, 1, At, B1); PG8_BAR; PG8_SCHED;
            PG8_LDA(At, 0, 1); PG8_STAGE(PG8_SB(0, 0), b2, voffB); PG8_STAGE(PG8_SB(0, 1), b2 + hstep, voffB); PG8_STAGE(PG8_SA(0, 0), a2, voffA);
            PG8_WAIT_V(8); PG8_WAIT_L(0); PG8_BAR; PG8_MMA(1, 0, At, B0); PG8_MMA(1, 1, At, B1); PG8_BAR; PG8_SCHED;
            PG8_LDB(B0, 1, 0); PG8_LDB(B1, 1, 1); PG8_SCHED; PG8_LDA(At, 1, 0); PG8_STAGE(PG8_SA(0, 1), a2 + hstep, voffA);
            PG8_WAIT_V(8); PG8_WAIT_L(0); PG8_BAR; PG8_MMA(0, 0, At, B0); PG8_MMA(0, 1, At, B1); PG8_BAR; PG8_SCHED;
            PG8_LDA(At, 1, 1); PG8_STAGE(PG8_SB(1, 0), b3, voffB); PG8_STAGE(PG8_SB(1, 1), b3 + hstep, voffB); PG8_STAGE(PG8_SA(1, 0), a3, voffA);
            PG8_WAIT_V(8); PG8_WAIT_L(0); PG8_BAR; PG8_MMA(1, 0, At, B0); PG8_MMA(1, 1, At, B1); PG8_BAR; PG8_SCHED;
            } else {
            PG8_LDB(B0, 0, 0); PG8_SCHED; PG8_LDA(At, 0, 0); PG8_STAGE(PG8_SA(1, 1), a1 + hstep, voffA);
            PG8_WAIT_L(8); PG8_BAR; PG8_WAIT_L(0); PG8_MMA(0, 0, At, B0); PG8_BAR; PG8_SCHED;
            PG8_LDB(B1, 0, 1); PG8_STAGE(PG8_SB(0, 0), b2, voffB);
            PG8_BAR; PG8_WAIT_L(0); PG8_MMA(0, 1, At, B1); PG8_BAR;
            PG8_LDA(At, 0, 1); PG8_STAGE(PG8_SA(0, 0), a2, voffA);
            PG8_BAR; PG8_WAIT_L(0); PG8_MMA(1, 0, At, B0); PG8_BAR; PG8_SCHED;
            PG8_STAGE(PG8_SB(0, 1), b2 + hstep, voffB);
            PG8_WAIT_V(6); PG8_BAR; PG8_MMA(1, 1, At, B1); PG8_BAR;
            PG8_LDB(B0, 1, 0); PG8_SCHED; PG8_LDA(At, 1, 0); PG8_STAGE(PG8_SA(0, 1), a2 + hstep, voffA);
            PG8_WAIT_L(8); PG8_BAR; PG8_WAIT_L(0); PG8_MMA(0, 0, At, B0); PG8_BAR; PG8_SCHED;
            PG8_LDB(B1, 1, 1); PG8_STAGE(PG8_SB(1, 0), b3, voffB);
            PG8_BAR; PG8_WAIT_L(0); PG8_MMA(0, 1, At, B1); PG8_BAR;
            PG8_LDA(At, 1, 1); PG8_STAGE(PG8_SA(1, 0), a3, voffA);
            PG8_BAR; PG8_WAIT_L(0); PG8_MMA(1, 0, At, B0); PG8_BAR; PG8_SCHED;
            PG8_STAGE(PG8_SB(1, 1), b3 + hstep, voffB);
            PG8_WAIT_V(6); PG8_BAR; PG8_MMA(1, 1, At, B1); PG8_BAR;
            }
        }
        if constexpr (ALIGN_EPI) { if (wr == 0) PG8_BAR; }
        if constexpr (!Epi::AFTER_DRAIN) { E(acc, cur, wr, wc, fr, fq); S.done(cur); }
        if (!has_next) break;
#pragma unroll
        for (int a = 0; a < 2; ++a)
#pragma unroll
            for (int b = 0; b < 2; ++b)
#pragma unroll
                for (int m = 0; m < 4; ++m)
#pragma unroll
                    for (int n = 0; n < 2; ++n) acc[a][b][m][n] = (f32x4){0.f, 0.f, 0.f, 0.f};
        cur = nxt; cA = nA; cB = nB; ++ui;
        if constexpr (ALIGN_EPI) { if (wr == 1) PG8_BAR; }
    }
    PG8_WAIT_V(0);
    if constexpr (!ALIGN_EPI) { if (wr == 0) PG8_BAR; }
    PG8_BAR;
    if constexpr (Epi::AFTER_DRAIN) { E.fused(acc, cur, wr, wc, fr, fq, lds, wid, lane); S.done(cur); }
#undef PG8_SA
#undef PG8_SB
#undef PG8_STAGE
#undef PG8_LDA
#undef PG8_LDB
#undef PG8_MMA
#undef PG8_WAIT_V
#undef PG8_WAIT_L
#undef PG8_BAR
#undef PG8_SCHED
}
template <class Epi, class Sched>
__device__ __forceinline__ void gemm_phase_x(PG8_LAS unsigned char* lds, const Gemm g, const int Mx, const Sched& S, const Epi& E) {
    const int tid = threadIdx.x, wid = __builtin_amdgcn_readfirstlane(tid >> 6), lane = tid & 63, wr = wid >> 2, wc = wid & 3, fr = lane & 15, fq = lane >> 4;
    const int K = g.K, nt = K / BK;
    unsigned voffA, voffB, voffE;
    { int R, C; stage_rc(tid * 16, R, C); const int Rb = Epi::PERM ? ((R & ~31) + perm32(R & 31)) : R;
        voffA = (unsigned)(R * K + C) * 2u; voffB = (unsigned)(Rb * K + C) * 2u; }
    { const int b = tid * 4; int R, C; stage_rc(b & ~15, R, C); C += (b & 15) >> 1; voffE = (unsigned)(R * K + C) * 2u; }
    const size_t kstep = (size_t)(BK * 2);
    const size_t hstep = (size_t)HALF * K * 2;
    const size_t tstep = 2 * hstep;
    const size_t qstep = (size_t)64 * K * 2;
    const size_t estep = (size_t)16 * K * 2;
    const unsigned ldsw = (unsigned)wid * 1024u;
    const int aoff = lds_byte(wr * 64 + fr, fq * 8), boff = lds_byte(wc * 32 + fr, fq * 8), eoff = lds_byte(fr, fq * 8);
    constexpr int ES0 = 135168;
#define PG8_SA(b, h) (((b) * 2 + (h)) * HTB)
#define PG8_SB(b, h) ((4 + (b) * 2 + (h)) * HTB)
#define PG8_STAGE(bufoff, gbase, voff) do { _Pragma("unroll") for (int _i = 0; _i < 2; ++_i) \
        __builtin_amdgcn_global_load_lds((const unsigned*)((const char*)(gbase) + (size_t)_i * qstep + (voff)), (PG8_LAS unsigned*)(lds + (bufoff) + ldsw + _i * 8192), 16, 0, 0); } while (0)
#define PG8_STAGE_E(b, gbase) __builtin_amdgcn_global_load_lds((const unsigned*)((const char*)(gbase) + voffE), (PG8_LAS unsigned*)(lds + ES0 + (b) * 2048 + wid * 256), 4, 0, 0)
#define PG8_LDA(dst, b, h) do { _Pragma("unroll") for (int m = 0; m < 4; ++m) _Pragma("unroll") for (int k = 0; k < 2; ++k) dst[m][k] = *(const PG8_LAS bf16x8*)(lds + PG8_SA(b, h) + aoff + m * 2048 + k * 1024); } while (0)
#define PG8_LDB(dst, b, h) do { _Pragma("unroll") for (int n = 0; n < 2; ++n) _Pragma("unroll") for (int k = 0; k < 2; ++k) dst[n][k] = *(const PG8_LAS bf16x8*)(lds + PG8_SB(b, h) + boff + n * 2048 + k * 1024); } while (0)
#define PG8_LDE(dst, b) do { _Pragma("unroll") for (int k = 0; k < 2; ++k) dst[k] = *(const PG8_LAS bf16x8*)(lds + ES0 + (b) * 2048 + eoff + k * 1024); } while (0)
#define PG8_MMA(ai, bj, At, Bt) do { __builtin_amdgcn_s_setprio(1); _Pragma("unroll") for (int m = 0; m < 4; ++m) _Pragma("unroll") for (int n = 0; n < 2; ++n) _Pragma("unroll") for (int k = 0; k < 2; ++k) \
        acc[ai][bj][m][n] = __builtin_amdgcn_mfma_f32_16x16x32_bf16(Bt[n][k], At[m][k], acc[ai][bj][m][n], 0, 0, 0); __builtin_amdgcn_s_setprio(0); } while (0)
#define PG8_MMA_E(Bt) do { _Pragma("unroll") for (int n = 0; n < 2; ++n) _Pragma("unroll") for (int k = 0; k < 2; ++k) accE[n] = __builtin_amdgcn_mfma_f32_16x16x32_bf16(Bt[n][k], Et[k], accE[n], 0, 0, 0); } while (0)
#define PG8_WAIT_V(n) asm volatile("s_waitcnt vmcnt(" #n ")" ::: "memory")
#define PG8_WAIT_L(n) asm volatile("s_waitcnt lgkmcnt(" #n ")" ::: "memory")
#define PG8_BAR __builtin_amdgcn_s_barrier()
#define PG8_SCHED __builtin_amdgcn_sched_barrier(0)
    Unit cur, nxt; int ui = 0;
    if (!S.next(0, cur)) return;
    f32x4 acc[2][2][4][2], accE[2];
#pragma unroll
    for (int a = 0; a < 2; ++a)
#pragma unroll
        for (int b = 0; b < 2; ++b)
#pragma unroll
            for (int m = 0; m < 4; ++m)
#pragma unroll
                for (int n = 0; n < 2; ++n) acc[a][b][m][n] = (f32x4){0.f, 0.f, 0.f, 0.f};
    accE[0] = (f32x4){0.f, 0.f, 0.f, 0.f}; accE[1] = accE[0];
    bf16x8 At[4][2], B0[2][2], B1[2][2], Et[2];
    const char* cA = (const char*)g.A + (size_t)cur.pm * tstep; const char* cB = (const char*)g.Bt + (size_t)cur.pn * tstep;
    const char* cE = (const char*)g.A + (size_t)Mx * K * 2 + (size_t)cur.pm * estep;
    S.a_ready(cur);
    PG8_STAGE(PG8_SB(0, 0), cB, voffB); PG8_STAGE(PG8_SB(0, 1), cB + hstep, voffB); PG8_STAGE(PG8_SA(0, 0), cA, voffA); PG8_STAGE_E(0, cE); PG8_STAGE(PG8_SA(0, 1), cA + hstep, voffA);
    if (wr == 1) PG8_BAR;
    PG8_WAIT_V(2); PG8_BAR;
    PG8_STAGE(PG8_SB(1, 0), cB + kstep, voffB); PG8_STAGE(PG8_SA(1, 0), cA + kstep, voffA); PG8_STAGE(PG8_SB(1, 1), cB + hstep + kstep, voffB);
    PG8_WAIT_V(6); PG8_BAR;
    for (;;) {
        const bool has_next = S.next(ui + 1, nxt);
        const char* nA = has_next ? (const char*)g.A + (size_t)nxt.pm * tstep : cA; const char* nB = has_next ? (const char*)g.Bt + (size_t)nxt.pn * tstep : cB;
        const char* nE = has_next ? (const char*)g.A + (size_t)Mx * K * 2 + (size_t)nxt.pm * estep : cE;
        for (int t = 0; t < nt; t += 2) {
            const bool last = (t == nt - 2);
            const char* a1 = cA + (size_t)(t + 1) * kstep;
            const char* a2 = last ? nA : cA + (size_t)(t + 2) * kstep; const char* b2 = last ? nB : cB + (size_t)(t + 2) * kstep; const char* e2 = last ? nE : cE + (size_t)(t + 2) * kstep;
            const char* a3 = a2 + kstep; const char* b3 = b2 + kstep; const char* e1 = cE + (size_t)(t + 1) * kstep;
            if (last && has_next) S.a_ready(nxt);
            PG8_LDB(B0, 0, 0); PG8_LDB(B1, 0, 1); PG8_SCHED; PG8_LDA(At, 0, 0); PG8_STAGE_E(1, e1); PG8_STAGE(PG8_SA(1, 1), a1 + hstep, voffA);
            PG8_WAIT_V(9); PG8_WAIT_L(0); PG8_BAR; PG8_MMA(0, 0, At, B0); PG8_MMA(0, 1, At, B1); PG8_SCHED; PG8_LDE(Et, 0); PG8_WAIT_L(0); if (wr == 0) PG8_MMA_E(B0); else PG8_MMA_E(B1); PG8_BAR; PG8_SCHED;
            PG8_LDA(At, 0, 1); PG8_STAGE(PG8_SB(0, 0), b2, voffB); PG8_STAGE(PG8_SB(0, 1), b2 + hstep, voffB); PG8_STAGE(PG8_SA(0, 0), a2, voffA);
            PG8_WAIT_V(8); PG8_WAIT_L(0); PG8_BAR; PG8_MMA(1, 0, At, B0); PG8_MMA(1, 1, At, B1); PG8_BAR; PG8_SCHED;
            PG8_LDB(B0, 1, 0); PG8_LDB(B1, 1, 1); PG8_SCHED; PG8_LDA(At, 1, 0); PG8_STAGE_E(0, e2); PG8_STAGE(PG8_SA(0, 1), a2 + hstep, voffA);
            PG8_WAIT_V(9); PG8_WAIT_L(0); PG8_BAR; PG8_MMA(0, 0, At, B0); PG8_MMA(0, 1, At, B1); PG8_SCHED; PG8_LDE(Et, 1); PG8_WAIT_L(0); if (wr == 0) PG8_MMA_E(B0); else PG8_MMA_E(B1); PG8_BAR; PG8_SCHED;
            PG8_LDA(At, 1, 1); PG8_STAGE(PG8_SB(1, 0), b3, voffB); PG8_STAGE(PG8_SB(1, 1), b3 + hstep, voffB); PG8_STAGE(PG8_SA(1, 0), a3, voffA);
            PG8_WAIT_V(8); PG8_WAIT_L(0); PG8_BAR; PG8_MMA(1, 0, At, B0); PG8_MMA(1, 1, At, B1); PG8_BAR; PG8_SCHED;
        }
        if (wr == 0) PG8_BAR;
        E(acc, cur, wr, wc, fr, fq); E.extra(accE, cur, wr, wc, fr, fq); S.done(cur);
        if (!has_next) break;
#pragma unroll
        for (int a = 0; a < 2; ++a)
#pragma unroll
            for (int b = 0; b < 2; ++b)
#pragma unroll
                for (int m = 0; m < 4; ++m)
#pragma unroll
                    for (int n = 0; n < 2; ++n) acc[a][b][m][n] = (f32x4){0.f, 0.f, 0.f, 0.f};
        accE[0] = (f32x4){0.f, 0.f, 0.f, 0.f}; accE[1] = accE[0];
        cur = nxt; cA = nA; cB = nB; cE = nE; ++ui;
        if (wr == 1) PG8_BAR;
    }
    PG8_WAIT_V(0);
    PG8_BAR;
#undef PG8_SA
#undef PG8_SB
#undef PG8_STAGE
#undef PG8_STAGE_E
#undef PG8_LDA
#undef PG8_LDB
#undef PG8_LDE
#undef PG8_MMA
#undef PG8_MMA_E
#undef PG8_WAIT_V
#undef PG8_WAIT_L
#undef PG8_BAR
#undef PG8_SCHED
}
}
constexpr int NWAVES = 8;
#ifndef MK_N_LAUNCHES
#define MK_N_LAUNCHES 1
#endif
constexpr int N_PHASES = 14;
constexpr int MROWS = 17408, MP = 16384, DM = 1024, DFF = 4096, NIN1 = 3088, NIN1P = 3328;
constexpr size_t MiB = 1u << 20;
constexpr size_t WS_CTL = 0, CTL_ZERO_BYTES = 1 * MiB;
constexpr size_t WS_SS = 128 * 1024;
constexpr size_t WS_LB = 1 * MiB;
constexpr size_t WS_WIN0 = 2 * MiB, WS_WOUT0 = 10 * MiB, WS_WUP0 = 12 * MiB, WS_WDN0 = 20 * MiB, WS_WIN1 = 28 * MiB, WS_WOUT1 = 35 * MiB, WS_WUP1 = 37 * MiB, WS_WDN1 = 45 * MiB;
constexpr size_t WS_XB = 53 * MiB;
constexpr size_t WS_ACT = 87 * MiB;
constexpr size_t ACT_T = (size_t)MROWS * 1024 * 2;
constexpr size_t WS_Q = WS_ACT, WS_LF = WS_ACT + ACT_T, WS_V = WS_ACT + 2 * ACT_T, WS_G = WS_ACT + 3 * ACT_T;
constexpr size_t WS_QM = WS_ACT, WS_KM = WS_ACT + ACT_T / 2, WS_VM = WS_ACT + ACT_T, WS_OM = WS_ACT + 2 * ACT_T, WS_GT = WS_ACT + 3 * ACT_T;
constexpr size_t WS_END = WS_ACT + 4 * ACT_T;
static_assert(WS_END <= 224 * MiB, "d_ws map");
constexpr int CW_BAR = 4096;
constexpr size_t OUT_Y = 0, OUT_SP = 17825792, OUT_CP = 18874368, OUT_NP = 19398656, OUT_MP = 19402752, OUT_SS = 19402816, OUT_CS = 36180032, OUT_NS = 44568640, OUT_MS = 44634176, OUT_END = 44635200;
constexpr int RING_BYTES = 131072, LDSCTL_OFF = RING_BYTES, MISC_OFF = LDSCTL_OFF + 320, LDS_BYTES = 147456;

#define GAS __attribute__((address_space(1)))
#define LAS __attribute__((address_space(3)))
typedef unsigned short bf16;
typedef unsigned v4u __attribute__((ext_vector_type(4)));
typedef unsigned v2u __attribute__((ext_vector_type(2)));
typedef float f32x4 __attribute__((ext_vector_type(4)));
typedef float f32x2 __attribute__((ext_vector_type(2)));
typedef short bf16x8 __attribute__((ext_vector_type(8)));
typedef GAS unsigned gu32;
#define RLX_AGENT __ATOMIC_RELAXED, __HIP_MEMORY_SCOPE_AGENT
#define LDS_WAIT() asm volatile("s_waitcnt lgkmcnt(0)" ::: "memory")
#define VM_WAIT() asm volatile("s_waitcnt vmcnt(0)" ::: "memory")
__device__ __forceinline__ unsigned f2bf(float f) { unsigned u = __builtin_bit_cast(unsigned, f); return (u + 0x7fffu + ((u >> 16) & 1u)) >> 16; }
typedef __bf16 bf16x2c __attribute__((ext_vector_type(2)));
__device__ __forceinline__ unsigned pk2(float lo, float hi) { f32x2 v = {lo, hi}; bf16x2c b = __builtin_convertvector(v, bf16x2c); return __builtin_bit_cast(unsigned, b); }
__device__ __forceinline__ float bflo(unsigned w) { return __builtin_bit_cast(float, w << 16); }
__device__ __forceinline__ float bfhi(unsigned w) { return __builtin_bit_cast(float, w & 0xffff0000u); }
__device__ __forceinline__ float bf1(unsigned short h) { return __builtin_bit_cast(float, (unsigned)h << 16); }
__device__ __forceinline__ float hlo(unsigned w) { return (float)__builtin_bit_cast(_Float16, (unsigned short)(w & 0xffffu)); }
__device__ __forceinline__ float hhi(unsigned w) { return (float)__builtin_bit_cast(_Float16, (unsigned short)(w >> 16)); }
__device__ __forceinline__ float h1(unsigned short h) { return (float)__builtin_bit_cast(_Float16, h); }

#define XB_TMO      128
#define XB_XCNT(j)  (256  + 64 * (j))
#define XB_XSUB(j)  (1280 + 64 * (j))
#define XB_XGEN(j)  (2304 + 64 * (j))
#define XB_TOP      3328
#define XB_TOPGEN   3392
#define XCD_BAR_WORDS 3456
#define XB_SPIN_CAP (1u << 18)
__device__ __forceinline__ unsigned xb_ld(unsigned* p)              { return __hip_atomic_load(p, __ATOMIC_RELAXED, __HIP_MEMORY_SCOPE_AGENT); }
__device__ __forceinline__ unsigned xb_add(unsigned* p, unsigned v) { return __hip_atomic_fetch_add(p, v, __ATOMIC_RELAXED, __HIP_MEMORY_SCOPE_AGENT); }
__device__ __forceinline__ unsigned xb_xcc_id() { return (unsigned)__builtin_amdgcn_s_getreg((3 << 11) | 20) & 0xFu; }
#define XB_SPIN(cond, bar) do { unsigned _sp = 0; while (cond) { __builtin_amdgcn_s_sleep(1); \
    if ((++_sp & 255u) == 0u) { if (xb_ld(&(bar)[XB_TMO])) break; if (_sp > XB_SPIN_CAP) { atomicAdd(&(bar)[XB_TMO], 1u); break; } } } } while (0)
struct XcdBarrier { unsigned* bar; unsigned x; volatile LAS unsigned* st; };
__device__ __forceinline__ XcdBarrier xcd_barrier_post(unsigned* bar, volatile LAS unsigned* st) {
    XcdBarrier b; b.bar = bar; b.x = xb_xcc_id(); b.st = st;
    if (threadIdx.x == 0) (void)xb_add(&bar[XB_XCNT(b.x)], 1u);
    return b;
}
__device__ __forceinline__ void xcd_barrier_complete(unsigned* bar, unsigned x, unsigned& nloc, unsigned& nx) {
    const unsigned G = gridDim.x * gridDim.y * gridDim.z;
    unsigned sum, cnt, mine, sp = 0u;
    for (;;) {
        sum = 0u; cnt = 0u; mine = 0u;
#pragma unroll
        for (unsigned j = 0; j < 16; ++j) { const unsigned c = xb_ld(&bar[XB_XCNT(j)]); sum += c; cnt += (c > 0u) ? 1u : 0u; mine = (j == x) ? c : mine; }
        if (sum == G) break;
        __builtin_amdgcn_s_sleep(1);
        if ((++sp & 255u) == 0u) { if (xb_ld(&bar[XB_TMO])) break; if (sp > XB_SPIN_CAP) { atomicAdd(&bar[XB_TMO], 1u); break; } }
    }
    nloc = mine > 0u ? mine : 1u; nx = cnt > 0u ? cnt : 1u;
}
__device__ __forceinline__ void xcd_barrier(const XcdBarrier& b) {
    asm volatile("s_waitcnt vmcnt(0)" ::: "memory");
    __syncthreads();
    if (threadIdx.x == 0) {
        unsigned* bar = b.bar;
        __builtin_amdgcn_s_waitcnt(0);
        unsigned nloc = b.st[0], nx = b.st[1];
        if (nloc == 0u) { xcd_barrier_complete(bar, b.x, nloc, nx); b.st[0] = nloc; b.st[1] = nx; }
        const unsigned old = xb_add(&bar[XB_XSUB(b.x)], 1u);
        const unsigned gen = old / nloc;
        if (old + 1u == (gen + 1u) * nloc) {
            __builtin_amdgcn_fence(__ATOMIC_RELEASE, "agent");
            asm volatile("s_waitcnt vmcnt(0)" ::: "memory");
            const unsigned og = xb_add(&bar[XB_TOP], 1u);
            const unsigned tg = og / nx;
            if (og + 1u == (tg + 1u) * nx) xb_add(&bar[XB_TOPGEN], 1u);
            else XB_SPIN(xb_ld(&bar[XB_TOPGEN]) == tg, bar);
            __builtin_amdgcn_fence(__ATOMIC_ACQUIRE, "agent");
            xb_add(&bar[XB_XGEN(b.x)], 1u);
            asm volatile("s_waitcnt vmcnt(0)" ::: "memory");
        } else {
            XB_SPIN(xb_ld(&bar[XB_XGEN(b.x)]) == gen, bar);
            __builtin_amdgcn_fence(__ATOMIC_ACQUIRE, "agent");
            asm volatile("s_waitcnt vmcnt(0)" ::: "memory");
        }
    }
    __syncthreads();
}

__device__ __forceinline__ float wave_sum(float v) {
#pragma unroll
    for (int o = 1; o < 64; o <<= 1) v += __shfl_xor(v, o);
    return v;
}
__device__ __forceinline__ void p0_transpose_item(const float* W, int K, int N, const float* sc, bf16* WT, LAS float* scr, int item, int lane) {
    const int nblk = (N + 31) / 32, kb = item / nblk, nb = item % nblk, k0 = 64 * kb, n0 = 32 * nb;
    const bool nok = (n0 + (lane & 31)) < N;
#pragma unroll 8
    for (int i = 0; i < 32; ++i) { const int kk = 2 * i + (lane >> 5); float v = nok ? W[(size_t)(k0 + kk) * N + n0 + (lane & 31)] : 0.f; if (sc) v *= sc[k0 + kk]; scr[kk * 33 + (lane & 31)] = v; }
    LDS_WAIT(); asm volatile("" ::: "memory");
    const int c = lane & 7;
#pragma unroll
    for (int j = 0; j < 4; ++j) { const int n = (lane >> 3) + 8 * j; const LAS float* s = scr + (8 * c) * 33 + n;
        v4u o; o.x = pk2(s[0 * 33], s[1 * 33]); o.y = pk2(s[2 * 33], s[3 * 33]); o.z = pk2(s[4 * 33], s[5 * 33]); o.w = pk2(s[6 * 33], s[7 * 33]);
        *(GAS v4u*)(WT + (size_t)(n0 + n) * K + k0 + 8 * c) = o; }
    LDS_WAIT(); asm volatile("" ::: "memory");
}
#define MFMA16(a, b, c) __builtin_amdgcn_mfma_f32_16x16x32_bf16((a), (b), (c), 0, 0, 0)
#define LDSV(T, off) (*(LAS T*)(lds + (off)))
#define LDSF(off) (*(const LAS bf16x8*)(lds + (off)))
#define BAR_LDS() do { asm volatile("s_waitcnt lgkmcnt(0)" ::: "memory"); __builtin_amdgcn_s_barrier(); asm volatile("" ::: "memory"); } while (0)
namespace hg {
constexpr int QP = 0, KP = QP + 64 * 272, KPPT = KP + 64 * 272, VT = KPPT + 128 * 144, AM = VT + 128 * 144, ST = AM + 64 * 144, GT = ST + 128 * 272, DEC = GT + 8 * 128 * 4, NP = DEC + 512, END = NP + 512;
static_assert(END <= RING_BYTES, "hgrn LDS");
}
template <bool STATE_ONLY>
__device__ __forceinline__ void hgrn_seg_item(LAS unsigned char* lds, int b, int h, int g, const bf16* Qb, const bf16* LFb, const bf16* Vb, const bf16* Gb, bf16* Ob, const float* onw, float* Escr, float* Dscr, float* S_out) {
    using namespace hg;
    constexpr int NCH = 8;
    const int tid = threadIdx.x, lane = tid & 63, w = __builtin_amdgcn_readfirstlane(tid >> 6), fr = lane & 15, fq = lane >> 4;
    const int tb = w & 3, wh = w >> 2;
    const size_t rowb = (size_t)b * 2048 + (size_t)g * 512;
    const int colp = h * 128 + 2 * lane;
    const int item0 = (b * 8 + h) * 4;
    __syncthreads();
    f32x4 sacc[8];
#pragma unroll
    for (int j = 0; j < 8; ++j) sacc[j] = (f32x4){0.f, 0.f, 0.f, 0.f};
    if (!STATE_ONLY && g > 0) {
#pragma unroll
        for (int j = 0; j < 8; ++j) sacc[j] = *(const f32x4*)(Escr + ((size_t)item0 * 16384) + ((w * 8 + j) * 64 + lane) * 4);
        for (int gg = 1; gg < g; ++gg) { const f32x4 dec = *(const f32x4*)(Dscr + (item0 + gg) * 128 + 16 * w + 4 * fq);
#pragma unroll
            for (int j = 0; j < 8; ++j) sacc[j] = sacc[j] * dec + *(const f32x4*)(Escr + ((size_t)(item0 + gg) * 16384) + ((w * 8 + j) * 64 + lane) * 4); }
#pragma unroll
        for (int j = 0; j < 8; ++j) LDSV(v2u, ST + (j * 16 + fr) * 272 + (16 * w + 4 * fq) * 2) = (v2u){pk2(sacc[j][0], sacc[j][1]), pk2(sacc[j][2], sacc[j][3])};
    } else if (!STATE_ONLY) {
        for (int i = tid; i < 128 * 272 / 4; i += 512) LDSV(unsigned, ST + 4 * i) = 0u;
    }
    __syncthreads();
    f32x4 wn[4];
#pragma unroll
    for (int j = 0; j < 4; ++j) wn[j] = *(const f32x4*)(onw + h * 128 + (4 * wh + j) * 16 + 4 * fq);
    unsigned rq[8], rl[8], rv[8]; float bp0 = 0.f, bp1 = 0.f;
#pragma unroll
    for (int i = 0; i < 8; ++i) { const size_t e = (rowb + 8 * w + i) * 1024 + colp; if (!STATE_ONLY) rq[i] = *(const unsigned*)(Qb + e); rl[i] = *(const unsigned*)(LFb + e); rv[i] = *(const unsigned*)(Vb + e); }
    for (int c = 0; c < NCH; ++c) {
        float c0[8], c1[8]; { float a0 = 0.f, a1 = 0.f;
#pragma unroll
            for (int i = 0; i < 8; ++i) { a0 += hlo(rl[i]); a1 += hhi(rl[i]); c0[i] = a0; c1[i] = a1; }
            LDSV(f32x2, GT + (w * 128 + 2 * lane) * 4) = (f32x2){a0, a1}; }
        BAR_LDS();
        float pre0 = 0.f, pre1 = 0.f, tot0 = 0.f, tot1 = 0.f;
#pragma unroll
        for (int gi = 0; gi < 8; ++gi) { const f32x2 x = LDSV(f32x2, GT + (gi * 128 + 2 * lane) * 4); tot0 += x.x; tot1 += x.y; if (gi < w) { pre0 += x.x; pre1 += x.y; } }
        if (w == 0) LDSV(f32x2, DEC + 2 * lane * 4) = (f32x2){__expf(tot0), __expf(tot1)};
        bp0 += tot0; bp1 += tot1;
        { unsigned kk0[4], kk1[4], vv0[4], vv1[4]; float pk0 = 0.f, pk1 = 0.f;
#pragma unroll
            for (int i = 0; i < 8; ++i) {
                const float b0 = pre0 + c0[i], b1 = pre1 + c1[i];
                const float k0 = 1.0f - __expf(hlo(rl[i])), k1 = 1.0f - __expf(hhi(rl[i]));
                const float l0 = __expf(tot0 - b0), l1 = __expf(tot1 - b1);
                if (!STATE_ONLY) { const float e0 = __expf(b0), e1 = __expf(b1), n0 = __expf(-b0), n1 = __expf(-b1);
                    LDSV(unsigned, QP + (8 * w + i) * 272 + 4 * lane) = pk2(bflo(rq[i]) * e0, bfhi(rq[i]) * e1);
                    LDSV(unsigned, KP + (8 * w + i) * 272 + 4 * lane) = pk2(k0 * n0, k1 * n1); }
                const float x0 = k0 * l0, x1 = k1 * l1;
                if (i & 1) { kk0[i >> 1] = pk2(pk0, x0); kk1[i >> 1] = pk2(pk1, x1); vv0[i >> 1] = (rv[i - 1] & 0xffffu) | (rv[i] << 16); vv1[i >> 1] = (rv[i - 1] >> 16) | (rv[i] & 0xffff0000u); }
                else { pk0 = x0; pk1 = x1; }
            }
            LDSV(v4u, KPPT + (2 * lane) * 144 + 16 * w) = (v4u){kk0[0], kk0[1], kk0[2], kk0[3]};
            LDSV(v4u, KPPT + (2 * lane + 1) * 144 + 16 * w) = (v4u){kk1[0], kk1[1], kk1[2], kk1[3]};
            LDSV(v4u, VT + (2 * lane) * 144 + 16 * w) = (v4u){vv0[0], vv0[1], vv0[2], vv0[3]};
            LDSV(v4u, VT + (2 * lane + 1) * 144 + 16 * w) = (v4u){vv1[0], vv1[1], vv1[2], vv1[3]}; }
        const size_t orow = (rowb + (size_t)c * 64 + tb * 16 + fr) * 1024 + h * 128 + 4 * fq;
        v2u rg[4];
        if (!STATE_ONLY) {
#pragma unroll
            for (int j = 0; j < 4; ++j) rg[j] = *(const v2u*)(Gb + orow + (4 * wh + j) * 16);
        }
        if (c + 1 < NCH) {
#pragma unroll
            for (int i = 0; i < 8; ++i) { const size_t e = (rowb + (size_t)(c + 1) * 64 + 8 * w + i) * 1024 + colp; if (!STATE_ONLY) rq[i] = *(const unsigned*)(Qb + e); rl[i] = *(const unsigned*)(LFb + e); rv[i] = *(const unsigned*)(Vb + e); }
        }
        BAR_LDS();
        f32x4 oacc[4];
        if (!STATE_ONLY) {
#pragma unroll
        for (int j = 0; j < 2; ++j) { const int sb = 2 * wh + j; f32x4 a = (f32x4){0.f, 0.f, 0.f, 0.f};
            if (sb <= tb) {
#pragma unroll
                for (int kk = 0; kk < 4; ++kk) a = MFMA16(LDSF(KP + (sb * 16 + fr) * 272 + kk * 64 + fq * 16), LDSF(QP + (tb * 16 + fr) * 272 + kk * 64 + fq * 16), a);
                const int t = tb * 16 + fr, s0 = sb * 16 + 4 * fq;
#pragma unroll
                for (int r = 0; r < 4; ++r) if (s0 + r > t) a[r] = 0.f;
            }
            LDSV(v2u, AM + (tb * 16 + fr) * 144 + (sb * 16 + 4 * fq) * 2) = (v2u){pk2(a[0], a[1]), pk2(a[2], a[3])}; }
        BAR_LDS();
        { bf16x8 bA[2], bQ[4];
#pragma unroll
            for (int kk = 0; kk < 2; ++kk) bA[kk] = LDSF(AM + (tb * 16 + fr) * 144 + kk * 64 + fq * 16);
#pragma unroll
            for (int kk = 0; kk < 4; ++kk) bQ[kk] = LDSF(QP + (tb * 16 + fr) * 272 + kk * 64 + fq * 16);
#pragma unroll
            for (int j = 0; j < 4; ++j) { const int dvb = 4 * wh + j; f32x4 a = (f32x4){0.f, 0.f, 0.f, 0.f};
#pragma unroll
                for (int kk = 0; kk < 2; ++kk) a = MFMA16(LDSF(VT + (dvb * 16 + fr) * 144 + kk * 64 + fq * 16), bA[kk], a);
#pragma unroll
                for (int kk = 0; kk < 4; ++kk) a = MFMA16(LDSF(ST + (dvb * 16 + fr) * 272 + kk * 64 + fq * 16), bQ[kk], a);
                oacc[j] = a; } }
        { float ss = 0.f;
#pragma unroll
            for (int j = 0; j < 4; ++j) ss += (oacc[j][0] * oacc[j][0] + oacc[j][1] * oacc[j][1]) + (oacc[j][2] * oacc[j][2] + oacc[j][3] * oacc[j][3]);
            ss += __shfl_xor(ss, 16); ss += __shfl_xor(ss, 32);
            if (fq == 0) LDSV(float, NP + ((tb * 16 + fr) * 2 + wh) * 4) = ss; }
        }
        { const f32x4 dec = LDSV(f32x4, DEC + (16 * w + 4 * fq) * 4); bf16x8 aK[2];
#pragma unroll
            for (int kk = 0; kk < 2; ++kk) aK[kk] = LDSF(KPPT + (16 * w + fr) * 144 + kk * 64 + fq * 16);
#pragma unroll
            for (int j = 0; j < 8; ++j) { f32x4 a = sacc[j] * dec;
#pragma unroll
                for (int kk = 0; kk < 2; ++kk) a = MFMA16(aK[kk], LDSF(VT + (j * 16 + fr) * 144 + kk * 64 + fq * 16), a);
                sacc[j] = a; } }
        BAR_LDS();
        if (!STATE_ONLY) {
        { const f32x2 p = LDSV(f32x2, NP + (tb * 16 + fr) * 8); const float rstd = rsqrtf((p.x + p.y) * (1.0f / 128.0f) + 1e-6f);
#pragma unroll
            for (int j = 0; j < 4; ++j) { const f32x4 o = oacc[j] * rstd * wn[j];
                *(v2u*)(Ob + orow + (4 * wh + j) * 16) = (v2u){pk2(o[0] * bflo(rg[j].x), o[1] * bfhi(rg[j].x)), pk2(o[2] * bflo(rg[j].y), o[3] * bfhi(rg[j].y))}; } }
#pragma unroll
        for (int j = 0; j < 8; ++j) LDSV(v2u, ST + (j * 16 + fr) * 272 + (16 * w + 4 * fq) * 2) = (v2u){pk2(sacc[j][0], sacc[j][1]), pk2(sacc[j][2], sacc[j][3])};
        }
    }
    if (STATE_ONLY) {
#pragma unroll
        for (int j = 0; j < 8; ++j) *(f32x4*)(Escr + ((size_t)(item0 + g) * 16384) + ((w * 8 + j) * 64 + lane) * 4) = sacc[j];
        if (w == 0) *(f32x2*)(Dscr + (item0 + g) * 128 + 2 * lane) = (f32x2){__expf(bp0), __expf(bp1)};
    } else if (g == 3) {
        float* so = S_out + (size_t)(b * 8 + h) * 128 * 128;
#pragma unroll
        for (int j = 0; j < 8; ++j)
#pragma unroll
            for (int r = 0; r < 4; ++r) so[(size_t)(16 * w + 4 * fq + r) * 128 + j * 16 + fr] = sacc[j][r];
    }
}
__device__ __forceinline__ void hgrn_sample_item(LAS unsigned char* lds, int b, int h, const bf16* Qb, const bf16* LFb, const bf16* Vb, const bf16* Gb, bf16* Ob, const float* onw, const float* S_in, float* S_out) {
    constexpr int FKQ = 0, VS = 16384, RED = 20480;
    const int tid = threadIdx.x, lane = tid & 63, w = __builtin_amdgcn_readfirstlane(tid >> 6), c4 = tid & 31, dg = tid >> 5;
    const size_t rowb = (size_t)MP + (size_t)b * 8;
    __syncthreads();
#pragma unroll
    for (int e = tid; e < 1024; e += 512) { const int t = e >> 7, d = e & 127; const size_t g = (rowb + t) * 1024 + h * 128 + d;
        const float f = __expf(h1(LFb[g])); LDSV(f32x4, FKQ + e * 16) = (f32x4){f, 1.0f - f, bf1(Qb[g]), 0.f}; LDSV(float, VS + e * 4) = bf1(Vb[g]); }
    const size_t sbase = ((size_t)(b * 8 + h) * 128 + 8 * dg) * 128 + 4 * c4;
    f32x4 s[8], po[8];
#pragma unroll
    for (int i = 0; i < 8; ++i) s[i] = *(const f32x4*)(S_in + sbase + (size_t)i * 128);
    __syncthreads();
#pragma unroll
    for (int t = 0; t < 8; ++t) { const f32x4 vv = LDSV(f32x4, VS + (t * 128 + 4 * c4) * 4); f32x4 p = (f32x4){0.f, 0.f, 0.f, 0.f};
#pragma unroll
        for (int i = 0; i < 8; ++i) { const f32x4 x = LDSV(f32x4, FKQ + (t * 128 + 8 * dg + i) * 16); s[i] = s[i] * x[0] + vv * x[1]; p += s[i] * x[2]; }
        po[t] = p; }
#pragma unroll
    for (int t = 0; t < 8; ++t) LDSV(f32x4, RED + ((dg * 8 + t) * 128 + 4 * c4) * 4) = po[t];
#pragma unroll
    for (int i = 0; i < 8; ++i) *(f32x4*)(S_out + sbase + (size_t)i * 128) = s[i];
    __syncthreads();
    { const int t = w; float o0 = 0.f, o1 = 0.f;
#pragma unroll
        for (int g = 0; g < 16; ++g) { const f32x2 x = LDSV(f32x2, RED + ((g * 8 + t) * 128 + 2 * lane) * 4); o0 += x.x; o1 += x.y; }
        const float rstd = rsqrtf(wave_sum(o0 * o0 + o1 * o1) * (1.0f / 128.0f) + 1e-6f);
        const size_t g = (rowb + t) * 1024 + h * 128 + 2 * lane; const unsigned gg = *(const unsigned*)(Gb + g);
        *(unsigned*)(Ob + g) = pk2(o0 * rstd * onw[h * 128 + 2 * lane] * bflo(gg), o1 * rstd * onw[h * 128 + 2 * lane + 1] * bfhi(gg)); }
}
namespace ml {
constexpr int Q = 0, K = Q + 64 * 144, KWT = K + 64 * 144, AM = KWT + 64 * 144, VTE = AM + 64 * 144, CTE = VTE + 144 * 144, AS = CTE + 144 * 144, MT = AS + 256, WI = MT + 256, EM = WI + 256, WS = EM + 256, DEN = WS + 256, SC = DEN + 256, NP = SC + 16, END = NP + 512;
static_assert(END <= RING_BYTES, "mlstm LDS");
}
template <bool STATE_ONLY>
__device__ __forceinline__ void mlstm_seg_item(LAS unsigned char* lds, int b, int h, int g, const bf16* Qm, const bf16* Km, const bf16* Vm, const bf16* Om, const float* GTg, bf16* Hb, const float* onw,
                                               float* Escr, float* Mscr, float* C_out, float* n_out, float* m_out) {
    using namespace ml;
    constexpr int NCH = 8;
    const int tid = threadIdx.x, lane = tid & 63, w = __builtin_amdgcn_readfirstlane(tid >> 6), fr = lane & 15, fq = lane >> 4;
    const int tb = w & 3, wh = w >> 2;
    const size_t rowb = (size_t)b * 2048 + (size_t)g * 512;
    const int dp = tid & 31, tg4 = tid >> 5;
    const int item0 = (b * 8 + h) * 4;
    __syncthreads();
    for (int i = tid; i < 144 * 144 / 4; i += 512) { LDSV(unsigned, CTE + 4 * i) = 0u; const int row = (4 * i) / 144; LDSV(unsigned, VTE + 4 * i) = row == 128 ? 0x3f803f80u : 0u; }
    __syncthreads();
    f32x4 cacc[5];
#pragma unroll
    for (int j = 0; j < 5; ++j) cacc[j] = (f32x4){0.f, 0.f, 0.f, 0.f};
    float m_prev = (STATE_ONLY && g > 0) ? -INFINITY : 0.f, btot = 0.f;
    if (!STATE_ONLY && g > 0) {
#pragma unroll
        for (int j = 0; j < 5; ++j) cacc[j] = *(const f32x4*)(Escr + (size_t)item0 * 10240 + ((w * 5 + j) * 64 + lane) * 4);
        m_prev = Mscr[item0 * 2];
        for (int gg = 1; gg < g; ++gg) { const float mE = Mscr[(item0 + gg) * 2], Bt = Mscr[(item0 + gg) * 2 + 1]; const float mn = fmaxf(m_prev + Bt, mE), f1 = __expf(m_prev + Bt - mn), f2 = __expf(mE - mn);
#pragma unroll
            for (int j = 0; j < 5; ++j) cacc[j] = cacc[j] * f1 + *(const f32x4*)(Escr + (size_t)(item0 + gg) * 10240 + ((w * 5 + j) * 64 + lane) * 4) * f2;
            m_prev = mn; }
#pragma unroll
        for (int j = 0; j < 5; ++j) { if (j == 4 && wh != 0) break; const int dvb = j == 4 ? 8 : 4 * wh + j;
            LDSV(v2u, CTE + (dvb * 16 + fr) * 144 + (16 * tb + 4 * fq) * 2) = (v2u){pk2(cacc[j][0], cacc[j][1]), pk2(cacc[j][2], cacc[j][3])}; }
    }
    f32x4 wn[4];
#pragma unroll
    for (int j = 0; j < 4; ++j) wn[j] = *(const f32x4*)(onw + h * 128 + (4 * wh + j) * 16 + 4 * fq);
    unsigned rq[4], rk[4], rv[8]; float gli = 0.f, glf = 0.f;
#pragma unroll
    for (int i = 0; i < 4; ++i) { const size_t e = (rowb + 4 * tg4 + i) * 512 + h * 64 + 2 * dp; if (!STATE_ONLY) rq[i] = *(const unsigned*)(Qm + e); rk[i] = *(const unsigned*)(Km + e); }
#pragma unroll
    for (int i = 0; i < 8; ++i) rv[i] = *(const unsigned*)(Vm + (rowb + 8 * w + i) * 1024 + h * 128 + 2 * lane);
    if (w == 0) { gli = GTg[(rowb + lane) * 16 + h]; glf = GTg[(rowb + lane) * 16 + 8 + h]; }
    for (int c = 0; c < NCH; ++c) {
        if (w == 0) {
            float bs = glf;
#pragma unroll
            for (int o = 1; o < 64; o <<= 1) { const float x = __shfl_up(bs, o); if (lane >= o) bs += x; }
            const float a = gli - bs; float pm = a;
#pragma unroll
            for (int o = 1; o < 64; o <<= 1) { const float x = __shfl_up(pm, o); if (lane >= o) pm = fmaxf(pm, x); }
            const float Mt = fmaxf(m_prev, pm), M63 = __shfl(Mt, 63), b63 = __shfl(bs, 63);
            LDSV(float, AS + 4 * lane) = a; LDSV(float, MT + 4 * lane) = Mt; LDSV(float, WI + 4 * lane) = __expf(m_prev - Mt); LDSV(float, EM + 4 * lane) = __expf(-(bs + Mt)); LDSV(float, WS + 4 * lane) = __expf(a - M63);
            if (lane == 0) { LDSV(float, SC) = __expf(m_prev - M63); LDSV(float, SC + 4) = b63 + M63; LDSV(float, SC + 8) = b63; }
        }
        if (!STATE_ONLY) {
#pragma unroll
            for (int i = 0; i < 4; ++i) { LDSV(unsigned, Q + (4 * tg4 + i) * 144 + 4 * dp) = rq[i]; LDSV(unsigned, K + (4 * tg4 + i) * 144 + 4 * dp) = rk[i]; }
        }
        LDSV(v4u, VTE + (2 * lane) * 144 + 16 * w) = (v4u){(rv[0] & 0xffffu) | (rv[1] << 16), (rv[2] & 0xffffu) | (rv[3] << 16), (rv[4] & 0xffffu) | (rv[5] << 16), (rv[6] & 0xffffu) | (rv[7] << 16)};
        LDSV(v4u, VTE + (2 * lane + 1) * 144 + 16 * w) = (v4u){(rv[0] >> 16) | (rv[1] & 0xffff0000u), (rv[2] >> 16) | (rv[3] & 0xffff0000u), (rv[4] >> 16) | (rv[5] & 0xffff0000u), (rv[6] >> 16) | (rv[7] & 0xffff0000u)};
        BAR_LDS();
        { const f32x4 ws = LDSV(f32x4, WS + 16 * tg4);
            LDSV(v2u, KWT + (2 * dp) * 144 + 8 * tg4) = (v2u){pk2(bflo(rk[0]) * ws[0], bflo(rk[1]) * ws[1]), pk2(bflo(rk[2]) * ws[2], bflo(rk[3]) * ws[3])};
            LDSV(v2u, KWT + (2 * dp + 1) * 144 + 8 * tg4) = (v2u){pk2(bfhi(rk[0]) * ws[0], bfhi(rk[1]) * ws[1]), pk2(bfhi(rk[2]) * ws[2], bfhi(rk[3]) * ws[3])}; }
        const float wc = LDSV(float, SC), m_next = LDSV(float, SC + 4); btot += LDSV(float, SC + 8);
        const size_t orow = (rowb + (size_t)c * 64 + tb * 16 + fr) * 1024 + h * 128 + 4 * fq;
        v2u rg[4];
        if (!STATE_ONLY) {
#pragma unroll
            for (int j = 0; j < 4; ++j) rg[j] = *(const v2u*)(Om + orow + (4 * wh + j) * 16);
        }
        if (c + 1 < NCH) { const size_t r1 = rowb + (size_t)(c + 1) * 64;
#pragma unroll
            for (int i = 0; i < 4; ++i) { const size_t e = (r1 + 4 * tg4 + i) * 512 + h * 64 + 2 * dp; if (!STATE_ONLY) rq[i] = *(const unsigned*)(Qm + e); rk[i] = *(const unsigned*)(Km + e); }
#pragma unroll
            for (int i = 0; i < 8; ++i) rv[i] = *(const unsigned*)(Vm + (r1 + 8 * w + i) * 1024 + h * 128 + 2 * lane);
            if (w == 0) { gli = GTg[(r1 + lane) * 16 + h]; glf = GTg[(r1 + lane) * 16 + 8 + h]; }
        }
        BAR_LDS();
        f32x4 num[5];
        if (!STATE_ONLY) {
        { const float Mt = LDSV(float, MT + (tb * 16 + fr) * 4);
#pragma unroll
            for (int j = 0; j < 2; ++j) { const int sb = 2 * wh + j; f32x4 a = (f32x4){0.f, 0.f, 0.f, 0.f};
                if (sb <= tb) {
#pragma unroll
                    for (int kk = 0; kk < 2; ++kk) a = MFMA16(LDSF(K + (sb * 16 + fr) * 144 + kk * 64 + fq * 16), LDSF(Q + (tb * 16 + fr) * 144 + kk * 64 + fq * 16), a);
                    const int t = tb * 16 + fr, s0 = sb * 16 + 4 * fq; const f32x4 as = LDSV(f32x4, AS + s0 * 4);
#pragma unroll
                    for (int r = 0; r < 4; ++r) a[r] = (s0 + r > t) ? 0.f : a[r] * __expf(as[r] - Mt);
                }
                LDSV(v2u, AM + (tb * 16 + fr) * 144 + (sb * 16 + 4 * fq) * 2) = (v2u){pk2(a[0], a[1]), pk2(a[2], a[3])}; } }
        BAR_LDS();
        { bf16x8 bA[2], bQ[2]; const float wi = LDSV(float, WI + (tb * 16 + fr) * 4);
#pragma unroll
            for (int kk = 0; kk < 2; ++kk) { bA[kk] = LDSF(AM + (tb * 16 + fr) * 144 + kk * 64 + fq * 16); bQ[kk] = LDSF(Q + (tb * 16 + fr) * 144 + kk * 64 + fq * 16); }
#pragma unroll
            for (int j = 0; j < 5; ++j) { if (j == 4 && wh != 0) break; const int dvb = j == 4 ? 8 : 4 * wh + j; f32x4 a1 = (f32x4){0.f, 0.f, 0.f, 0.f}, a2 = a1;
#pragma unroll
                for (int kk = 0; kk < 2; ++kk) { a1 = MFMA16(LDSF(VTE + (dvb * 16 + fr) * 144 + kk * 64 + fq * 16), bA[kk], a1); a2 = MFMA16(LDSF(CTE + (dvb * 16 + fr) * 144 + kk * 64 + fq * 16), bQ[kk], a2); }
                num[j] = a1 + a2 * wi; }
            if (wh == 0 && fq == 0) LDSV(float, DEN + (tb * 16 + fr) * 4) = num[4][0]; }
        }
        { bf16x8 aK[2];
#pragma unroll
            for (int kk = 0; kk < 2; ++kk) aK[kk] = LDSF(KWT + (16 * tb + fr) * 144 + kk * 64 + fq * 16);
#pragma unroll
            for (int j = 0; j < 5; ++j) { if (j == 4 && wh != 0) break; const int dvb = j == 4 ? 8 : 4 * wh + j; f32x4 a = cacc[j] * wc;
#pragma unroll
                for (int kk = 0; kk < 2; ++kk) a = MFMA16(aK[kk], LDSF(VTE + (dvb * 16 + fr) * 144 + kk * 64 + fq * 16), a);
                cacc[j] = a; } }
        BAR_LDS();
        if (!STATE_ONLY) {
        { const float dn = fmaxf(fabsf(LDSV(float, DEN + (tb * 16 + fr) * 4)), LDSV(float, EM + (tb * 16 + fr) * 4)); const float inv = 1.0f / dn; float ss = 0.f;
#pragma unroll
            for (int j = 0; j < 4; ++j) { num[j] = num[j] * inv; ss += (num[j][0] * num[j][0] + num[j][1] * num[j][1]) + (num[j][2] * num[j][2] + num[j][3] * num[j][3]); }
            ss += __shfl_xor(ss, 16); ss += __shfl_xor(ss, 32);
            if (fq == 0) LDSV(float, NP + ((tb * 16 + fr) * 2 + wh) * 4) = ss; }
        BAR_LDS();
        { const f32x2 p = LDSV(f32x2, NP + (tb * 16 + fr) * 8); const float rstd = rsqrtf((p.x + p.y) * (1.0f / 128.0f) + 1e-6f);
#pragma unroll
            for (int j = 0; j < 4; ++j) { const f32x4 o = num[j] * rstd * wn[j];
                *(v2u*)(Hb + orow + (4 * wh + j) * 16) = (v2u){pk2(o[0] * bflo(rg[j].x), o[1] * bfhi(rg[j].x)), pk2(o[2] * bflo(rg[j].y), o[3] * bfhi(rg[j].y))}; } }
#pragma unroll
        for (int j = 0; j < 5; ++j) { if (j == 4 && wh != 0) break; const int dvb = j == 4 ? 8 : 4 * wh + j;
            LDSV(v2u, CTE + (dvb * 16 + fr) * 144 + (16 * tb + 4 * fq) * 2) = (v2u){pk2(cacc[j][0], cacc[j][1]), pk2(cacc[j][2], cacc[j][3])}; }
        }
        m_prev = m_next;
    }
    if (STATE_ONLY) {
#pragma unroll
        for (int j = 0; j < 5; ++j) *(f32x4*)(Escr + (size_t)(item0 + g) * 10240 + ((w * 5 + j) * 64 + lane) * 4) = cacc[j];
        if (tid == 0) { Mscr[(item0 + g) * 2] = m_prev; Mscr[(item0 + g) * 2 + 1] = btot; }
    } else if (g == 3) {
        float* co = C_out + (size_t)(b * 8 + h) * 64 * 128;
#pragma unroll
        for (int j = 0; j < 4; ++j)
#pragma unroll
            for (int r = 0; r < 4; ++r) co[(size_t)(16 * tb + 4 * fq + r) * 128 + (4 * wh + j) * 16 + fr] = cacc[j][r];
        if (wh == 0 && fr == 0) {
#pragma unroll
            for (int r = 0; r < 4; ++r) n_out[(size_t)(b * 8 + h) * 64 + 16 * tb + 4 * fq + r] = cacc[4][r]; }
        if (tid == 0) m_out[b * 8 + h] = m_prev;
    }
}
__device__ __forceinline__ void mlstm_sample_item(LAS unsigned char* lds, int b, int h, const bf16* Qm, const bf16* Km, const bf16* Vm, const bf16* Om, const float* GTg, bf16* Hb, const float* onw,
                                                  const float* C_in, const float* n_in, const float* m_in, float* C_out, float* n_out, float* m_out) {
    constexpr int KQ = 0, VS = 4096, SCL = 8192, DENR = 8320, RED = 20480;
    const int tid = threadIdx.x, lane = tid & 63, w = __builtin_amdgcn_readfirstlane(tid >> 6), c4 = tid & 31, dg = tid >> 5;
    const size_t rowb = (size_t)MP + (size_t)b * 8;
    __syncthreads();
    { const int t = tid >> 6, d = tid & 63; const size_t g = (rowb + t) * 512 + h * 64 + d; LDSV(f32x2, KQ + tid * 8) = (f32x2){bf1(Km[g]), bf1(Qm[g])}; }
#pragma unroll
    for (int e = tid; e < 1024; e += 512) { const int t = e >> 7, d = e & 127; LDSV(float, VS + e * 4) = bf1(Vm[(rowb + t) * 1024 + h * 128 + d]); }
    if (tid == 0) { float m = m_in[b * 8 + h];
        for (int t = 0; t < 8; ++t) { const float li = GTg[(rowb + t) * 16 + h], lf = GTg[(rowb + t) * 16 + 8 + h]; const float mn = fmaxf(lf + m, li);
            LDSV(f32x4, SCL + t * 16) = (f32x4){__expf(lf + m - mn), __expf(li - mn), __expf(-mn), 0.f}; m = mn; }
        m_out[b * 8 + h] = m; }
    const size_t cbase = ((size_t)(b * 8 + h) * 64 + 4 * dg) * 128 + 4 * c4;
    f32x4 cc[4], pn[8]; float nn[4], pd[8];
#pragma unroll
    for (int i = 0; i < 4; ++i) { cc[i] = *(const f32x4*)(C_in + cbase + (size_t)i * 128); nn[i] = n_in[(size_t)(b * 8 + h) * 64 + 4 * dg + i]; }
    __syncthreads();
#pragma unroll
    for (int t = 0; t < 8; ++t) { const f32x4 vv = LDSV(f32x4, VS + (t * 128 + 4 * c4) * 4); const f32x4 sc = LDSV(f32x4, SCL + t * 16); f32x4 p = (f32x4){0.f, 0.f, 0.f, 0.f}; float d = 0.f;
#pragma unroll
        for (int i = 0; i < 4; ++i) { const f32x2 kq = LDSV(f32x2, KQ + (t * 64 + 4 * dg + i) * 8); const float ik = sc[1] * kq.x;
            cc[i] = cc[i] * sc[0] + vv * ik; p += cc[i] * kq.y; nn[i] = nn[i] * sc[0] + ik; d += nn[i] * kq.y; }
        pn[t] = p; pd[t] = d; }
#pragma unroll
    for (int t = 0; t < 8; ++t) { LDSV(f32x4, RED + ((dg * 8 + t) * 128 + 4 * c4) * 4) = pn[t]; if (c4 == 0) LDSV(float, DENR + (dg * 8 + t) * 4) = pd[t]; }
#pragma unroll
    for (int i = 0; i < 4; ++i) { *(f32x4*)(C_out + cbase + (size_t)i * 128) = cc[i]; if (c4 == 0) n_out[(size_t)(b * 8 + h) * 64 + 4 * dg + i] = nn[i]; }
    __syncthreads();
    { const int t = w; float o0 = 0.f, o1 = 0.f, dn = 0.f;
#pragma unroll
        for (int g = 0; g < 16; ++g) { const f32x2 x = LDSV(f32x2, RED + ((g * 8 + t) * 128 + 2 * lane) * 4); o0 += x.x; o1 += x.y; dn += LDSV(float, DENR + (g * 8 + t) * 4); }
        const float inv = 1.0f / fmaxf(fabsf(dn), LDSV(f32x4, SCL + t * 16)[2]); o0 *= inv; o1 *= inv;
        const float rstd = rsqrtf(wave_sum(o0 * o0 + o1 * o1) * (1.0f / 128.0f) + 1e-6f);
        const size_t g = (rowb + t) * 1024 + h * 128 + 2 * lane; const unsigned gg = *(const unsigned*)(Om + g);
        *(unsigned*)(Hb + g) = pk2(o0 * rstd * onw[h * 128 + 2 * lane] * bflo(gg), o1 * rstd * onw[h * 128 + 2 * lane + 1] * bfhi(gg)); }
}

__device__ __forceinline__ void small_unit_resid(LAS unsigned char* lds, const bf16* A, const bf16* Bt, int K, int R0, int C0, const float* basep, float* X, bf16* Xb, float* ssq) {
    const int tid = threadIdx.x, lane = tid & 63, w = __builtin_amdgcn_readfirstlane(tid >> 6), fr = lane & 15, fq = lane >> 4;
    const int kw = K >> 3;
    const bf16* ap = A + (size_t)(R0 + fr) * K + w * kw + 8 * fq;
    const bf16* bp = Bt + (size_t)(C0 + fr) * K + w * kw + 8 * fq;
    const size_t rs16 = (size_t)16 * K;
    f32x4 acc[4][4];
#pragma unroll
    for (int i = 0; i < 4; ++i)
#pragma unroll
        for (int j = 0; j < 4; ++j) acc[i][j] = (f32x4){0.f, 0.f, 0.f, 0.f};
    bf16x8 a0[4], b0[4], a1[4], b1[4];
#pragma unroll
    for (int i = 0; i < 4; ++i) { a0[i] = *(const bf16x8*)(ap + i * rs16); b0[i] = *(const bf16x8*)(bp + i * rs16); }
    for (int ks = 0; ks < kw; ks += 64) {
#pragma unroll
        for (int i = 0; i < 4; ++i) { a1[i] = *(const bf16x8*)(ap + i * rs16 + ks + 32); b1[i] = *(const bf16x8*)(bp + i * rs16 + ks + 32); }
#pragma unroll
        for (int i = 0; i < 4; ++i)
#pragma unroll
            for (int j = 0; j < 4; ++j) acc[i][j] = MFMA16(b0[j], a0[i], acc[i][j]);
        if (ks + 64 < kw) {
#pragma unroll
            for (int i = 0; i < 4; ++i) { a0[i] = *(const bf16x8*)(ap + i * rs16 + ks + 64); b0[i] = *(const bf16x8*)(bp + i * rs16 + ks + 64); }
        }
#pragma unroll
        for (int i = 0; i < 4; ++i)
#pragma unroll
            for (int j = 0; j < 4; ++j) acc[i][j] = MFMA16(b1[j], a1[i], acc[i][j]);
    }
    __syncthreads();
#pragma unroll
    for (int i = 0; i < 4; ++i)
#pragma unroll
        for (int j = 0; j < 4; ++j) LDSV(f32x4, w * 16384 + (16 * i + fr) * 256 + (((4 * j + fq) ^ fr) << 4)) = acc[i][j];
    __syncthreads();
    { const int row = tid >> 3, cg = tid & 7; f32x4 x0 = (f32x4){0.f, 0.f, 0.f, 0.f}, x1 = x0;
#pragma unroll
        for (int g = 0; g < 8; ++g) { x0 += LDSV(f32x4, g * 16384 + row * 256 + (((2 * cg) ^ (row & 15)) << 4)); x1 += LDSV(f32x4, g * 16384 + row * 256 + (((2 * cg + 1) ^ (row & 15)) << 4)); }
        const size_t off = (size_t)(R0 + row) * 1024 + C0 + 8 * cg;
        const f32x4 v0 = *(const f32x4*)(basep + off) + x0, v1 = *(const f32x4*)(basep + off + 4) + x1;
        *(f32x4*)(X + off) = v0; *(f32x4*)(X + off + 4) = v1;
        *(v4u*)(Xb + off) = (v4u){pk2(v0[0], v0[1]), pk2(v0[2], v0[3]), pk2(v1[0], v1[1]), pk2(v1[2], v1[3])};
        float sq = (v0[0] * v0[0] + v0[1] * v0[1]) + (v0[2] * v0[2] + v0[3] * v0[3]) + (v1[0] * v1[0] + v1[1] * v1[1]) + (v1[2] * v1[2] + v1[3] * v1[3]);
        sq += __shfl_xor(sq, 1); sq += __shfl_xor(sq, 2); sq += __shfl_xor(sq, 4);
        if (cg == 0) atomicAdd(ssq + R0 + row, sq); }
}
struct Args { const float* in[19]; float* out; unsigned char* ws; int ph_lo, ph_hi, li, pad; };
#ifndef PG8_SP2
#define PG8_SP2 true
#endif
#ifndef PG8_ALIGN
#define PG8_ALIGN true
#endif
__global__ void __launch_bounds__(NWAVES * 64, 2) trunk_fwd(Args args) {
    extern __shared__ __attribute__((aligned(16))) unsigned char lds_raw[];
    LAS unsigned char* lds = (LAS unsigned char*)lds_raw;
    volatile LAS unsigned* MISC = (volatile LAS unsigned*)(lds + MISC_OFF);
    const int tid = threadIdx.x, lane = tid & 63, wave = __builtin_amdgcn_readfirstlane(tid >> 6);
    const int G = gridDim.x, bx = blockIdx.x;
    unsigned char* ws = args.ws; float* out = args.out;
    gu32* ctl = (gu32*)(ws + WS_CTL);
    float* SS = (float*)(ws + WS_SS); float* LB = (float*)(ws + WS_LB);
    bf16* Win0 = (bf16*)(ws + WS_WIN0); bf16* Wout0 = (bf16*)(ws + WS_WOUT0); bf16* Wup0 = (bf16*)(ws + WS_WUP0); bf16* Wdn0 = (bf16*)(ws + WS_WDN0);
    bf16* Win1 = (bf16*)(ws + WS_WIN1); bf16* Wout1 = (bf16*)(ws + WS_WOUT1); bf16* Wup1 = (bf16*)(ws + WS_WUP1); bf16* Wdn1 = (bf16*)(ws + WS_WDN1);
    bf16* Xb = (bf16*)(ws + WS_XB); bf16* U = (bf16*)(ws + WS_ACT);
    bf16* Qb = (bf16*)(ws + WS_Q); bf16* LFb = (bf16*)(ws + WS_LF); bf16* Vb = (bf16*)(ws + WS_V); bf16* Gb = (bf16*)(ws + WS_G);
    bf16* Qm = (bf16*)(ws + WS_QM); bf16* Km = (bf16*)(ws + WS_KM); bf16* Vm = (bf16*)(ws + WS_VM); bf16* Om = (bf16*)(ws + WS_OM); float* GTg = (float*)(ws + WS_GT);
    float* X = out + OUT_Y;
    for (int u = tid; u < (LDS_BYTES - LDSCTL_OFF) / 4; u += NWAVES * 64) ((LAS unsigned*)(lds + LDSCTL_OFF))[u] = 0u;
    __syncthreads();
    XcdBarrier bar; bar.bar = (unsigned*)(ctl + CW_BAR); bar.x = 0; bar.st = nullptr;
    if (MK_N_LAUNCHES == 1) bar = xcd_barrier_post((unsigned*)(ctl + CW_BAR), MISC + 8);
    const int lo = args.ph_lo, hi = args.ph_hi;
#define IN(k) (lo <= (k) && (k) < hi)
#define SEAM(k) do { if (IN(k) && IN((k) + 1)) xcd_barrier(bar); } while (0)

    if (IN(0)) {
        LAS float* scr = (LAS float*)(lds + wave * 16384);
        const int gw = bx * NWAVES + wave, NGW = G * NWAVES;
        constexpr int I0 = 16 * 128, I1 = 16 * 32, I2 = 16 * 128, I3 = 64 * 32, I4 = 16 * 97, I5 = I1, I6 = I2, I7 = I3, NITEMS = I0 + I1 + I2 + I3 + I4 + I5 + I6 + I7;
        for (int it = gw; it < NITEMS; it += NGW) {
            int r = it;
            if (r < I0) { p0_transpose_item(args.in[8], 1024, 4096, args.in[6], Win0, scr, r, lane); continue; } r -= I0;
            if (r < I1) { p0_transpose_item(args.in[11], 1024, 1024, nullptr, Wout0, scr, r, lane); continue; } r -= I1;
            if (r < I2) { p0_transpose_item(args.in[16], 1024, 4096, args.in[7], Wup0, scr, r, lane); continue; } r -= I2;
            if (r < I3) { p0_transpose_item(args.in[17], 4096, 1024, nullptr, Wdn0, scr, r, lane); continue; } r -= I3;
            if (r < I4) { p0_transpose_item(args.in[12], 1024, NIN1, args.in[6] + 1024, Win1, scr, r, lane); continue; } r -= I4;
            if (r < I5) { p0_transpose_item(args.in[15], 1024, 1024, nullptr, Wout1, scr, r, lane); continue; } r -= I5;
            if (r < I6) { p0_transpose_item(args.in[16] + (size_t)1024 * 4096, 1024, 4096, args.in[7] + 1024, Wup1, scr, r, lane); continue; } r -= I6;
            p0_transpose_item(args.in[17] + (size_t)4096 * 1024, 4096, 1024, nullptr, Wdn1, scr, r, lane);
        }
        for (int m = gw; m < MROWS; m += NGW) {
            const float* xr = m < MP ? args.in[0] + (size_t)m * 1024 : args.in[1] + (size_t)(m - MP) * 1024;
            f32x4 v[4]; float s = 0.f;
#pragma unroll
            for (int j = 0; j < 4; ++j) { v[j] = *((const f32x4*)xr + lane + 64 * j); s += (v[j][0] * v[j][0] + v[j][1] * v[j][1]) + (v[j][2] * v[j][2] + v[j][3] * v[j][3]); }
            s = wave_sum(s); if (lane == 0) SS[m] = s;
#pragma unroll
            for (int j = 0; j < 4; ++j) *((v2u*)(Xb + (size_t)m * 1024) + lane + 64 * j) = (v2u){pk2(v[j][0], v[j][1]), pk2(v[j][2], v[j][3])};
        }
        if (bx == 0) for (int d = tid; d < 1024; d += NWAVES * 64) { const float l0 = args.in[9][d], l1 = args.in[9][1024 + d], l2 = args.in[9][2048 + d]; const float mx = fmaxf(l0, fmaxf(l1, l2));
            const float e0 = expf(l0 - mx), e1 = expf(l1 - mx), e2 = expf(l2 - mx); LB[d] = e0 / (e0 + e1 + e2); }
    }
    SEAM(0);
    if (IN(1)) { pg8::Gemm g{Xb, Win0, MP, 4096, 1024}; pg8::StaticOrder S; S.init(MP, 4096, G, bx);
        pg8::EpiHgrnIn E{Qb, LFb, Vb, Gb, SS, LB};
        pg8::gemm_phase_x<pg8::EpiHgrnIn, pg8::StaticOrder>(lds, g, MP, S, E); }
    SEAM(1);
    if (IN(2)) {
        float* Escr = (float*)(ws + WS_XB); float* Dscr = (float*)(ws + WS_XB + 16 * MiB);
        for (int it = bx; it < 192; it += G) hgrn_seg_item<true>(lds, (it / 3) >> 3, (it / 3) & 7, it % 3, Qb, LFb, Vb, Gb, Qb, args.in[10], Escr, Dscr, out + OUT_SP);
        for (int it = bx; it < 768; it += G) hgrn_sample_item(lds, it >> 3, it & 7, Qb, LFb, Vb, Gb, Qb, args.in[10], args.in[2], out + OUT_SS);
        if (G == 256) { if (bx >= 192) for (int it = 768 + (bx - 192) * 4; it < 772 + (bx - 192) * 4; ++it) hgrn_sample_item(lds, it >> 3, it & 7, Qb, LFb, Vb, Gb, Qb, args.in[10], args.in[2], out + OUT_SS); }
        else for (int it = 768 + bx; it < 1024; it += G) hgrn_sample_item(lds, it >> 3, it & 7, Qb, LFb, Vb, Gb, Qb, args.in[10], args.in[2], out + OUT_SS);
    }
    SEAM(2);
    if (IN(3)) {
        float* Escr = (float*)(ws + WS_XB); float* Dscr = (float*)(ws + WS_XB + 16 * MiB);
        for (int it = bx; it < 256; it += G) hgrn_seg_item<false>(lds, it >> 5, (it >> 2) & 7, it & 3, Qb, LFb, Vb, Gb, Qb, args.in[10], Escr, Dscr, out + OUT_SP);
    }
    SEAM(3);
    if (IN(4)) { pg8::Gemm g{Qb, Wout0, MP, 1024, 1024}; pg8::StaticOrder S; S.init(MP, 1024, G, bx);
        pg8::EpiResid E{args.in[0], args.in[1], X, Xb, SS + MROWS};
        pg8::gemm_phase_x<pg8::EpiResid, pg8::StaticOrder>(lds, g, MP, S, E); }
    SEAM(4);
    if (IN(5)) { pg8::Gemm g{Xb, Wup0, MP, 4096, 1024}; pg8::StaticOrder S; S.init(MP, 4096, G, bx);
        pg8::EpiUp E{U, SS + MROWS};
        pg8::gemm_phase_x<pg8::EpiUp, pg8::StaticOrder>(lds, g, MP, S, E); }
    SEAM(5);
    if (IN(6)) { pg8::Gemm g{U, Wdn0, MP, 1024, 4096}; pg8::StaticOrder S; S.init(MP, 1024, G, bx);
        pg8::EpiResid E{X, X + (size_t)MP * 1024, X, Xb, SS + 2 * MROWS};
        pg8::gemm_phase_x<pg8::EpiResid, pg8::StaticOrder>(lds, g, MP, S, E); }
    SEAM(6);
    if (IN(7)) { pg8::Gemm g{Xb, Win1, MP, NIN1P, 1024}; pg8::StaticOrder S; S.init(MP, NIN1P, G, bx);
        pg8::EpiMlstmIn E{Qm, Km, Vm, Om, GTg, SS + 2 * MROWS, args.in[13]};
        pg8::gemm_phase_x<pg8::EpiMlstmIn, pg8::StaticOrder>(lds, g, MP, S, E); }
    SEAM(7);
    if (IN(8)) {
        float* Escr = (float*)(ws + WS_XB); float* Mscr = (float*)(ws + WS_XB + 16 * MiB);
        for (int it = bx; it < 192; it += G) mlstm_seg_item<true>(lds, (it / 3) >> 3, (it / 3) & 7, it % 3, Qm, Km, Vm, Om, GTg, Vm, args.in[14], Escr, Mscr, out + OUT_CP, out + OUT_NP, out + OUT_MP);
        for (int it = bx; it < 768; it += G) mlstm_sample_item(lds, it >> 3, it & 7, Qm, Km, Vm, Om, GTg, Vm, args.in[14], args.in[3], args.in[4], args.in[5], out + OUT_CS, out + OUT_NS, out + OUT_MS);
        if (G == 256) { if (bx >= 192) for (int it = 768 + (bx - 192) * 4; it < 772 + (bx - 192) * 4; ++it) mlstm_sample_item(lds, it >> 3, it & 7, Qm, Km, Vm, Om, GTg, Vm, args.in[14], args.in[3], args.in[4], args.in[5], out + OUT_CS, out + OUT_NS, out + OUT_MS); }
        else for (int it = 768 + bx; it < 1024; it += G) mlstm_sample_item(lds, it >> 3, it & 7, Qm, Km, Vm, Om, GTg, Vm, args.in[14], args.in[3], args.in[4], args.in[5], out + OUT_CS, out + OUT_NS, out + OUT_MS);
    }
    SEAM(8);
    if (IN(9)) {
        float* Escr = (float*)(ws + WS_XB); float* Mscr = (float*)(ws + WS_XB + 16 * MiB);
        for (int it = bx; it < 256; it += G) mlstm_seg_item<false>(lds, it >> 5, (it >> 2) & 7, it & 3, Qm, Km, Vm, Om, GTg, Vm, args.in[14], Escr, Mscr, out + OUT_CP, out + OUT_NP, out + OUT_MP);
    }
    SEAM(9);
    if (IN(10)) { pg8::Gemm g{Vm, Wout1, MP, 1024, 1024}; pg8::StaticOrder S; S.init(MP, 1024, G, bx);
        pg8::EpiResid E{X, X + (size_t)MP * 1024, X, Xb, SS + 3 * MROWS};
        pg8::gemm_phase_x<pg8::EpiResid, pg8::StaticOrder>(lds, g, MP, S, E); }
    SEAM(10);
    if (IN(11)) { pg8::Gemm g{Xb, Wup1, MP, 4096, 1024}; pg8::StaticOrder S; S.init(MP, 4096, G, bx);
        pg8::EpiUp E{U, SS + 3 * MROWS};
        pg8::gemm_phase_x<pg8::EpiUp, pg8::StaticOrder>(lds, g, MP, S, E); }
    SEAM(11);
    if (IN(12)) { pg8::Gemm g{U, Wdn1, MP, 1024, 4096}; pg8::StaticOrder S; S.init(MP, 1024, G, bx);
        pg8::EpiResid E{X, X + (size_t)MP * 1024, X, Xb, SS + 4 * MROWS};
        pg8::gemm_phase_x<pg8::EpiResid, pg8::StaticOrder>(lds, g, MP, S, E); }
    SEAM(12);
    if (IN(13)) {
        const int gw = bx * NWAVES + wave, NGW = G * NWAVES; const float* wf = args.in[18];
        f32x4 wv[4];
#pragma unroll
        for (int j = 0; j < 4; ++j) wv[j] = *((const f32x4*)wf + lane + 64 * j);
        for (int m = gw; m < MROWS; m += NGW) { const float rs = rsqrtf(SS[4 * MROWS + m] * (1.0f / 1024.0f) + 1e-6f); f32x4* xr = (f32x4*)(X + (size_t)m * 1024);
#pragma unroll
            for (int j = 0; j < 4; ++j) xr[lane + 64 * j] = xr[lane + 64 * j] * rs * wv[j]; }
    }
#undef IN
#undef SEAM
}

extern "C" void kernel_launch(void* const* d_in, const int* in_sizes, int n_in, void* d_out, int out_size, void* d_ws, size_t ws_size, hipStream_t stream) {
    static int grid = 0;
    if (grid == 0) {
        if (n_in != 19 || out_size != (int)OUT_END || ws_size < WS_END) { fprintf(stderr, "kernel_launch: unexpected shapes: n_in %d out %d ws %zu\n", n_in, out_size, ws_size); grid = -1; return; }
        int dev = 0, cus = 0, per_cu = 0;
        if (hipGetDevice(&dev) != hipSuccess || hipDeviceGetAttribute(&cus, hipDeviceAttributeMultiprocessorCount, dev) != hipSuccess) { grid = -1; return; }
        if (hipFuncSetAttribute((const void*)trunk_fwd, hipFuncAttributeMaxDynamicSharedMemorySize, LDS_BYTES) != hipSuccess) { fprintf(stderr, "kernel_launch: hipFuncSetAttribute failed\n"); grid = -1; return; }
        if (hipOccupancyMaxActiveBlocksPerMultiprocessor(&per_cu, (const void*)trunk_fwd, NWAVES * 64, LDS_BYTES) != hipSuccess || per_cu < 1) { fprintf(stderr, "kernel_launch: occupancy query says %d blocks per CU\n", per_cu); grid = -1; return; }
        (void)hipGetLastError();
        grid = cus;
    }
    if (grid < 0) return;
    (void)hipMemsetAsync((char*)d_ws + WS_CTL, 0, CTL_ZERO_BYTES, stream);
    Args a{};
    for (int i = 0; i < 19; ++i) a.in[i] = (const float*)d_in[i];
    a.out = (float*)d_out; a.ws = (unsigned char*)d_ws;
#if MK_N_LAUNCHES == 1
    a.ph_lo = 0; a.ph_hi = N_PHASES; a.li = 0;
    hipLaunchKernelGGL(trunk_fwd, dim3(grid), dim3(NWAVES * 64), LDS_BYTES, stream, a);
#else
    for (int li = 0; li < N_PHASES; ++li) { a.ph_lo = li; a.ph_hi = li + 1; a.li = li; hipLaunchKernelGGL(trunk_fwd, dim3(grid), dim3(NWAVES * 64), LDS_BYTES, stream, a); }
#endif
}
```

```cpp
#include <hip/hip_runtime.h>
#include <cstdio>
#include <cstdint>
#include <cmath>
namespace pg8 {
#define PG8_LAS __attribute__((address_space(3)))
typedef unsigned short bf16_t;
typedef short bf16x8 __attribute__((ext_vector_type(8)));
typedef float f32x4 __attribute__((ext_vector_type(4)));
typedef unsigned u32x4 __attribute__((ext_vector_type(4)));
constexpr int BM = 256, BK = 64, HALF = 128, HTB = HALF * BK * 2  , STAGE_BYTES = 8 * HTB, NXCD = 8, WGM = 8;

__host__ __device__ __forceinline__ int lds_byte(int r, int c) { const int st = (r >> 4) * 2 + (c >> 5), rr = r & 15, cc = c & 31, ob = rr * 64 + cc * 2; return st * 1024 + (ob ^ (((ob >> 9) & 1) << 5)); }
__host__ __device__ __forceinline__ void stage_rc(int b, int& R, int& C) { const int st = b / 1024, sb = b % 1024, swz = sb ^ (((sb >> 9) & 1) << 5); R = (st >> 1) * 16 + swz / 64; C = (st & 1) * 32 + (swz % 64) / 2; }
__host__ __device__ __forceinline__ int perm32(int rho) { const int n = rho >> 4, i = rho & 15; return 8 * (i >> 2) + 4 * n + (i & 3); }

struct Unit { int pm, pn; };
struct Gemm { const bf16_t* A; const bf16_t* Bt; int M, N, K; };

struct StaticOrder {
    int nM, nN, nwg, G, c;
    __host__ __device__ void init(int M, int N, int G_, int c_) { nM = M / BM; nN = N / BM; nwg = nM * nN; G = G_; c = c_; }
    __host__ __device__ bool next(int i, Unit& u) const {
        const long L = (long)i * G + c; if (L >= nwg) return false;
        int wgid = (int)L; { const int q = nwg / NXCD, r = nwg % NXCD, xcd = wgid % NXCD, off = wgid / NXCD; wgid = (xcd < r ? xcd * (q + 1) : r * (q + 1) + (xcd - r) * q) + off; }
        const int nig = WGM * nN, gid = wgid / nig, fm = gid * WGM, gsz = (nM - fm) < WGM ? (nM - fm) : WGM;
        u.pm = fm + ((wgid % nig) % gsz); u.pn = (wgid % nig) / gsz; return true;
    }
    __device__ __forceinline__ void a_ready(const Unit&) const {}
    __device__ __forceinline__ void done(const Unit&) const {}
};

typedef unsigned u32x2 __attribute__((ext_vector_type(2)));
__device__ __forceinline__ unsigned f2bf_(float f) { unsigned u = __builtin_bit_cast(unsigned, f); return (u + 0x7fffu + ((u >> 16) & 1u)) >> 16; }
typedef float f32x2c_ __attribute__((ext_vector_type(2))); typedef __bf16 bf16x2c_ __attribute__((ext_vector_type(2)));
__device__ __forceinline__ unsigned pkbf(float lo, float hi) { f32x2c_ v = {lo, hi}; bf16x2c_ b = __builtin_convertvector(v, bf16x2c_); return __builtin_bit_cast(unsigned, b); }
__device__ __forceinline__ unsigned pkh(float lo, float hi) { const _Float16 a = (_Float16)lo, b = (_Float16)hi; return (unsigned)__builtin_bit_cast(unsigned short, a) | ((unsigned)__builtin_bit_cast(unsigned short, b) << 16); }
__device__ __forceinline__ float sigm(float x) { return __builtin_amdgcn_rcpf(1.0f + __expf(-x)); }
constexpr float NORM_EPS = 1e-6f;
constexpr int XROW0 = 16384;

struct EpiHgrnIn {
    static constexpr bool PERM = true, AFTER_DRAIN = false;
    bf16_t* Q; bf16_t* LF; bf16_t* V; bf16_t* G; const float* ss; const float* lb;
    template <int GRP> __device__ __forceinline__ void run(const f32x4 (&acc)[2][2][4][2], const Unit& u, int wr, int wc, int fr, int fq) const {
        const int row0 = u.pm * BM + wr * 64 + fr, gc0 = (u.pn & 3) * BM + wc * 32 + 8 * fq;
        bf16_t* dst = GRP == 0 ? Q : GRP == 1 ? LF : GRP == 2 ? V : G;
        f32x4 lbv[2][2];
        if (GRP == 1) {
#pragma unroll
            for (int bj = 0; bj < 2; ++bj)
#pragma unroll
                for (int n = 0; n < 2; ++n) lbv[bj][n] = *(const f32x4*)(lb + gc0 + bj * HALF + 4 * n);
        }
#pragma unroll
        for (int ai = 0; ai < 2; ++ai)
#pragma unroll
            for (int m = 0; m < 4; ++m) { const int row = row0 + ai * HALF + m * 16; const float rs = rsqrtf(ss[row] * (1.0f / 1024.0f) + NORM_EPS);
                bf16_t* rowp = dst + (size_t)row * 1024 + gc0;
#pragma unroll
                for (int bj = 0; bj < 2; ++bj) { float x[8];
#pragma unroll
                    for (int n = 0; n < 2; ++n)
#pragma unroll
                        for (int j = 0; j < 4; ++j) x[4 * n + j] = acc[ai][bj][m][n][j] * rs;
                    u32x4 w;
                    if (GRP == 0 || GRP == 3) {
#pragma unroll
                        for (int j = 0; j < 8; ++j) x[j] = x[j] * sigm(x[j]);
                    }
                    if (GRP == 1) {
#pragma unroll
                        for (int j = 0; j < 8; ++j) { const float l = lbv[bj][j >> 2][j & 3]; x[j] = __logf(l + (1.0f - l) * sigm(x[j])); }
                        w.x = pkh(x[0], x[1]); w.y = pkh(x[2], x[3]); w.z = pkh(x[4], x[5]); w.w = pkh(x[6], x[7]);
                    } else { w.x = pkbf(x[0], x[1]); w.y = pkbf(x[2], x[3]); w.z = pkbf(x[4], x[5]); w.w = pkbf(x[6], x[7]); }
                    *(u32x4*)(rowp + bj * HALF) = w; } }
    }
    __device__ __forceinline__ void operator()(const f32x4 (&acc)[2][2][4][2], const Unit& u, int wr, int wc, int fr, int fq) const {
        const int grp = u.pn >> 2;
        if (grp == 0) run<0>(acc, u, wr, wc, fr, fq); else if (grp == 1) run<1>(acc, u, wr, wc, fr, fq); else if (grp == 2) run<2>(acc, u, wr, wc, fr, fq); else run<3>(acc, u, wr, wc, fr, fq);
    }
    __device__ __forceinline__ void extra(const f32x4 (&accE)[2], const Unit& u, int wr, int wc, int fr, int fq) const {
        const int grp = u.pn >> 2, row = XROW0 + 16 * u.pm + fr, gc0 = (u.pn & 3) * BM + wr * HALF + wc * 32 + 8 * fq;
        const float rs = rsqrtf(ss[row] * (1.0f / 1024.0f) + NORM_EPS);
        float x[8];
#pragma unroll
        for (int j = 0; j < 8; ++j) x[j] = accE[j >> 2][j & 3] * rs;
        bf16_t* dst = grp == 0 ? Q : grp == 1 ? LF : grp == 2 ? V : G;
        u32x4 w;
        if (grp == 0 || grp == 3) {
#pragma unroll
            for (int j = 0; j < 8; ++j) x[j] = x[j] * sigm(x[j]);
        }
        if (grp == 1) {
#pragma unroll
            for (int j = 0; j < 8; ++j) { const float l = lb[gc0 + j]; x[j] = __logf(l + (1.0f - l) * sigm(x[j])); }
            w.x = pkh(x[0], x[1]); w.y = pkh(x[2], x[3]); w.z = pkh(x[4], x[5]); w.w = pkh(x[6], x[7]);
        } else { w.x = pkbf(x[0], x[1]); w.y = pkbf(x[2], x[3]); w.z = pkbf(x[4], x[5]); w.w = pkbf(x[6], x[7]); }
        *(u32x4*)(dst + (size_t)row * 1024 + gc0) = w;
    }
};

struct EpiMlstmIn {
    static constexpr bool PERM = true, AFTER_DRAIN = false;
    bf16_t* Qm; bf16_t* Km; bf16_t* Vm; bf16_t* Om; float* GT; const float* ss; const float* gb;
    template <int GRP> __device__ __forceinline__ void run(const f32x4 (&acc)[2][2][4][2], const Unit& u, int wr, int wc, int fr, int fq) const {
        const int row0 = u.pm * BM + wr * 64 + fr;
        const int ld = GRP < 2 ? 512 : 1024;
        const int tb = GRP == 0 ? 0 : GRP == 1 ? 2 : GRP == 2 ? 4 : 8;
        const int gc0 = (u.pn - tb) * BM + wc * 32 + 8 * fq;
        bf16_t* dst = GRP == 0 ? Qm : GRP == 1 ? Km : GRP == 2 ? Vm : Om;
#pragma unroll
        for (int ai = 0; ai < 2; ++ai)
#pragma unroll
            for (int m = 0; m < 4; ++m) { const int row = row0 + ai * HALF + m * 16; const float rs = rsqrtf(ss[row] * (1.0f / 1024.0f) + NORM_EPS);
                bf16_t* rowp = dst + (size_t)row * ld + gc0;
#pragma unroll
                for (int bj = 0; bj < 2; ++bj) { float x[8];
#pragma unroll
                    for (int n = 0; n < 2; ++n)
#pragma unroll
                        for (int j = 0; j < 4; ++j) x[4 * n + j] = acc[ai][bj][m][n][j] * rs;
                    if (GRP == 0) {
#pragma unroll
                        for (int j = 0; j < 8; ++j) x[j] *= 0.125f;
                    }
                    if (GRP == 3) {
#pragma unroll
                        for (int j = 0; j < 8; ++j) x[j] = sigm(x[j]);
                    }
                    u32x4 w; w.x = pkbf(x[0], x[1]); w.y = pkbf(x[2], x[3]); w.z = pkbf(x[4], x[5]); w.w = pkbf(x[6], x[7]);
                    *(u32x4*)(rowp + bj * HALF) = w; } }
    }
    __device__ __forceinline__ void gates(const f32x4 (&acc)[2][2][4][2], const Unit& u, int wr, int wc, int fr, int fq) const {
        if (wc != 0 || fq >= 2) return;
        const int row0 = u.pm * BM + wr * 64 + fr;
#pragma unroll
        for (int ai = 0; ai < 2; ++ai)
#pragma unroll
            for (int m = 0; m < 4; ++m) { const int row = row0 + ai * HALF + m * 16; const float rs = rsqrtf(ss[row] * (1.0f / 1024.0f) + NORM_EPS);
                float x[8];
#pragma unroll
                for (int n = 0; n < 2; ++n)
#pragma unroll
                    for (int j = 0; j < 4; ++j) x[4 * n + j] = acc[ai][0][m][n][j] * rs;
#pragma unroll
                for (int j = 0; j < 8; ++j) { const float y2 = (x[j] + gb[8 * fq + j]) * (2.0f / 15.0f); const float z = 15.0f - 30.0f * __builtin_amdgcn_rcpf(__expf(y2) + 1.0f); x[j] = fq == 0 ? z : -__logf(1.0f + __expf(-z)); }
                float* o = GT + (size_t)row * 16 + 8 * fq;
                *(f32x4*)o = (f32x4){x[0], x[1], x[2], x[3]}; *(f32x4*)(o + 4) = (f32x4){x[4], x[5], x[6], x[7]}; }
    }
    __device__ __forceinline__ void operator()(const f32x4 (&acc)[2][2][4][2], const Unit& u, int wr, int wc, int fr, int fq) const {
        const int pn = u.pn;
        if (pn < 2) run<0>(acc, u, wr, wc, fr, fq); else if (pn < 4) run<1>(acc, u, wr, wc, fr, fq); else if (pn < 8) run<2>(acc, u, wr, wc, fr, fq); else if (pn < 12) run<3>(acc, u, wr, wc, fr, fq); else gates(acc, u, wr, wc, fr, fq);
    }
    __device__ __forceinline__ void extra(const f32x4 (&accE)[2], const Unit& u, int wr, int wc, int fr, int fq) const {
        const int pn = u.pn, row = XROW0 + 16 * u.pm + fr;
        const float rs = rsqrtf(ss[row] * (1.0f / 1024.0f) + NORM_EPS);
        float x[8];
#pragma unroll
        for (int j = 0; j < 8; ++j) x[j] = accE[j >> 2][j & 3] * rs;
        if (pn == 12) {
            if (wr != 0 || wc != 0 || fq >= 2) return;
#pragma unroll
            for (int j = 0; j < 8; ++j) { const float y2 = (x[j] + gb[8 * fq + j]) * (2.0f / 15.0f); const float z = 15.0f - 30.0f * __builtin_amdgcn_rcpf(__expf(y2) + 1.0f); x[j] = fq == 0 ? z : -__logf(1.0f + __expf(-z)); }
            float* o = GT + (size_t)row * 16 + 8 * fq;
            *(f32x4*)o = (f32x4){x[0], x[1], x[2], x[3]}; *(f32x4*)(o + 4) = (f32x4){x[4], x[5], x[6], x[7]};
            return;
        }
        const int grp = pn < 2 ? 0 : pn < 4 ? 1 : pn < 8 ? 2 : 3, tb = grp == 0 ? 0 : grp == 1 ? 2 : grp == 2 ? 4 : 8, ld = grp < 2 ? 512 : 1024;
        const int gc0 = (pn - tb) * BM + wr * HALF + wc * 32 + 8 * fq;
        bf16_t* dst = grp == 0 ? Qm : grp == 1 ? Km : grp == 2 ? Vm : Om;
        if (grp == 0) {
#pragma unroll
            for (int j = 0; j < 8; ++j) x[j] *= 0.125f;
        }
        if (grp == 3) {
#pragma unroll
            for (int j = 0; j < 8; ++j) x[j] = sigm(x[j]);
        }
        u32x4 w; w.x = pkbf(x[0], x[1]); w.y = pkbf(x[2], x[3]); w.z = pkbf(x[4], x[5]); w.w = pkbf(x[6], x[7]);
        *(u32x4*)(dst + (size_t)row * ld + gc0) = w;
    }
};

struct EpiUp {
    static constexpr bool PERM = true, AFTER_DRAIN = false;
    bf16_t* U; const float* ss;
    __device__ __forceinline__ void operator()(const f32x4 (&acc)[2][2][4][2], const Unit& u, int wr, int wc, int fr, int fq) const {
        const int row0 = u.pm * BM + wr * 64 + fr, c0 = u.pn * BM + wc * 32 + 8 * fq;
#pragma unroll
        for (int ai = 0; ai < 2; ++ai)
#pragma unroll
            for (int m = 0; m < 4; ++m) { const int row = row0 + ai * HALF + m * 16; const float rs = rsqrtf(ss[row] * (1.0f / 1024.0f) + NORM_EPS);
                bf16_t* rowp = U + (size_t)row * 4096 + c0;
#pragma unroll
                for (int bj = 0; bj < 2; ++bj) { float x[8];
#pragma unroll
                    for (int n = 0; n < 2; ++n)
#pragma unroll
                        for (int j = 0; j < 4; ++j) { const float a = fmaxf(acc[ai][bj][m][n][j] * rs, 0.0f); x[4 * n + j] = a * a; }
                    u32x4 w; w.x = pkbf(x[0], x[1]); w.y = pkbf(x[2], x[3]); w.z = pkbf(x[4], x[5]); w.w = pkbf(x[6], x[7]);
                    *(u32x4*)(rowp + bj * HALF) = w; } }
    }
    __device__ __forceinline__ void extra(const f32x4 (&accE)[2], const Unit& u, int wr, int wc, int fr, int fq) const {
        const int row = XROW0 + 16 * u.pm + fr, c0 = u.pn * BM + wr * HALF + wc * 32 + 8 * fq;
        const float rs = rsqrtf(ss[row] * (1.0f / 1024.0f) + NORM_EPS);
        float x[8];
#pragma unroll
        for (int j = 0; j < 8; ++j) { const float a = fmaxf(accE[j >> 2][j & 3] * rs, 0.0f); x[j] = a * a; }
        u32x4 w; w.x = pkbf(x[0], x[1]); w.y = pkbf(x[2], x[3]); w.z = pkbf(x[4], x[5]); w.w = pkbf(x[6], x[7]);
        *(u32x4*)(U + (size_t)row * 4096 + c0) = w;
    }
};

struct EpiDummy {
    static constexpr bool PERM = true, AFTER_DRAIN = false;
    bf16_t* O;
    __device__ __forceinline__ void operator()(const f32x4 (&acc)[2][2][4][2], const Unit& u, int wr, int wc, int fr, int fq) const {
        const int row0 = u.pm * BM + wr * 64 + fr, c0 = u.pn * BM + wc * 32 + 8 * fq;
#pragma unroll
        for (int ai = 0; ai < 2; ++ai)
#pragma unroll
            for (int m = 0; m < 4; ++m) { bf16_t* rowp = O + (size_t)(row0 + ai * HALF + m * 16) * 1024 + c0;
#pragma unroll
                for (int bj = 0; bj < 2; ++bj) { u32x4 w; w.x = pkbf(acc[ai][bj][m][0][0], acc[ai][bj][m][0][1]); w.y = pkbf(acc[ai][bj][m][0][2], acc[ai][bj][m][0][3]); w.z = pkbf(acc[ai][bj][m][1][0], acc[ai][bj][m][1][1]); w.w = pkbf(acc[ai][bj][m][1][2], acc[ai][bj][m][1][3]);
                    *(u32x4*)(rowp + bj * HALF) = w; } }
    }
    __device__ __forceinline__ void extra(const f32x4 (&accE)[2], const Unit& u, int wr, int wc, int fr, int fq) const {
        const int row = XROW0 + 16 * u.pm + fr, c0 = u.pn * BM + wr * HALF + wc * 32 + 8 * fq;
        u32x4 w; w.x = pkbf(accE[0][0], accE[0][1]); w.y = pkbf(accE[0][2], accE[0][3]); w.z = pkbf(accE[1][0], accE[1][1]); w.w = pkbf(accE[1][2], accE[1][3]);
        *(u32x4*)(O + (size_t)row * 1024 + c0) = w;
    }
};
template <bool BASE_F32> struct EpiResid {
    static constexpr bool PERM = true, AFTER_DRAIN = false;
    const float* base0; const float* base1; bf16_t* Xb; float* ssq;
    __device__ __forceinline__ void row8(const float* brow, size_t off, const f32x4& a0, const f32x4& a1, float& s) const {
        float v[8];
        if (BASE_F32) { const f32x4 b0 = *(const f32x4*)(brow + off), b1 = *(const f32x4*)(brow + off + 4);
#pragma unroll
            for (int j = 0; j < 4; ++j) { v[j] = b0[j] + a0[j]; v[4 + j] = b1[j] + a1[j]; } }
        else { const u32x4 b = *(const u32x4*)(Xb + off);
#pragma unroll
            for (int j = 0; j < 4; ++j) { v[j] = __builtin_bit_cast(float, (j & 1) ? (b[j >> 1] & 0xffff0000u) : (b[j >> 1] << 16)) + a0[j]; v[4 + j] = __builtin_bit_cast(float, (j & 1) ? (b[2 + (j >> 1)] & 0xffff0000u) : (b[2 + (j >> 1)] << 16)) + a1[j]; } }
        u32x4 w; w.x = pkbf(v[0], v[1]); w.y = pkbf(v[2], v[3]); w.z = pkbf(v[4], v[5]); w.w = pkbf(v[6], v[7]);
        *(u32x4*)(Xb + off) = w;
#pragma unroll
        for (int j = 0; j < 8; ++j) s += v[j] * v[j];
    }
    __device__ __forceinline__ void operator()(const f32x4 (&acc)[2][2][4][2], const Unit& u, int wr, int wc, int fr, int fq) const {
        const int row0 = u.pm * BM + wr * 64 + fr, c0 = u.pn * BM + wc * 32 + 8 * fq;
#pragma unroll
        for (int ai = 0; ai < 2; ++ai)
#pragma unroll
            for (int m = 0; m < 4; ++m) { const int row = row0 + ai * HALF + m * 16; const size_t off = (size_t)row * 1024 + c0; float s = 0.f;
#pragma unroll
                for (int bj = 0; bj < 2; ++bj) row8(base0, off + bj * HALF, acc[ai][bj][m][0], acc[ai][bj][m][1], s);
                s += __shfl_xor(s, 16); s += __shfl_xor(s, 32);
                if (fq == 0) atomicAdd(ssq + row, s); }
    }
    __device__ __forceinline__ void extra(const f32x4 (&accE)[2], const Unit& u, int wr, int wc, int fr, int fq) const {
        const int row = XROW0 + 16 * u.pm + fr, c0 = u.pn * BM + wr * HALF + wc * 32 + 8 * fq;
        float s = 0.f; row8(base1 - (size_t)XROW0 * 1024, (size_t)row * 1024 + c0, accE[0], accE[1], s);
        s += __shfl_xor(s, 16); s += __shfl_xor(s, 32);
        if (fq == 0) atomicAdd(ssq + row, s);
    }
};
template <class Epi, class Sched, bool ALIGN_EPI = false, bool SP2 = false>
__device__ __forceinline__ void gemm_phase(PG8_LAS unsigned char* lds, const Gemm g, const Sched& S, const Epi& E) {
    const int tid = threadIdx.x, wid = __builtin_amdgcn_readfirstlane(tid >> 6), lane = tid & 63, wr = wid >> 2, wc = wid & 3, fr = lane & 15, fq = lane >> 4;
    const int K = g.K, nt = K / BK;
    unsigned voffA[2], voffB[2];
#pragma unroll
    for (int i = 0; i < 2; ++i) { int R, C; stage_rc(tid * 16 + i * 8192, R, C); const int Rb = Epi::PERM ? ((R & ~31) + perm32(R & 31)) : R;
        voffA[i] = (unsigned)(R * K + C) * 2u; voffB[i] = (unsigned)(Rb * K + C) * 2u; }
    const size_t kstep = (size_t)(BK * 2);
    const size_t hstep = (size_t)HALF * K * 2;
    const size_t tstep = 2 * hstep;
    const unsigned ldsw = (unsigned)wid * 1024u;
    const int aoff = lds_byte(wr * 64 + fr, fq * 8), boff = lds_byte(wc * 32 + fr, fq * 8);
#define PG8_SA(b, h) (((b) * 2 + (h)) * HTB)
#define PG8_SB(b, h) ((4 + (b) * 2 + (h)) * HTB)
#define PG8_STAGE(bufoff, gbase, voff) do { _Pragma("unroll") for (int _i = 0; _i < 2; ++_i) \
        __builtin_amdgcn_global_load_lds((const unsigned*)((const char*)(gbase) + (voff)[_i]), (PG8_LAS unsigned*)(lds + (bufoff) + ldsw + _i * 8192), 16, 0, 0); } while (0)
#define PG8_LDA(dst, b, h) do { _Pragma("unroll") for (int m = 0; m < 4; ++m) _Pragma("unroll") for (int k = 0; k < 2; ++k) dst[m][k] = *(const PG8_LAS bf16x8*)(lds + PG8_SA(b, h) + aoff + m * 2048 + k * 1024); } while (0)
#define PG8_LDB(dst, b, h) do { _Pragma("unroll") for (int n = 0; n < 2; ++n) _Pragma("unroll") for (int k = 0; k < 2; ++k) dst[n][k] = *(const PG8_LAS bf16x8*)(lds + PG8_SB(b, h) + boff + n * 2048 + k * 1024); } while (0)
#define PG8_MMA(ai, bj, At, Bt) do { __builtin_amdgcn_s_setprio(1); _Pragma("unroll") for (int m = 0; m < 4; ++m) _Pragma("unroll") for (int n = 0; n < 2; ++n) _Pragma("unroll") for (int k = 0; k < 2; ++k) \
        acc[ai][bj][m][n] = __builtin_amdgcn_mfma_f32_16x16x32_bf16(Bt[n][k], At[m][k], acc[ai][bj][m][n], 0, 0, 0); __builtin_amdgcn_s_setprio(0); } while (0)
#define PG8_WAIT_V(n) asm volatile("s_waitcnt vmcnt(" #n ")" ::: "memory")
#define PG8_WAIT_L(n) asm volatile("s_waitcnt lgkmcnt(" #n ")" ::: "memory")
#define PG8_BAR __builtin_amdgcn_s_barrier()
#define PG8_SCHED __builtin_amdgcn_sched_barrier(0)
    Unit cur, nxt; int ui = 0;
    if (!S.next(0, cur)) return;
    f32x4 acc[2][2][4][2];
#pragma unroll
    for (int a = 0; a < 2; ++a)
#pragma unroll
        for (int b = 0; b < 2; ++b)
#pragma unroll
            for (int m = 0; m < 4; ++m)
#pragma unroll
                for (int n = 0; n < 2; ++n) acc[a][b][m][n] = (f32x4){0.f, 0.f, 0.f, 0.f};
    bf16x8 At[4][2], B0[2][2], B1[2][2];
    const char* cA = (const char*)g.A + (size_t)cur.pm * tstep; const char* cB = (const char*)g.Bt + (size_t)cur.pn * tstep;
    S.a_ready(cur);
    if constexpr (SP2) {
        PG8_STAGE(PG8_SB(0, 0), cB, voffB); PG8_STAGE(PG8_SB(0, 1), cB + hstep, voffB); PG8_STAGE(PG8_SA(0, 0), cA, voffA); PG8_STAGE(PG8_SA(0, 1), cA + hstep, voffA);
        if (wr == 1) PG8_BAR;
        PG8_WAIT_V(2); PG8_BAR;
        PG8_STAGE(PG8_SB(1, 0), cB + kstep, voffB); PG8_STAGE(PG8_SA(1, 0), cA + kstep, voffA); PG8_STAGE(PG8_SB(1, 1), cB + hstep + kstep, voffB);
        PG8_WAIT_V(6); PG8_BAR;
    } else {
        PG8_STAGE(PG8_SB(0, 0), cB, voffB); PG8_STAGE(PG8_SA(0, 0), cA, voffA); PG8_STAGE(PG8_SB(0, 1), cB + hstep, voffB); PG8_STAGE(PG8_SA(0, 1), cA + hstep, voffA);
        if (wr == 1) PG8_BAR;
        PG8_WAIT_V(4); PG8_BAR;
        PG8_STAGE(PG8_SB(1, 0), cB + kstep, voffB); PG8_STAGE(PG8_SA(1, 0), cA + kstep, voffA); PG8_STAGE(PG8_SB(1, 1), cB + hstep + kstep, voffB);
        PG8_WAIT_V(6); PG8_BAR;
    }
    for (;;) {
        const bool has_next = S.next(ui + 1, nxt);
        const char* nA = has_next ? (const char*)g.A + (size_t)nxt.pm * tstep : cA; const char* nB = has_next ? (const char*)g.Bt + (size_t)nxt.pn * tstep : cB;
        for (int t = 0; t < nt; t += 2) {
            const bool last = (t == nt - 2);
            const char* a1 = cA + (size_t)(t + 1) * kstep;
            const char* a2 = last ? nA : cA + (size_t)(t + 2) * kstep; const char* b2 = last ? nB : cB + (size_t)(t + 2) * kstep;
            const char* a3 = a2 + kstep; const char* b3 = b2 + kstep;
            if (last && has_next) S.a_ready(nxt);
            if constexpr (SP2) {
            PG8_LDB(B0, 0, 0); PG8_LDB(B1, 0, 1); PG8_SCHED; PG8_LDA(At, 0, 0); PG8_STAGE(PG8_SA(1, 1), a1 + hstep, voffA);
            PG8_WAIT_V(8); PG8_WAIT_L(0); PG8_BAR; PG8_MMA(0, 0, At, B0); PG8_MMA(0, 1, At, B1); PG8_BAR; PG8_SCHED;
            PG8_LDA(At, 0, 1); PG8_STAGE(PG8_SB(0, 0), b2, voffB); PG8_STAGE(PG8_SB(0, 1), b2 + hstep, voffB); PG8_STAGE(PG8_SA(0, 0), a2, voffA);
            PG8_WAIT_V(8); PG8_WAIT_L(0); PG8_BAR; PG8_MMA(1, 0, At, B0); PG8_MMA(1, 1, At, B1); PG8_BAR; PG8_SCHED;
            PG8_LDB(B0, 1, 0); PG8_LDB(B1, 1, 1); PG8_SCHED; PG8_LDA(At, 1, 0); PG8_STAGE(PG8_SA(0, 1), a2 + hstep, voffA);
            PG8_WAIT_V(8); PG8_WAIT_L(0); PG8_BAR; PG8_MMA(0, 0, At, B0); PG8_MMA(0, 1, At, B1); PG8_BAR; PG8_SCHED;
            PG8_LDA(At, 1, 1); PG8_STAGE(PG8_SB(1, 0), b3, voffB); PG8_STAGE(PG8_SB(1, 1), b3 + hstep, voffB); PG8_STAGE(PG8_SA(1, 0), a3, voffA);
            PG8_WAIT_V(8); PG8_WAIT_L(0); PG8_BAR; PG8_MMA(1, 0, At, B0); PG8_MMA(1, 1, At, B1); PG8_BAR; PG8_SCHED;
            } else {
            PG8_LDB(B0, 0, 0); PG8_SCHED; PG8_LDA(At, 0, 0); PG8_STAGE(PG8_SA(1, 1), a1 + hstep, voffA);
            PG8_WAIT_L(8); PG8_BAR; PG8_WAIT_L(0); PG8_MMA(0, 0, At, B0); PG8_BAR; PG8_SCHED;
            PG8_LDB(B1, 0, 1); PG8_STAGE(PG8_SB(0, 0), b2, voffB);
            PG8_BAR; PG8_WAIT_L(0); PG8_MMA(0, 1, At, B1); PG8_BAR;
            PG8_LDA(At, 0, 1); PG8_STAGE(PG8_SA(0, 0), a2, voffA);
            PG8_BAR; PG8_WAIT_L(0); PG8_MMA(1, 0, At, B0); PG8_BAR; PG8_SCHED;
            PG8_STAGE(PG8_SB(0, 1), b2 + hstep, voffB);
            PG8_WAIT_V(6); PG8_BAR; PG8_MMA(1, 1, At, B1); PG8_BAR;
            PG8_LDB(B0, 1, 0); PG8_SCHED; PG8_LDA(At, 1, 0); PG8_STAGE(PG8_SA(0, 1), a2 + hstep, voffA);
            PG8_WAIT_L(8); PG8_BAR; PG8_WAIT_L(0); PG8_MMA(0, 0, At, B0); PG8_BAR; PG8_SCHED;
            PG8_LDB(B1, 1, 1); PG8_STAGE(PG8_SB(1, 0), b3, voffB);
            PG8_BAR; PG8_WAIT_L(0); PG8_MMA(0, 1, At, B1); PG8_BAR;
            PG8_LDA(At, 1, 1); PG8_STAGE(PG8_SA(1, 0), a3, voffA);
            PG8_BAR; PG8_WAIT_L(0); PG8_MMA(1, 0, At, B0); PG8_BAR; PG8_SCHED;
            PG8_STAGE(PG8_SB(1, 1), b3 + hstep, voffB);
            PG8_WAIT_V(6); PG8_BAR; PG8_MMA(1, 1, At, B1); PG8_BAR;
            }
        }
        if constexpr (ALIGN_EPI) { if (wr == 0) PG8_BAR; }
        if constexpr (!Epi::AFTER_DRAIN) { E(acc, cur, wr, wc, fr, fq); S.done(cur); }
        if (!has_next) break;
#pragma unroll
        for (int a = 0; a < 2; ++a)
#pragma unroll
            for (int b = 0; b < 2; ++b)
#pragma unroll
                for (int m = 0; m < 4; ++m)
#pragma unroll
                    for (int n = 0; n < 2; ++n) acc[a][b][m][n] = (f32x4){0.f, 0.f, 0.f, 0.f};
        cur = nxt; cA = nA; cB = nB; ++ui;
        if constexpr (ALIGN_EPI) { if (wr == 1) PG8_BAR; }
    }
    PG8_WAIT_V(0);
    if constexpr (!ALIGN_EPI) { if (wr == 0) PG8_BAR; }
    PG8_BAR;
    if constexpr (Epi::AFTER_DRAIN) { E.fused(acc, cur, wr, wc, fr, fq, lds, wid, lane); S.done(cur); }
#undef PG8_SA
#undef PG8_SB
#undef PG8_STAGE
#undef PG8_LDA
#undef PG8_LDB
#undef PG8_MMA
#undef PG8_WAIT_V
#undef PG8_WAIT_L
#undef PG8_BAR
#undef PG8_SCHED
}
template <class Epi, class Sched>
__device__ __forceinline__ void gemm_phase_x(PG8_LAS unsigned char* lds, const Gemm g, const int Mx, const Sched& S, const Epi& E) {
    const int tid = threadIdx.x, wid = __builtin_amdgcn_readfirstlane(tid >> 6), lane = tid & 63, wr = wid >> 2, wc = wid & 3, fr = lane & 15, fq = lane >> 4;
    const int K = g.K, nt = K / BK;
    unsigned voffA, voffB, voffE;
    { int R, C; stage_rc(tid * 16, R, C); const int Rb = Epi::PERM ? ((R & ~31) + perm32(R & 31)) : R;
        voffA = (unsigned)(R * K + C) * 2u; voffB = (unsigned)(Rb * K + C) * 2u; }
    { const int b = tid * 4; int R, C; stage_rc(b & ~15, R, C); C += (b & 15) >> 1; voffE = (unsigned)(R * K + C) * 2u; }
    const size_t kstep = (size_t)(BK * 2);
    const size_t hstep = (size_t)HALF * K * 2;
    const size_t tstep = 2 * hstep;
    const size_t qstep = (size_t)64 * K * 2;
    const size_t estep = (size_t)16 * K * 2;
    const unsigned ldsw = (unsigned)wid * 1024u;
    const int aoff = lds_byte(wr * 64 + fr, fq * 8), boff = lds_byte(wc * 32 + fr, fq * 8), eoff = lds_byte(fr, fq * 8);
    constexpr int ES0 = 135168;
#define PG8_SA(b, h) (((b) * 2 + (h)) * HTB)
#define PG8_SB(b, h) ((4 + (b) * 2 + (h)) * HTB)
#define PG8_STAGE(bufoff, gbase, voff) do { _Pragma("unroll") for (int _i = 0; _i < 2; ++_i) \
        __builtin_amdgcn_global_load_lds((const unsigned*)((const char*)(gbase) + (size_t)_i * qstep + (voff)), (PG8_LAS unsigned*)(lds + (bufoff) + ldsw + _i * 8192), 16, 0, 0); } while (0)
#define PG8_STAGE_E(b, gbase) __builtin_amdgcn_global_load_lds((const unsigned*)((const char*)(gbase) + voffE), (PG8_LAS unsigned*)(lds + ES0 + (b) * 2048 + wid * 256), 4, 0, 0)
#define PG8_LDA(dst, b, h) do { _Pragma("unroll") for (int m = 0; m < 4; ++m) _Pragma("unroll") for (int k = 0; k < 2; ++k) dst[m][k] = *(const PG8_LAS bf16x8*)(lds + PG8_SA(b, h) + aoff + m * 2048 + k * 1024); } while (0)
#define PG8_LDB(dst, b, h) do { _Pragma("unroll") for (int n = 0; n < 2; ++n) _Pragma("unroll") for (int k = 0; k < 2; ++k) dst[n][k] = *(const PG8_LAS bf16x8*)(lds + PG8_SB(b, h) + boff + n * 2048 + k * 1024); } while (0)
#define PG8_LDE(dst, b) do { _Pragma("unroll") for (int k = 0; k < 2; ++k) dst[k] = *(const PG8_LAS bf16x8*)(lds + ES0 + (b) * 2048 + eoff + k * 1024); } while (0)
#define PG8_MMA(ai, bj, At, Bt) do { __builtin_amdgcn_s_setprio(1); _Pragma("unroll") for (int m = 0; m < 4; ++m) _Pragma("unroll") for (int n = 0; n < 2; ++n) _Pragma("unroll") for (int k = 0; k < 2; ++k) \
        acc[ai][bj][m][n] = __builtin_amdgcn_mfma_f32_16x16x32_bf16(Bt[n][k], At[m][k], acc[ai][bj][m][n], 0, 0, 0); __builtin_amdgcn_s_setprio(0); } while (0)
#define PG8_MMA_E(Bt) do { _Pragma("unroll") for (int n = 0; n < 2; ++n) _Pragma("unroll") for (int k = 0; k < 2; ++k) accE[n] = __builtin_amdgcn_mfma_f32_16x16x32_bf16(Bt[n][k], Et[k], accE[n], 0, 0, 0); } while (0)
#define PG8_WAIT_V(n) asm volatile("s_waitcnt vmcnt(" #n ")" ::: "memory")
#define PG8_WAIT_L(n) asm volatile("s_waitcnt lgkmcnt(" #n ")" ::: "memory")
#define PG8_BAR __builtin_amdgcn_s_barrier()
#define PG8_SCHED __builtin_amdgcn_sched_barrier(0)
    Unit cur, nxt; int ui = 0;
    if (!S.next(0, cur)) return;
    f32x4 acc[2][2][4][2], accE[2];
#pragma unroll
    for (int a = 0; a < 2; ++a)
#pragma unroll
        for (int b = 0; b < 2; ++b)
#pragma unroll
            for (int m = 0; m < 4; ++m)
#pragma unroll
                for (int n = 0; n < 2; ++n) acc[a][b][m][n] = (f32x4){0.f, 0.f, 0.f, 0.f};
    accE[0] = (f32x4){0.f, 0.f, 0.f, 0.f}; accE[1] = accE[0];
    bf16x8 At[4][2], B0[2][2], B1[2][2], Et[2];
    const char* cA = (const char*)g.A + (size_t)cur.pm * tstep; const char* cB = (const char*)g.Bt + (size_t)cur.pn * tstep;
    const char* cE = (const char*)g.A + (size_t)Mx * K * 2 + (size_t)cur.pm * estep;
    S.a_ready(cur);
    PG8_STAGE(PG8_SB(0, 0), cB, voffB); PG8_STAGE(PG8_SB(0, 1), cB + hstep, voffB); PG8_STAGE(PG8_SA(0, 0), cA, voffA); PG8_STAGE_E(0, cE); PG8_STAGE(PG8_SA(0, 1), cA + hstep, voffA);
    if (wr == 1) PG8_BAR;
    PG8_WAIT_V(2); PG8_BAR;
    PG8_STAGE(PG8_SB(1, 0), cB + kstep, voffB); PG8_STAGE(PG8_SA(1, 0), cA + kstep, voffA); PG8_STAGE(PG8_SB(1, 1), cB + hstep + kstep, voffB);
    PG8_WAIT_V(6); PG8_BAR;
    for (;;) {
        const bool has_next = S.next(ui + 1, nxt);
        const char* nA = has_next ? (const char*)g.A + (size_t)nxt.pm * tstep : cA; const char* nB = has_next ? (const char*)g.Bt + (size_t)nxt.pn * tstep : cB;
        const char* nE = has_next ? (const char*)g.A + (size_t)Mx * K * 2 + (size_t)nxt.pm * estep : cE;
        for (int t = 0; t < nt; t += 2) {
            const bool last = (t == nt - 2);
            const char* a1 = cA + (size_t)(t + 1) * kstep;
            const char* a2 = last ? nA : cA + (size_t)(t + 2) * kstep; const char* b2 = last ? nB : cB + (size_t)(t + 2) * kstep; const char* e2 = last ? nE : cE + (size_t)(t + 2) * kstep;
            const char* a3 = a2 + kstep; const char* b3 = b2 + kstep; const char* e1 = cE + (size_t)(t + 1) * kstep;
            if (last && has_next) S.a_ready(nxt);
            PG8_LDB(B0, 0, 0); PG8_LDB(B1, 0, 1); PG8_SCHED; PG8_LDA(At, 0, 0); PG8_STAGE_E(1, e1); PG8_STAGE(PG8_SA(1, 1), a1 + hstep, voffA);
            PG8_WAIT_V(9); PG8_WAIT_L(0); PG8_BAR; PG8_MMA(0, 0, At, B0); PG8_MMA(0, 1, At, B1); PG8_SCHED; PG8_LDE(Et, 0); PG8_WAIT_L(0); if (wr == 0) PG8_MMA_E(B0); else PG8_MMA_E(B1); PG8_BAR; PG8_SCHED;
            PG8_LDA(At, 0, 1); PG8_STAGE(PG8_SB(0, 0), b2, voffB); PG8_STAGE(PG8_SB(0, 1), b2 + hstep, voffB); PG8_STAGE(PG8_SA(0, 0), a2, voffA);
            PG8_WAIT_V(8); PG8_WAIT_L(0); PG8_BAR; PG8_MMA(1, 0, At, B0); PG8_MMA(1, 1, At, B1); PG8_BAR; PG8_SCHED;
            PG8_LDB(B0, 1, 0); PG8_LDB(B1, 1, 1); PG8_SCHED; PG8_LDA(At, 1, 0); PG8_STAGE_E(0, e2); PG8_STAGE(PG8_SA(0, 1), a2 + hstep, voffA);
            PG8_WAIT_V(9); PG8_WAIT_L(0); PG8_BAR; PG8_MMA(0, 0, At, B0); PG8_MMA(0, 1, At, B1); PG8_SCHED; PG8_LDE(Et, 1); PG8_WAIT_L(0); if (wr == 0) PG8_MMA_E(B0); else PG8_MMA_E(B1); PG8_BAR; PG8_SCHED;
            PG8_LDA(At, 1, 1); PG8_STAGE(PG8_SB(1, 0), b3, voffB); PG8_STAGE(PG8_SB(1, 1), b3 + hstep, voffB); PG8_STAGE(PG8_SA(1, 0), a3, voffA);
            PG8_WAIT_V(8); PG8_WAIT_L(0); PG8_BAR; PG8_MMA(1, 0, At, B0); PG8_MMA(1, 1, At, B1); PG8_BAR; PG8_SCHED;
        }
        if (wr == 0) PG8_BAR;
        E(acc, cur, wr, wc, fr, fq); E.extra(accE, cur, wr, wc, fr, fq); S.done(cur);
        if (!has_next) break;
#pragma unroll
        for (int a = 0; a < 2; ++a)
#pragma unroll
            for (int b = 0; b < 2; ++b)
#pragma unroll
                for (int m = 0; m < 4; ++m)
#pragma unroll
                    for (int n = 0; n < 2; ++n) acc[a][b][m][n] = (f32x4){0.f, 0.f, 0.f, 0.f};
        accE[0] = (f32x4){0.f, 0.f, 0.f, 0.f}; accE[1] = accE[0];
        cur = nxt; cA = nA; cB = nB; cE = nE; ++ui;
        if (wr == 1) PG8_BAR;
    }
    PG8_WAIT_V(0);
    PG8_BAR;
#undef PG8_SA
#undef PG8_SB
#undef PG8_STAGE
#undef PG8_STAGE_E
#undef PG8_LDA
#undef PG8_LDB
#undef PG8_LDE
#undef PG8_MMA
#undef PG8_MMA_E
#undef PG8_WAIT_V
#undef PG8_WAIT_L
#undef PG8_BAR
#undef PG8_SCHED
}
}
constexpr int NWAVES = 8;
#ifndef MK_N_LAUNCHES
#define MK_N_LAUNCHES 1
#endif
constexpr int N_PHASES = 14;
constexpr int MROWS = 17408, MP = 16384, DM = 1024, DFF = 4096, NIN1 = 3088, NIN1P = 3328;
constexpr size_t MiB = 1u << 20;
constexpr size_t WS_CTL = 0, CTL_ZERO_BYTES = 1 * MiB;
constexpr size_t WS_SS = 128 * 1024;
constexpr size_t WS_LB = 1 * MiB;
constexpr size_t WS_WIN0 = 2 * MiB, WS_WOUT0 = 10 * MiB, WS_WUP0 = 12 * MiB, WS_WDN0 = 20 * MiB, WS_WIN1 = 28 * MiB, WS_WOUT1 = 35 * MiB, WS_WUP1 = 37 * MiB, WS_WDN1 = 45 * MiB;
constexpr size_t WS_XB = 53 * MiB;
constexpr size_t WS_ACT = 87 * MiB;
constexpr size_t ACT_T = (size_t)MROWS * 1024 * 2;
constexpr size_t WS_Q = WS_ACT, WS_LF = WS_ACT + ACT_T, WS_V = WS_ACT + 2 * ACT_T, WS_G = WS_ACT + 3 * ACT_T;
constexpr size_t WS_QM = WS_ACT, WS_KM = WS_ACT + ACT_T / 2, WS_VM = WS_ACT + ACT_T, WS_OM = WS_ACT + 2 * ACT_T, WS_GT = WS_ACT + 3 * ACT_T;
constexpr size_t WS_END = WS_ACT + 4 * ACT_T;
static_assert(WS_END <= 224 * MiB, "d_ws map");
constexpr int CW_BAR = 4096;
constexpr size_t OUT_Y = 0, OUT_SP = 17825792, OUT_CP = 18874368, OUT_NP = 19398656, OUT_MP = 19402752, OUT_SS = 19402816, OUT_CS = 36180032, OUT_NS = 44568640, OUT_MS = 44634176, OUT_END = 44635200;
constexpr int RING_BYTES = 131072, LDSCTL_OFF = RING_BYTES, MISC_OFF = LDSCTL_OFF + 320, LDS_BYTES = 147456;

#define GAS __attribute__((address_space(1)))
#define LAS __attribute__((address_space(3)))
typedef unsigned short bf16;
typedef unsigned v4u __attribute__((ext_vector_type(4)));
typedef unsigned v2u __attribute__((ext_vector_type(2)));
typedef float f32x4 __attribute__((ext_vector_type(4)));
typedef float f32x2 __attribute__((ext_vector_type(2)));
typedef short bf16x8 __attribute__((ext_vector_type(8)));
typedef GAS unsigned gu32;
#define RLX_AGENT __ATOMIC_RELAXED, __HIP_MEMORY_SCOPE_AGENT
#define LDS_WAIT() asm volatile("s_waitcnt lgkmcnt(0)" ::: "memory")
#define VM_WAIT() asm volatile("s_waitcnt vmcnt(0)" ::: "memory")
__device__ __forceinline__ unsigned f2bf(float f) { unsigned u = __builtin_bit_cast(unsigned, f); return (u + 0x7fffu + ((u >> 16) & 1u)) >> 16; }
typedef __bf16 bf16x2c __attribute__((ext_vector_type(2)));
__device__ __forceinline__ unsigned pk2(float lo, float hi) { f32x2 v = {lo, hi}; bf16x2c b = __builtin_convertvector(v, bf16x2c); return __builtin_bit_cast(unsigned, b); }
__device__ __forceinline__ float bflo(unsigned w) { return __builtin_bit_cast(float, w << 16); }
__device__ __forceinline__ float bfhi(unsigned w) { return __builtin_bit_cast(float, w & 0xffff0000u); }
__device__ __forceinline__ float bf1(unsigned short h) { return __builtin_bit_cast(float, (unsigned)h << 16); }
__device__ __forceinline__ float hlo(unsigned w) { return (float)__builtin_bit_cast(_Float16, (unsigned short)(w & 0xffffu)); }
__device__ __forceinline__ float hhi(unsigned w) { return (float)__builtin_bit_cast(_Float16, (unsigned short)(w >> 16)); }
__device__ __forceinline__ float h1(unsigned short h) { return (float)__builtin_bit_cast(_Float16, h); }

#define XB_TMO      128
#define XB_XCNT(j)  (256  + 64 * (j))
#define XB_XSUB(j)  (1280 + 64 * (j))
#define XB_XGEN(j)  (2304 + 64 * (j))
#define XB_TOP      3328
#define XB_TOPGEN   3392
#define XCD_BAR_WORDS 3456
#define XB_SPIN_CAP (1u << 18)
__device__ __forceinline__ unsigned xb_ld(unsigned* p)              { return __hip_atomic_load(p, __ATOMIC_RELAXED, __HIP_MEMORY_SCOPE_AGENT); }
__device__ __forceinline__ unsigned xb_add(unsigned* p, unsigned v) { return __hip_atomic_fetch_add(p, v, __ATOMIC_RELAXED, __HIP_MEMORY_SCOPE_AGENT); }
__device__ __forceinline__ unsigned xb_xcc_id() { return (unsigned)__builtin_amdgcn_s_getreg((3 << 11) | 20) & 0xFu; }
#define XB_SPIN(cond, bar) do { unsigned _sp = 0; while (cond) { __builtin_amdgcn_s_sleep(1); \
    if ((++_sp & 255u) == 0u) { if (xb_ld(&(bar)[XB_TMO])) break; if (_sp > XB_SPIN_CAP) { atomicAdd(&(bar)[XB_TMO], 1u); break; } } } } while (0)
struct XcdBarrier { unsigned* bar; unsigned x; volatile LAS unsigned* st; };
__device__ __forceinline__ XcdBarrier xcd_barrier_post(unsigned* bar, volatile LAS unsigned* st) {
    XcdBarrier b; b.bar = bar; b.x = xb_xcc_id(); b.st = st;
    if (threadIdx.x == 0) (void)xb_add(&bar[XB_XCNT(b.x)], 1u);
    return b;
}
__device__ __forceinline__ void xcd_barrier_complete(unsigned* bar, unsigned x, unsigned& nloc, unsigned& nx) {
    const unsigned G = gridDim.x * gridDim.y * gridDim.z;
    unsigned sum, cnt, mine, sp = 0u;
    for (;;) {
        sum = 0u; cnt = 0u; mine = 0u;
#pragma unroll
        for (unsigned j = 0; j < 16; ++j) { const unsigned c = xb_ld(&bar[XB_XCNT(j)]); sum += c; cnt += (c > 0u) ? 1u : 0u; mine = (j == x) ? c : mine; }
        if (sum == G) break;
        __builtin_amdgcn_s_sleep(1);
        if ((++sp & 255u) == 0u) { if (xb_ld(&bar[XB_TMO])) break; if (sp > XB_SPIN_CAP) { atomicAdd(&bar[XB_TMO], 1u); break; } }
    }
    nloc = mine > 0u ? mine : 1u; nx = cnt > 0u ? cnt : 1u;
}
__device__ __forceinline__ void xcd_barrier(const XcdBarrier& b) {
    asm volatile("s_waitcnt vmcnt(0)" ::: "memory");
    __syncthreads();
    if (threadIdx.x == 0) {
        unsigned* bar = b.bar;
        __builtin_amdgcn_s_waitcnt(0);
        unsigned nloc = b.st[0], nx = b.st[1];
        if (nloc == 0u) { xcd_barrier_complete(bar, b.x, nloc, nx); b.st[0] = nloc; b.st[1] = nx; }
        const unsigned old = xb_add(&bar[XB_XSUB(b.x)], 1u);
        const unsigned gen = old / nloc;
        if (old + 1u == (gen + 1u) * nloc) {
            __builtin_amdgcn_fence(__ATOMIC_RELEASE, "agent");
            asm volatile("s_waitcnt vmcnt(0)" ::: "memory");
            const unsigned og = xb_add(&bar[XB_TOP], 1u);
            const unsigned tg = og / nx;
            if (og + 1u == (tg + 1u) * nx) xb_add(&bar[XB_TOPGEN], 1u);
            else XB_SPIN(xb_ld(&bar[XB_TOPGEN]) == tg, bar);
            __builtin_amdgcn_fence(__ATOMIC_ACQUIRE, "agent");
            xb_add(&bar[XB_XGEN(b.x)], 1u);
            asm volatile("s_waitcnt vmcnt(0)" ::: "memory");
        } else {
            XB_SPIN(xb_ld(&bar[XB_XGEN(b.x)]) == gen, bar);
            __builtin_amdgcn_fence(__ATOMIC_ACQUIRE, "agent");
            asm volatile("s_waitcnt vmcnt(0)" ::: "memory");
        }
    }
    __syncthreads();
}

__device__ __forceinline__ float wave_sum(float v) {
#pragma unroll
    for (int o = 1; o < 64; o <<= 1) v += __shfl_xor(v, o);
    return v;
}
__device__ __forceinline__ void p0_transpose_item(const float* W, int K, int N, const float* sc, bf16* WT, LAS float* scr, int item, int lane) {
    const int nblk = (N + 31) / 32, kb = item / nblk, nb = item % nblk, k0 = 64 * kb, n0 = 32 * nb;
    const bool nok = (n0 + (lane & 31)) < N;
#pragma unroll 8
    for (int i = 0; i < 32; ++i) { const int kk = 2 * i + (lane >> 5); float v = nok ? W[(size_t)(k0 + kk) * N + n0 + (lane & 31)] : 0.f; if (sc) v *= sc[k0 + kk]; scr[kk * 33 + (lane & 31)] = v; }
    LDS_WAIT(); asm volatile("" ::: "memory");
    const int c = lane & 7;
#pragma unroll
    for (int j = 0; j < 4; ++j) { const int n = (lane >> 3) + 8 * j; const LAS float* s = scr + (8 * c) * 33 + n;
        v4u o; o.x = pk2(s[0 * 33], s[1 * 33]); o.y = pk2(s[2 * 33], s[3 * 33]); o.z = pk2(s[4 * 33], s[5 * 33]); o.w = pk2(s[6 * 33], s[7 * 33]);
        *(GAS v4u*)(WT + (size_t)(n0 + n) * K + k0 + 8 * c) = o; }
    LDS_WAIT(); asm volatile("" ::: "memory");
}
#define MFMA16(a, b, c) __builtin_amdgcn_mfma_f32_16x16x32_bf16((a), (b), (c), 0, 0, 0)
#define LDSV(T, off) (*(LAS T*)(lds + (off)))
#define LDSF(off) (*(const LAS bf16x8*)(lds + (off)))
#define BAR_LDS() do { asm volatile("s_waitcnt lgkmcnt(0)" ::: "memory"); __builtin_amdgcn_s_barrier(); asm volatile("" ::: "memory"); } while (0)
namespace hg {
constexpr int QP = 0, KP = QP + 64 * 272, KPPT = KP + 64 * 272, VT = KPPT + 128 * 144, AM = VT + 128 * 144, ST = AM + 64 * 144, GT = ST + 128 * 272, DEC = GT + 8 * 128 * 4, NP = DEC + 512, END = NP + 512;
static_assert(END <= RING_BYTES, "hgrn LDS");
}
template <bool STATE_ONLY>
__device__ __forceinline__ void hgrn_seg_item(LAS unsigned char* lds, int b, int h, int g, const bf16* Qb, const bf16* LFb, const bf16* Vb, const bf16* Gb, bf16* Ob, const float* onw, float* Escr, float* Dscr, float* S_out) {
    using namespace hg;
    constexpr int NCH = 8;
    const int tid = threadIdx.x, lane = tid & 63, w = __builtin_amdgcn_readfirstlane(tid >> 6), fr = lane & 15, fq = lane >> 4;
    const int tb = w & 3, wh = w >> 2;
    const size_t rowb = (size_t)b * 2048 + (size_t)g * 512;
    const int colp = h * 128 + 2 * lane;
    const int item0 = (b * 8 + h) * 4;
    __syncthreads();
    f32x4 sacc[8];
#pragma unroll
    for (int j = 0; j < 8; ++j) sacc[j] = (f32x4){0.f, 0.f, 0.f, 0.f};
    if (!STATE_ONLY && g > 0) {
#pragma unroll
        for (int j = 0; j < 8; ++j) sacc[j] = *(const f32x4*)(Escr + ((size_t)item0 * 16384) + ((w * 8 + j) * 64 + lane) * 4);
        for (int gg = 1; gg < g; ++gg) { const f32x4 dec = *(const f32x4*)(Dscr + (item0 + gg) * 128 + 16 * w + 4 * fq);
#pragma unroll
            for (int j = 0; j < 8; ++j) sacc[j] = sacc[j] * dec + *(const f32x4*)(Escr + ((size_t)(item0 + gg) * 16384) + ((w * 8 + j) * 64 + lane) * 4); }
#pragma unroll
        for (int j = 0; j < 8; ++j) LDSV(v2u, ST + (j * 16 + fr) * 272 + (16 * w + 4 * fq) * 2) = (v2u){pk2(sacc[j][0], sacc[j][1]), pk2(sacc[j][2], sacc[j][3])};
    } else if (!STATE_ONLY) {
        for (int i = tid; i < 128 * 272 / 4; i += 512) LDSV(unsigned, ST + 4 * i) = 0u;
    }
    __syncthreads();
    f32x4 wn[4];
#pragma unroll
    for (int j = 0; j < 4; ++j) wn[j] = *(const f32x4*)(onw + h * 128 + (4 * wh + j) * 16 + 4 * fq);
    unsigned rq[8], rl[8], rv[8]; float bp0 = 0.f, bp1 = 0.f;
#pragma unroll
    for (int i = 0; i < 8; ++i) { const size_t e = (rowb + 8 * w + i) * 1024 + colp; if (!STATE_ONLY) rq[i] = *(const unsigned*)(Qb + e); rl[i] = *(const unsigned*)(LFb + e); rv[i] = *(const unsigned*)(Vb + e); }
    for (int c = 0; c < NCH; ++c) {
        float c0[8], c1[8]; { float a0 = 0.f, a1 = 0.f;
#pragma unroll
            for (int i = 0; i < 8; ++i) { a0 += hlo(rl[i]); a1 += hhi(rl[i]); c0[i] = a0; c1[i] = a1; }
            LDSV(f32x2, GT + (w * 128 + 2 * lane) * 4) = (f32x2){a0, a1}; }
        BAR_LDS();
        float pre0 = 0.f, pre1 = 0.f, tot0 = 0.f, tot1 = 0.f;
#pragma unroll
        for (int gi = 0; gi < 8; ++gi) { const f32x2 x = LDSV(f32x2, GT + (gi * 128 + 2 * lane) * 4); tot0 += x.x; tot1 += x.y; if (gi < w) { pre0 += x.x; pre1 += x.y; } }
        if (w == 0) LDSV(f32x2, DEC + 2 * lane * 4) = (f32x2){__expf(tot0), __expf(tot1)};
        bp0 += tot0; bp1 += tot1;
        { unsigned kk0[4], kk1[4], vv0[4], vv1[4]; float pk0 = 0.f, pk1 = 0.f;
#pragma unroll
            for (int i = 0; i < 8; ++i) {
                const float b0 = pre0 + c0[i], b1 = pre1 + c1[i];
                const float k0 = 1.0f - __expf(hlo(rl[i])), k1 = 1.0f - __expf(hhi(rl[i]));
                const float l0 = __expf(tot0 - b0), l1 = __expf(tot1 - b1);
                if (!STATE_ONLY) { const float e0 = __expf(b0), e1 = __expf(b1), n0 = __expf(-b0), n1 = __expf(-b1);
                    LDSV(unsigned, QP + (8 * w + i) * 272 + 4 * lane) = pk2(bflo(rq[i]) * e0, bfhi(rq[i]) * e1);
                    LDSV(unsigned, KP + (8 * w + i) * 272 + 4 * lane) = pk2(k0 * n0, k1 * n1); }
                const float x0 = k0 * l0, x1 = k1 * l1;
                if (i & 1) { kk0[i >> 1] = pk2(pk0, x0); kk1[i >> 1] = pk2(pk1, x1); vv0[i >> 1] = (rv[i - 1] & 0xffffu) | (rv[i] << 16); vv1[i >> 1] = (rv[i - 1] >> 16) | (rv[i] & 0xffff0000u); }
                else { pk0 = x0; pk1 = x1; }
            }
            LDSV(v4u, KPPT + (2 * lane) * 144 + 16 * w) = (v4u){kk0[0], kk0[1], kk0[2], kk0[3]};
            LDSV(v4u, KPPT + (2 * lane + 1) * 144 + 16 * w) = (v4u){kk1[0], kk1[1], kk1[2], kk1[3]};
            LDSV(v4u, VT + (2 * lane) * 144 + 16 * w) = (v4u){vv0[0], vv0[1], vv0[2], vv0[3]};
            LDSV(v4u, VT + (2 * lane + 1) * 144 + 16 * w) = (v4u){vv1[0], vv1[1], vv1[2], vv1[3]}; }
        const size_t orow = (rowb + (size_t)c * 64 + tb * 16 + fr) * 1024 + h * 128 + 4 * fq;
        v2u rg[4];
        if (!STATE_ONLY) {
#pragma unroll
            for (int j = 0; j < 4; ++j) rg[j] = *(const v2u*)(Gb + orow + (4 * wh + j) * 16);
        }
        if (c + 1 < NCH) {
#pragma unroll
            for (int i = 0; i < 8; ++i) { const size_t e = (rowb + (size_t)(c + 1) * 64 + 8 * w + i) * 1024 + colp; if (!STATE_ONLY) rq[i] = *(const unsigned*)(Qb + e); rl[i] = *(const unsigned*)(LFb + e); rv[i] = *(const unsigned*)(Vb + e); }
        }
        BAR_LDS();
        f32x4 oacc[4];
        if (!STATE_ONLY) {
#pragma unroll
        for (int j = 0; j < 2; ++j) { const int sb = 2 * wh + j; f32x4 a = (f32x4){0.f, 0.f, 0.f, 0.f};
            if (sb <= tb) {
#pragma unroll
                for (int kk = 0; kk < 4; ++kk) a = MFMA16(LDSF(KP + (sb * 16 + fr) * 272 + kk * 64 + fq * 16), LDSF(QP + (tb * 16 + fr) * 272 + kk * 64 + fq * 16), a);
                const int t = tb * 16 + fr, s0 = sb * 16 + 4 * fq;
#pragma unroll
                for (int r = 0; r < 4; ++r) if (s0 + r > t) a[r] = 0.f;
            }
            LDSV(v2u, AM + (tb * 16 + fr) * 144 + (sb * 16 + 4 * fq) * 2) = (v2u){pk2(a[0], a[1]), pk2(a[2], a[3])}; }
        BAR_LDS();
        { bf16x8 bA[2], bQ[4];
#pragma unroll
            for (int kk = 0; kk < 2; ++kk) bA[kk] = LDSF(AM + (tb * 16 + fr) * 144 + kk * 64 + fq * 16);
#pragma unroll
            for (int kk = 0; kk < 4; ++kk) bQ[kk] = LDSF(QP + (tb * 16 + fr) * 272 + kk * 64 + fq * 16);
#pragma unroll
            for (int j = 0; j < 4; ++j) { const int dvb = 4 * wh + j; f32x4 a = (f32x4){0.f, 0.f, 0.f, 0.f};
#pragma unroll
                for (int kk = 0; kk < 2; ++kk) a = MFMA16(LDSF(VT + (dvb * 16 + fr) * 144 + kk * 64 + fq * 16), bA[kk], a);
#pragma unroll
                for (int kk = 0; kk < 4; ++kk) a = MFMA16(LDSF(ST + (dvb * 16 + fr) * 272 + kk * 64 + fq * 16), bQ[kk], a);
                oacc[j] = a; } }
        { float ss = 0.f;
#pragma unroll
            for (int j = 0; j < 4; ++j) ss += (oacc[j][0] * oacc[j][0] + oacc[j][1] * oacc[j][1]) + (oacc[j][2] * oacc[j][2] + oacc[j][3] * oacc[j][3]);
            ss += __shfl_xor(ss, 16); ss += __shfl_xor(ss, 32);
            if (fq == 0) LDSV(float, NP + ((tb * 16 + fr) * 2 + wh) * 4) = ss; }
        }
        { const f32x4 dec = LDSV(f32x4, DEC + (16 * w + 4 * fq) * 4); bf16x8 aK[2];
#pragma unroll
            for (int kk = 0; kk < 2; ++kk) aK[kk] = LDSF(KPPT + (16 * w + fr) * 144 + kk * 64 + fq * 16);
#pragma unroll
            for (int j = 0; j < 8; ++j) { f32x4 a = sacc[j] * dec;
#pragma unroll
                for (int kk = 0; kk < 2; ++kk) a = MFMA16(aK[kk], LDSF(VT + (j * 16 + fr) * 144 + kk * 64 + fq * 16), a);
                sacc[j] = a; } }
        BAR_LDS();
        if (!STATE_ONLY) {
        { const f32x2 p = LDSV(f32x2, NP + (tb * 16 + fr) * 8); const float rstd = rsqrtf((p.x + p.y) * (1.0f / 128.0f) + 1e-6f);
#pragma unroll
            for (int j = 0; j < 4; ++j) { const f32x4 o = oacc[j] * rstd * wn[j];
                *(v2u*)(Ob + orow + (4 * wh + j) * 16) = (v2u){pk2(o[0] * bflo(rg[j].x), o[1] * bfhi(rg[j].x)), pk2(o[2] * bflo(rg[j].y), o[3] * bfhi(rg[j].y))}; } }
#pragma unroll
        for (int j = 0; j < 8; ++j) LDSV(v2u, ST + (j * 16 + fr) * 272 + (16 * w + 4 * fq) * 2) = (v2u){pk2(sacc[j][0], sacc[j][1]), pk2(sacc[j][2], sacc[j][3])};
        }
    }
    if (STATE_ONLY) {
#pragma unroll
        for (int j = 0; j < 8; ++j) *(f32x4*)(Escr + ((size_t)(item0 + g) * 16384) + ((w * 8 + j) * 64 + lane) * 4) = sacc[j];
        if (w == 0) *(f32x2*)(Dscr + (item0 + g) * 128 + 2 * lane) = (f32x2){__expf(bp0), __expf(bp1)};
    } else if (g == 3) {
        float* so = S_out + (size_t)(b * 8 + h) * 128 * 128;
#pragma unroll
        for (int j = 0; j < 8; ++j)
#pragma unroll
            for (int r = 0; r < 4; ++r) so[(size_t)(16 * w + 4 * fq + r) * 128 + j * 16 + fr] = sacc[j][r];
    }
}
__device__ __forceinline__ void hgrn_sample_item(LAS unsigned char* lds, int b, int h, const bf16* Qb, const bf16* LFb, const bf16* Vb, const bf16* Gb, bf16* Ob, const float* onw, const float* S_in, float* S_out) {
    constexpr int FKQ = 0, VS = 16384, RED = 20480;
    const int tid = threadIdx.x, lane = tid & 63, w = __builtin_amdgcn_readfirstlane(tid >> 6), c4 = tid & 31, dg = tid >> 5;
    const size_t rowb = (size_t)MP + (size_t)b * 8;
    __syncthreads();
#pragma unroll
    for (int e = tid; e < 1024; e += 512) { const int t = e >> 7, d = e & 127; const size_t g = (rowb + t) * 1024 + h * 128 + d;
        const float f = __expf(h1(LFb[g])); LDSV(f32x4, FKQ + e * 16) = (f32x4){f, 1.0f - f, bf1(Qb[g]), 0.f}; LDSV(float, VS + e * 4) = bf1(Vb[g]); }
    const size_t sbase = ((size_t)(b * 8 + h) * 128 + 8 * dg) * 128 + 4 * c4;
    f32x4 s[8], po[8];
#pragma unroll
    for (int i = 0; i < 8; ++i) s[i] = *(const f32x4*)(S_in + sbase + (size_t)i * 128);
    __syncthreads();
#pragma unroll
    for (int t = 0; t < 8; ++t) { const f32x4 vv = LDSV(f32x4, VS + (t * 128 + 4 * c4) * 4); f32x4 p = (f32x4){0.f, 0.f, 0.f, 0.f};
#pragma unroll
        for (int i = 0; i < 8; ++i) { const f32x4 x = LDSV(f32x4, FKQ + (t * 128 + 8 * dg + i) * 16); s[i] = s[i] * x[0] + vv * x[1]; p += s[i] * x[2]; }
        po[t] = p; }
#pragma unroll
    for (int t = 0; t < 8; ++t) LDSV(f32x4, RED + ((dg * 8 + t) * 128 + 4 * c4) * 4) = po[t];
#pragma unroll
    for (int i = 0; i < 8; ++i) *(f32x4*)(S_out + sbase + (size_t)i * 128) = s[i];
    __syncthreads();
    { const int t = w; float o0 = 0.f, o1 = 0.f;
#pragma unroll
        for (int g = 0; g < 16; ++g) { const f32x2 x = LDSV(f32x2, RED + ((g * 8 + t) * 128 + 2 * lane) * 4); o0 += x.x; o1 += x.y; }
        const float rstd = rsqrtf(wave_sum(o0 * o0 + o1 * o1) * (1.0f / 128.0f) + 1e-6f);
        const size_t g = (rowb + t) * 1024 + h * 128 + 2 * lane; const unsigned gg = *(const unsigned*)(Gb + g);
        *(unsigned*)(Ob + g) = pk2(o0 * rstd * onw[h * 128 + 2 * lane] * bflo(gg), o1 * rstd * onw[h * 128 + 2 * lane + 1] * bfhi(gg)); }
}
namespace ml {
constexpr int Q = 0, K = Q + 64 * 144, KWT = K + 64 * 144, AM = KWT + 64 * 144, VTE = AM + 64 * 144, CTE = VTE + 144 * 144, AS = CTE + 144 * 144, MT = AS + 256, WI = MT + 256, EM = WI + 256, WS = EM + 256, DEN = WS + 256, SC = DEN + 256, NP = SC + 16, END = NP + 512;
static_assert(END <= RING_BYTES, "mlstm LDS");
}
template <bool STATE_ONLY>
__device__ __forceinline__ void mlstm_seg_item(LAS unsigned char* lds, int b, int h, int g, const bf16* Qm, const bf16* Km, const bf16* Vm, const bf16* Om, const float* GTg, bf16* Hb, const float* onw,
                                               float* Escr, float* Mscr, float* C_out, float* n_out, float* m_out) {
    using namespace ml;
    constexpr int NCH = 8;
    const int tid = threadIdx.x, lane = tid & 63, w = __builtin_amdgcn_readfirstlane(tid >> 6), fr = lane & 15, fq = lane >> 4;
    const int tb = w & 3, wh = w >> 2;
    const size_t rowb = (size_t)b * 2048 + (size_t)g * 512;
    const int dp = tid & 31, tg4 = tid >> 5;
    const int item0 = (b * 8 + h) * 4;
    __syncthreads();
    for (int i = tid; i < 144 * 144 / 4; i += 512) { LDSV(unsigned, CTE + 4 * i) = 0u; const int row = (4 * i) / 144; LDSV(unsigned, VTE + 4 * i) = row == 128 ? 0x3f803f80u : 0u; }
    __syncthreads();
    f32x4 cacc[5];
#pragma unroll
    for (int j = 0; j < 5; ++j) cacc[j] = (f32x4){0.f, 0.f, 0.f, 0.f};
    float m_prev = (STATE_ONLY && g > 0) ? -INFINITY : 0.f, btot = 0.f;
    if (!STATE_ONLY && g > 0) {
#pragma unroll
        for (int j = 0; j < 5; ++j) cacc[j] = *(const f32x4*)(Escr + (size_t)item0 * 10240 + ((w * 5 + j) * 64 + lane) * 4);
        m_prev = Mscr[item0 * 2];
        for (int gg = 1; gg < g; ++gg) { const float mE = Mscr[(item0 + gg) * 2], Bt = Mscr[(item0 + gg) * 2 + 1]; const float mn = fmaxf(m_prev + Bt, mE), f1 = __expf(m_prev + Bt - mn), f2 = __expf(mE - mn);
#pragma unroll
            for (int j = 0; j < 5; ++j) cacc[j] = cacc[j] * f1 + *(const f32x4*)(Escr + (size_t)(item0 + gg) * 10240 + ((w * 5 + j) * 64 + lane) * 4) * f2;
            m_prev = mn; }
#pragma unroll
        for (int j = 0; j < 5; ++j) { if (j == 4 && wh != 0) break; const int dvb = j == 4 ? 8 : 4 * wh + j;
            LDSV(v2u, CTE + (dvb * 16 + fr) * 144 + (16 * tb + 4 * fq) * 2) = (v2u){pk2(cacc[j][0], cacc[j][1]), pk2(cacc[j][2], cacc[j][3])}; }
    }
    f32x4 wn[4];
#pragma unroll
    for (int j = 0; j < 4; ++j) wn[j] = *(const f32x4*)(onw + h * 128 + (4 * wh + j) * 16 + 4 * fq);
    unsigned rq[4], rk[4], rv[8]; float gli = 0.f, glf = 0.f;
#pragma unroll
    for (int i = 0; i < 4; ++i) { const size_t e = (rowb + 4 * tg4 + i) * 512 + h * 64 + 2 * dp; if (!STATE_ONLY) rq[i] = *(const unsigned*)(Qm + e); rk[i] = *(const unsigned*)(Km + e); }
#pragma unroll
    for (int i = 0; i < 8; ++i) rv[i] = *(const unsigned*)(Vm + (rowb + 8 * w + i) * 1024 + h * 128 + 2 * lane);
    if (w == 0) { gli = GTg[(rowb + lane) * 16 + h]; glf = GTg[(rowb + lane) * 16 + 8 + h]; }
    for (int c = 0; c < NCH; ++c) {
        if (w == 0) {
            float bs = glf;
#pragma unroll
            for (int o = 1; o < 64; o <<= 1) { const float x = __shfl_up(bs, o); if (lane >= o) bs += x; }
            const float a = gli - bs; float pm = a;
#pragma unroll
            for (int o = 1; o < 64; o <<= 1) { const float x = __shfl_up(pm, o); if (lane >= o) pm = fmaxf(pm, x); }
            const float Mt = fmaxf(m_prev, pm), M63 = __shfl(Mt, 63), b63 = __shfl(bs, 63);
            LDSV(float, AS + 4 * lane) = a; LDSV(float, MT + 4 * lane) = Mt; LDSV(float, WI + 4 * lane) = __expf(m_prev - Mt); LDSV(float, EM + 4 * lane) = __expf(-(bs + Mt)); LDSV(float, WS + 4 * lane) = __expf(a - M63);
            if (lane == 0) { LDSV(float, SC) = __expf(m_prev - M63); LDSV(float, SC + 4) = b63 + M63; LDSV(float, SC + 8) = b63; }
        }
        if (!STATE_ONLY) {
#pragma unroll
            for (int i = 0; i < 4; ++i) { LDSV(unsigned, Q + (4 * tg4 + i) * 144 + 4 * dp) = rq[i]; LDSV(unsigned, K + (4 * tg4 + i) * 144 + 4 * dp) = rk[i]; }
        }
        LDSV(v4u, VTE + (2 * lane) * 144 + 16 * w) = (v4u){(rv[0] & 0xffffu) | (rv[1] << 16), (rv[2] & 0xffffu) | (rv[3] << 16), (rv[4] & 0xffffu) | (rv[5] << 16), (rv[6] & 0xffffu) | (rv[7] << 16)};
        LDSV(v4u, VTE + (2 * lane + 1) * 144 + 16 * w) = (v4u){(rv[0] >> 16) | (rv[1] & 0xffff0000u), (rv[2] >> 16) | (rv[3] & 0xffff0000u), (rv[4] >> 16) | (rv[5] & 0xffff0000u), (rv[6] >> 16) | (rv[7] & 0xffff0000u)};
        BAR_LDS();
        { const f32x4 ws = LDSV(f32x4, WS + 16 * tg4);
            LDSV(v2u, KWT + (2 * dp) * 144 + 8 * tg4) = (v2u){pk2(bflo(rk[0]) * ws[0], bflo(rk[1]) * ws[1]), pk2(bflo(rk[2]) * ws[2], bflo(rk[3]) * ws[3])};
            LDSV(v2u, KWT + (2 * dp + 1) * 144 + 8 * tg4) = (v2u){pk2(bfhi(rk[0]) * ws[0], bfhi(rk[1]) * ws[1]), pk2(bfhi(rk[2]) * ws[2], bfhi(rk[3]) * ws[3])}; }
        const float wc = LDSV(float, SC), m_next = LDSV(float, SC + 4); btot += LDSV(float, SC + 8);
        const size_t orow = (rowb + (size_t)c * 64 + tb * 16 + fr) * 1024 + h * 128 + 4 * fq;
        v2u rg[4];
        if (!STATE_ONLY) {
#pragma unroll
            for (int j = 0; j < 4; ++j) rg[j] = *(const v2u*)(Om + orow + (4 * wh + j) * 16);
        }
        if (c + 1 < NCH) { const size_t r1 = rowb + (size_t)(c + 1) * 64;
#pragma unroll
            for (int i = 0; i < 4; ++i) { const size_t e = (r1 + 4 * tg4 + i) * 512 + h * 64 + 2 * dp; if (!STATE_ONLY) rq[i] = *(const unsigned*)(Qm + e); rk[i] = *(const unsigned*)(Km + e); }
#pragma unroll
            for (int i = 0; i < 8; ++i) rv[i] = *(const unsigned*)(Vm + (r1 + 8 * w + i) * 1024 + h * 128 + 2 * lane);
            if (w == 0) { gli = GTg[(r1 + lane) * 16 + h]; glf = GTg[(r1 + lane) * 16 + 8 + h]; }
        }
        BAR_LDS();
        f32x4 num[5];
        if (!STATE_ONLY) {
        { const float Mt = LDSV(float, MT + (tb * 16 + fr) * 4);
#pragma unroll
            for (int j = 0; j < 2; ++j) { const int sb = 2 * wh + j; f32x4 a = (f32x4){0.f, 0.f, 0.f, 0.f};
                if (sb <= tb) {
#pragma unroll
                    for (int kk = 0; kk < 2; ++kk) a = MFMA16(LDSF(K + (sb * 16 + fr) * 144 + kk * 64 + fq * 16), LDSF(Q + (tb * 16 + fr) * 144 + kk * 64 + fq * 16), a);
                    const int t = tb * 16 + fr, s0 = sb * 16 + 4 * fq; const f32x4 as = LDSV(f32x4, AS + s0 * 4);
#pragma unroll
                    for (int r = 0; r < 4; ++r) a[r] = (s0 + r > t) ? 0.f : a[r] * __expf(as[r] - Mt);
                }
                LDSV(v2u, AM + (tb * 16 + fr) * 144 + (sb * 16 + 4 * fq) * 2) = (v2u){pk2(a[0], a[1]), pk2(a[2], a[3])}; } }
        BAR_LDS();
        { bf16x8 bA[2], bQ[2]; const float wi = LDSV(float, WI + (tb * 16 + fr) * 4);
#pragma unroll
            for (int kk = 0; kk < 2; ++kk) { bA[kk] = LDSF(AM + (tb * 16 + fr) * 144 + kk * 64 + fq * 16); bQ[kk] = LDSF(Q + (tb * 16 + fr) * 144 + kk * 64 + fq * 16); }
#pragma unroll
            for (int j = 0; j < 5; ++j) { if (j == 4 && wh != 0) break; const int dvb = j == 4 ? 8 : 4 * wh + j; f32x4 a1 = (f32x4){0.f, 0.f, 0.f, 0.f}, a2 = a1;
#pragma unroll
                for (int kk = 0; kk < 2; ++kk) { a1 = MFMA16(LDSF(VTE + (dvb * 16 + fr) * 144 + kk * 64 + fq * 16), bA[kk], a1); a2 = MFMA16(LDSF(CTE + (dvb * 16 + fr) * 144 + kk * 64 + fq * 16), bQ[kk], a2); }
                num[j] = a1 + a2 * wi; }
            if (wh == 0 && fq == 0) LDSV(float, DEN + (tb * 16 + fr) * 4) = num[4][0]; }
        }
        { bf16x8 aK[2];
#pragma unroll
            for (int kk = 0; kk < 2; ++kk) aK[kk] = LDSF(KWT + (16 * tb + fr) * 144 + kk * 64 + fq * 16);
#pragma unroll
            for (int j = 0; j < 5; ++j) { if (j == 4 && wh != 0) break; const int dvb = j == 4 ? 8 : 4 * wh + j; f32x4 a = cacc[j] * wc;
#pragma unroll
                for (int kk = 0; kk < 2; ++kk) a = MFMA16(aK[kk], LDSF(VTE + (dvb * 16 + fr) * 144 + kk * 64 + fq * 16), a);
                cacc[j] = a; } }
        BAR_LDS();
        if (!STATE_ONLY) {
        { const float dn = fmaxf(fabsf(LDSV(float, DEN + (tb * 16 + fr) * 4)), LDSV(float, EM + (tb * 16 + fr) * 4)); const float inv = 1.0f / dn; float ss = 0.f;
#pragma unroll
            for (int j = 0; j < 4; ++j) { num[j] = num[j] * inv; ss += (num[j][0] * num[j][0] + num[j][1] * num[j][1]) + (num[j][2] * num[j][2] + num[j][3] * num[j][3]); }
            ss += __shfl_xor(ss, 16); ss += __shfl_xor(ss, 32);
            if (fq == 0) LDSV(float, NP + ((tb * 16 + fr) * 2 + wh) * 4) = ss; }
        BAR_LDS();
        { const f32x2 p = LDSV(f32x2, NP + (tb * 16 + fr) * 8); const float rstd = rsqrtf((p.x + p.y) * (1.0f / 128.0f) + 1e-6f);
#pragma unroll
            for (int j = 0; j < 4; ++j) { const f32x4 o = num[j] * rstd * wn[j];
                *(v2u*)(Hb + orow + (4 * wh + j) * 16) = (v2u){pk2(o[0] * bflo(rg[j].x), o[1] * bfhi(rg[j].x)), pk2(o[2] * bflo(rg[j].y), o[3] * bfhi(rg[j].y))}; } }
#pragma unroll
        for (int j = 0; j < 5; ++j) { if (j == 4 && wh != 0) break; const int dvb = j == 4 ? 8 : 4 * wh + j;
            LDSV(v2u, CTE + (dvb * 16 + fr) * 144 + (16 * tb + 4 * fq) * 2) = (v2u){pk2(cacc[j][0], cacc[j][1]), pk2(cacc[j][2], cacc[j][3])}; }
        }
        m_prev = m_next;
    }
    if (STATE_ONLY) {
#pragma unroll
        for (int j = 0; j < 5; ++j) *(f32x4*)(Escr + (size_t)(item0 + g) * 10240 + ((w * 5 + j) * 64 + lane) * 4) = cacc[j];
        if (tid == 0) { Mscr[(item0 + g) * 2] = m_prev; Mscr[(item0 + g) * 2 + 1] = btot; }
    } else if (g == 3) {
        float* co = C_out + (size_t)(b * 8 + h) * 64 * 128;
#pragma unroll
        for (int j = 0; j < 4; ++j)
#pragma unroll
            for (int r = 0; r < 4; ++r) co[(size_t)(16 * tb + 4 * fq + r) * 128 + (4 * wh + j) * 16 + fr] = cacc[j][r];
        if (wh == 0 && fr == 0) {
#pragma unroll
            for (int r = 0; r < 4; ++r) n_out[(size_t)(b * 8 + h) * 64 + 16 * tb + 4 * fq + r] = cacc[4][r]; }
        if (tid == 0) m_out[b * 8 + h] = m_prev;
    }
}
__device__ __forceinline__ void mlstm_sample_item(LAS unsigned char* lds, int b, int h, const bf16* Qm, const bf16* Km, const bf16* Vm, const bf16* Om, const float* GTg, bf16* Hb, const float* onw,
                                                  const float* C_in, const float* n_in, const float* m_in, float* C_out, float* n_out, float* m_out) {
    constexpr int KQ = 0, VS = 4096, SCL = 8192, DENR = 8320, RED = 20480;
    const int tid = threadIdx.x, lane = tid & 63, w = __builtin_amdgcn_readfirstlane(tid >> 6), c4 = tid & 31, dg = tid >> 5;
    const size_t rowb = (size_t)MP + (size_t)b * 8;
    __syncthreads();
    { const int t = tid >> 6, d = tid & 63; const size_t g = (rowb + t) * 512 + h * 64 + d; LDSV(f32x2, KQ + tid * 8) = (f32x2){bf1(Km[g]), bf1(Qm[g])}; }
#pragma unroll
    for (int e = tid; e < 1024; e += 512) { const int t = e >> 7, d = e & 127; LDSV(float, VS + e * 4) = bf1(Vm[(rowb + t) * 1024 + h * 128 + d]); }
    if (tid == 0) { float m = m_in[b * 8 + h];
        for (int t = 0; t < 8; ++t) { const float li = GTg[(rowb + t) * 16 + h], lf = GTg[(rowb + t) * 16 + 8 + h]; const float mn = fmaxf(lf + m, li);
            LDSV(f32x4, SCL + t * 16) = (f32x4){__expf(lf + m - mn), __expf(li - mn), __expf(-mn), 0.f}; m = mn; }
        m_out[b * 8 + h] = m; }
    const size_t cbase = ((size_t)(b * 8 + h) * 64 + 4 * dg) * 128 + 4 * c4;
    f32x4 cc[4], pn[8]; float nn[4], pd[8];
#pragma unroll
    for (int i = 0; i < 4; ++i) { cc[i] = *(const f32x4*)(C_in + cbase + (size_t)i * 128); nn[i] = n_in[(size_t)(b * 8 + h) * 64 + 4 * dg + i]; }
    __syncthreads();
#pragma unroll
    for (int t = 0; t < 8; ++t) { const f32x4 vv = LDSV(f32x4, VS + (t * 128 + 4 * c4) * 4); const f32x4 sc = LDSV(f32x4, SCL + t * 16); f32x4 p = (f32x4){0.f, 0.f, 0.f, 0.f}; float d = 0.f;
#pragma unroll
        for (int i = 0; i < 4; ++i) { const f32x2 kq = LDSV(f32x2, KQ + (t * 64 + 4 * dg + i) * 8); const float ik = sc[1] * kq.x;
            cc[i] = cc[i] * sc[0] + vv * ik; p += cc[i] * kq.y; nn[i] = nn[i] * sc[0] + ik; d += nn[i] * kq.y; }
        pn[t] = p; pd[t] = d; }
#pragma unroll
    for (int t = 0; t < 8; ++t) { LDSV(f32x4, RED + ((dg * 8 + t) * 128 + 4 * c4) * 4) = pn[t]; if (c4 == 0) LDSV(float, DENR + (dg * 8 + t) * 4) = pd[t]; }
#pragma unroll
    for (int i = 0; i < 4; ++i) { *(f32x4*)(C_out + cbase + (size_t)i * 128) = cc[i]; if (c4 == 0) n_out[(size_t)(b * 8 + h) * 64 + 4 * dg + i] = nn[i]; }
    __syncthreads();
    { const int t = w; float o0 = 0.f, o1 = 0.f, dn = 0.f;
#pragma unroll
        for (int g = 0; g < 16; ++g) { const f32x2 x = LDSV(f32x2, RED + ((g * 8 + t) * 128 + 2 * lane) * 4); o0 += x.x; o1 += x.y; dn += LDSV(float, DENR + (g * 8 + t) * 4); }
        const float inv = 1.0f / fmaxf(fabsf(dn), LDSV(f32x4, SCL + t * 16)[2]); o0 *= inv; o1 *= inv;
        const float rstd = rsqrtf(wave_sum(o0 * o0 + o1 * o1) * (1.0f / 128.0f) + 1e-6f);
        const size_t g = (rowb + t) * 1024 + h * 128 + 2 * lane; const unsigned gg = *(const unsigned*)(Om + g);
        *(unsigned*)(Hb + g) = pk2(o0 * rstd * onw[h * 128 + 2 * lane] * bflo(gg), o1 * rstd * onw[h * 128 + 2 * lane + 1] * bfhi(gg)); }
}

__device__ __forceinline__ void small_unit_resid(LAS unsigned char* lds, const bf16* A, const bf16* Bt, int K, int R0, int C0, const float* basep, float* X, bf16* Xb, float* ssq) {
    const int tid = threadIdx.x, lane = tid & 63, w = __builtin_amdgcn_readfirstlane(tid >> 6), fr = lane & 15, fq = lane >> 4;
    const int kw = K >> 3;
    const bf16* ap = A + (size_t)(R0 + fr) * K + w * kw + 8 * fq;
    const bf16* bp = Bt + (size_t)(C0 + fr) * K + w * kw + 8 * fq;
    const size_t rs16 = (size_t)16 * K;
    f32x4 acc[4][4];
#pragma unroll
    for (int i = 0; i < 4; ++i)
#pragma unroll
        for (int j = 0; j < 4; ++j) acc[i][j] = (f32x4){0.f, 0.f, 0.f, 0.f};
    bf16x8 a0[4], b0[4], a1[4], b1[4];
#pragma unroll
    for (int i = 0; i < 4; ++i) { a0[i] = *(const bf16x8*)(ap + i * rs16); b0[i] = *(const bf16x8*)(bp + i * rs16); }
    for (int ks = 0; ks < kw; ks += 64) {
#pragma unroll
        for (int i = 0; i < 4; ++i) { a1[i] = *(const bf16x8*)(ap + i * rs16 + ks + 32); b1[i] = *(const bf16x8*)(bp + i * rs16 + ks + 32); }
#pragma unroll
        for (int i = 0; i < 4; ++i)
#pragma unroll
            for (int j = 0; j < 4; ++j) acc[i][j] = MFMA16(b0[j], a0[i], acc[i][j]);
        if (ks + 64 < kw) {
#pragma unroll
            for (int i = 0; i < 4; ++i) { a0[i] = *(const bf16x8*)(ap + i * rs16 + ks + 64); b0[i] = *(const bf16x8*)(bp + i * rs16 + ks + 64); }
        }
#pragma unroll
        for (int i = 0; i < 4; ++i)
#pragma unroll
            for (int j = 0; j < 4; ++j) acc[i][j] = MFMA16(b1[j], a1[i], acc[i][j]);
    }
    __syncthreads();
#pragma unroll
    for (int i = 0; i < 4; ++i)
#pragma unroll
        for (int j = 0; j < 4; ++j) LDSV(f32x4, w * 16384 + (16 * i + fr) * 256 + (((4 * j + fq) ^ fr) << 4)) = acc[i][j];
    __syncthreads();
    { const int row = tid >> 3, cg = tid & 7; f32x4 x0 = (f32x4){0.f, 0.f, 0.f, 0.f}, x1 = x0;
#pragma unroll
        for (int g = 0; g < 8; ++g) { x0 += LDSV(f32x4, g * 16384 + row * 256 + (((2 * cg) ^ (row & 15)) << 4)); x1 += LDSV(f32x4, g * 16384 + row * 256 + (((2 * cg + 1) ^ (row & 15)) << 4)); }
        const size_t off = (size_t)(R0 + row) * 1024 + C0 + 8 * cg;
        const f32x4 v0 = *(const f32x4*)(basep + off) + x0, v1 = *(const f32x4*)(basep + off + 4) + x1;
        *(f32x4*)(X + off) = v0; *(f32x4*)(X + off + 4) = v1;
        *(v4u*)(Xb + off) = (v4u){pk2(v0[0], v0[1]), pk2(v0[2], v0[3]), pk2(v1[0], v1[1]), pk2(v1[2], v1[3])};
        float sq = (v0[0] * v0[0] + v0[1] * v0[1]) + (v0[2] * v0[2] + v0[3] * v0[3]) + (v1[0] * v1[0] + v1[1] * v1[1]) + (v1[2] * v1[2] + v1[3] * v1[3]);
        sq += __shfl_xor(sq, 1); sq += __shfl_xor(sq, 2); sq += __shfl_xor(sq, 4);
        if (cg == 0) atomicAdd(ssq + R0 + row, sq); }
}
struct Args { const float* in[19]; float* out; unsigned char* ws; int ph_lo, ph_hi, li, pad; };
#ifndef PG8_SP2
#define PG8_SP2 true
#endif
#ifndef PG8_ALIGN
#define PG8_ALIGN true
#endif
__global__ void __launch_bounds__(NWAVES * 64, 2) trunk_fwd(Args args) {
    extern __shared__ __attribute__((aligned(16))) unsigned char lds_raw[];
    LAS unsigned char* lds = (LAS unsigned char*)lds_raw;
    volatile LAS unsigned* MISC = (volatile LAS unsigned*)(lds + MISC_OFF);
    const int tid = threadIdx.x, lane = tid & 63, wave = __builtin_amdgcn_readfirstlane(tid >> 6);
    const int G = gridDim.x, bx = blockIdx.x;
    unsigned char* ws = args.ws; float* out = args.out;
    gu32* ctl = (gu32*)(ws + WS_CTL);
    float* SS = (float*)(ws + WS_SS); float* LB = (float*)(ws + WS_LB);
    bf16* Win0 = (bf16*)(ws + WS_WIN0); bf16* Wout0 = (bf16*)(ws + WS_WOUT0); bf16* Wup0 = (bf16*)(ws + WS_WUP0); bf16* Wdn0 = (bf16*)(ws + WS_WDN0);
    bf16* Win1 = (bf16*)(ws + WS_WIN1); bf16* Wout1 = (bf16*)(ws + WS_WOUT1); bf16* Wup1 = (bf16*)(ws + WS_WUP1); bf16* Wdn1 = (bf16*)(ws + WS_WDN1);
    bf16* Xb = (bf16*)(ws + WS_XB); bf16* U = (bf16*)(ws + WS_ACT);
    bf16* Qb = (bf16*)(ws + WS_Q); bf16* LFb = (bf16*)(ws + WS_LF); bf16* Vb = (bf16*)(ws + WS_V); bf16* Gb = (bf16*)(ws + WS_G);
    bf16* Qm = (bf16*)(ws + WS_QM); bf16* Km = (bf16*)(ws + WS_KM); bf16* Vm = (bf16*)(ws + WS_VM); bf16* Om = (bf16*)(ws + WS_OM); float* GTg = (float*)(ws + WS_GT);
    float* X = out + OUT_Y;
    for (int u = tid; u < (LDS_BYTES - LDSCTL_OFF) / 4; u += NWAVES * 64) ((LAS unsigned*)(lds + LDSCTL_OFF))[u] = 0u;
    __syncthreads();
    XcdBarrier bar; bar.bar = (unsigned*)(ctl + CW_BAR); bar.x = 0; bar.st = nullptr;
    if (MK_N_LAUNCHES == 1) bar = xcd_barrier_post((unsigned*)(ctl + CW_BAR), MISC + 8);
    const int lo = args.ph_lo, hi = args.ph_hi;
#define IN(k) (lo <= (k) && (k) < hi)
#define SEAM(k) do { if (IN(k) && IN((k) + 1)) xcd_barrier(bar); } while (0)

    if (IN(0)) {
        LAS float* scr = (LAS float*)(lds + wave * 16384);
        const int gw = bx * NWAVES + wave, NGW = G * NWAVES;
        constexpr int I0 = 16 * 128, I1 = 16 * 32, I2 = 16 * 128, I3 = 64 * 32, I4 = 16 * 97, I5 = I1, I6 = I2, I7 = I3, NITEMS = I0 + I1 + I2 + I3 + I4 + I5 + I6 + I7;
        for (int it = gw; it < NITEMS; it += NGW) {
            int r = it;
            if (r < I0) { p0_transpose_item(args.in[8], 1024, 4096, args.in[6], Win0, scr, r, lane); continue; } r -= I0;
            if (r < I1) { p0_transpose_item(args.in[11], 1024, 1024, nullptr, Wout0, scr, r, lane); continue; } r -= I1;
            if (r < I2) { p0_transpose_item(args.in[16], 1024, 4096, args.in[7], Wup0, scr, r, lane); continue; } r -= I2;
            if (r < I3) { p0_transpose_item(args.in[17], 4096, 1024, nullptr, Wdn0, scr, r, lane); continue; } r -= I3;
            if (r < I4) { p0_transpose_item(args.in[12], 1024, NIN1, args.in[6] + 1024, Win1, scr, r, lane); continue; } r -= I4;
            if (r < I5) { p0_transpose_item(args.in[15], 1024, 1024, nullptr, Wout1, scr, r, lane); continue; } r -= I5;
            if (r < I6) { p0_transpose_item(args.in[16] + (size_t)1024 * 4096, 1024, 4096, args.in[7] + 1024, Wup1, scr, r, lane); continue; } r -= I6;
            p0_transpose_item(args.in[17] + (size_t)4096 * 1024, 4096, 1024, nullptr, Wdn1, scr, r, lane);
        }
        for (int m = gw; m < MROWS; m += NGW) {
            const float* xr = m < MP ? args.in[0] + (size_t)m * 1024 : args.in[1] + (size_t)(m - MP) * 1024;
            f32x4 v[4]; float s = 0.f;
#pragma unroll
            for (int j = 0; j < 4; ++j) { v[j] = *((const f32x4*)xr + lane + 64 * j); s += (v[j][0] * v[j][0] + v[j][1] * v[j][1]) + (v[j][2] * v[j][2] + v[j][3] * v[j][3]); }
            s = wave_sum(s); if (lane == 0) SS[m] = s;
#pragma unroll
            for (int j = 0; j < 4; ++j) *((v2u*)(Xb + (size_t)m * 1024) + lane + 64 * j) = (v2u){pk2(v[j][0], v[j][1]), pk2(v[j][2], v[j][3])};
        }
        if (bx == 0) for (int d = tid; d < 1024; d += NWAVES * 64) { const float l0 = args.in[9][d], l1 = args.in[9][1024 + d], l2 = args.in[9][2048 + d]; const float mx = fmaxf(l0, fmaxf(l1, l2));
            const float e0 = expf(l0 - mx), e1 = expf(l1 - mx), e2 = expf(l2 - mx); LB[d] = e0 / (e0 + e1 + e2); }
    }
    SEAM(0);
    if (IN(1)) { pg8::Gemm g{Xb, Win0, MP, 4096, 1024}; pg8::StaticOrder S; S.init(MP, 4096, G, bx);
        pg8::EpiHgrnIn E{Qb, LFb, Vb, Gb, SS, LB};
        pg8::gemm_phase_x<pg8::EpiHgrnIn, pg8::StaticOrder>(lds, g, MP, S, E); }
    SEAM(1);
    if (IN(2)) {
        float* Escr = (float*)(ws + WS_XB); float* Dscr = (float*)(ws + WS_XB + 16 * MiB);
        for (int it = bx; it < 192; it += G) hgrn_seg_item<true>(lds, (it / 3) >> 3, (it / 3) & 7, it % 3, Qb, LFb, Vb, Gb, Qb, args.in[10], Escr, Dscr, out + OUT_SP);
        for (int it = bx; it < 768; it += G) hgrn_sample_item(lds, it >> 3, it & 7, Qb, LFb, Vb, Gb, Qb, args.in[10], args.in[2], out + OUT_SS);
        if (G == 256) { if (bx >= 192) for (int it = 768 + (bx - 192) * 4; it < 772 + (bx - 192) * 4; ++it) hgrn_sample_item(lds, it >> 3, it & 7, Qb, LFb, Vb, Gb, Qb, args.in[10], args.in[2], out + OUT_SS); }
        else for (int it = 768 + bx; it < 1024; it += G) hgrn_sample_item(lds, it >> 3, it & 7, Qb, LFb, Vb, Gb, Qb, args.in[10], args.in[2], out + OUT_SS);
    }
    SEAM(2);
    if (IN(3)) {
        float* Escr = (float*)(ws + WS_XB); float* Dscr = (float*)(ws + WS_XB + 16 * MiB);
        for (int it = bx; it < 256; it += G) hgrn_seg_item<false>(lds, it >> 5, (it >> 2) & 7, it & 3, Qb, LFb, Vb, Gb, Qb, args.in[10], Escr, Dscr, out + OUT_SP);
    }
    SEAM(3);
    if (IN(4)) { pg8::Gemm g{Qb, Wout0, MP, 1024, 1024}; pg8::StaticOrder S; S.init(MP, 1024, G, bx);
        pg8::EpiResid<true> E{args.in[0], args.in[1], Xb, SS + MROWS};
        pg8::gemm_phase_x<pg8::EpiResid<true>, pg8::StaticOrder>(lds, g, MP, S, E); }
    SEAM(4);
    if (IN(5)) { pg8::Gemm g{Xb, Wup0, MP, 4096, 1024}; pg8::StaticOrder S; S.init(MP, 4096, G, bx);
        pg8::EpiUp E{U, SS + MROWS};
        pg8::gemm_phase_x<pg8::EpiUp, pg8::StaticOrder>(lds, g, MP, S, E); }
    SEAM(5);
    if (IN(6)) { pg8::Gemm g{U, Wdn0, MP, 1024, 4096}; pg8::StaticOrder S; S.init(MP, 1024, G, bx);
        pg8::EpiResid<false> E{nullptr, nullptr, Xb, SS + 2 * MROWS};
        pg8::gemm_phase_x<pg8::EpiResid<false>, pg8::StaticOrder>(lds, g, MP, S, E); }
    SEAM(6);
    if (IN(7)) { pg8::Gemm g{Xb, Win1, MP, NIN1P, 1024}; pg8::StaticOrder S; S.init(MP, NIN1P, G, bx);
        pg8::EpiMlstmIn E{Qm, Km, Vm, Om, GTg, SS + 2 * MROWS, args.in[13]};
        pg8::gemm_phase_x<pg8::EpiMlstmIn, pg8::StaticOrder>(lds, g, MP, S, E); }
    SEAM(7);
    if (IN(8)) {
        float* Escr = (float*)(ws + WS_GT + 2 * MiB); float* Mscr = (float*)(ws + WS_GT + 14 * MiB);
        for (int it = bx; it < 192; it += G) mlstm_seg_item<true>(lds, (it / 3) >> 3, (it / 3) & 7, it % 3, Qm, Km, Vm, Om, GTg, Vm, args.in[14], Escr, Mscr, out + OUT_CP, out + OUT_NP, out + OUT_MP);
        for (int it = bx; it < 768; it += G) mlstm_sample_item(lds, it >> 3, it & 7, Qm, Km, Vm, Om, GTg, Vm, args.in[14], args.in[3], args.in[4], args.in[5], out + OUT_CS, out + OUT_NS, out + OUT_MS);
        if (G == 256) { if (bx >= 192) for (int it = 768 + (bx - 192) * 4; it < 772 + (bx - 192) * 4; ++it) mlstm_sample_item(lds, it >> 3, it & 7, Qm, Km, Vm, Om, GTg, Vm, args.in[14], args.in[3], args.in[4], args.in[5], out + OUT_CS, out + OUT_NS, out + OUT_MS); }
        else for (int it = 768 + bx; it < 1024; it += G) mlstm_sample_item(lds, it >> 3, it & 7, Qm, Km, Vm, Om, GTg, Vm, args.in[14], args.in[3], args.in[4], args.in[5], out + OUT_CS, out + OUT_NS, out + OUT_MS);
    }
    SEAM(8);
    if (IN(9)) {
        float* Escr = (float*)(ws + WS_GT + 2 * MiB); float* Mscr = (float*)(ws + WS_GT + 14 * MiB);
        for (int it = bx; it < 256; it += G) mlstm_seg_item<false>(lds, it >> 5, (it >> 2) & 7, it & 3, Qm, Km, Vm, Om, GTg, Vm, args.in[14], Escr, Mscr, out + OUT_CP, out + OUT_NP, out + OUT_MP);
    }
    SEAM(9);
    if (IN(10)) { pg8::Gemm g{Vm, Wout1, MP, 1024, 1024}; pg8::StaticOrder S; S.init(MP, 1024, G, bx);
        pg8::EpiResid<false> E{nullptr, nullptr, Xb, SS + 3 * MROWS};
        pg8::gemm_phase_x<pg8::EpiResid<false>, pg8::StaticOrder>(lds, g, MP, S, E); }
    SEAM(10);
    if (IN(11)) { pg8::Gemm g{Xb, Wup1, MP, 4096, 1024}; pg8::StaticOrder S; S.init(MP, 4096, G, bx);
        pg8::EpiUp E{U, SS + 3 * MROWS};
        pg8::gemm_phase_x<pg8::EpiUp, pg8::StaticOrder>(lds, g, MP, S, E); }
    SEAM(11);
    if (IN(12)) { pg8::Gemm g{U, Wdn1, MP, 1024, 4096}; pg8::StaticOrder S; S.init(MP, 1024, G, bx);
        pg8::EpiResid<false> E{nullptr, nullptr, Xb, SS + 4 * MROWS};
        pg8::gemm_phase_x<pg8::EpiResid<false>, pg8::StaticOrder>(lds, g, MP, S, E); }
    SEAM(12);
    if (IN(13)) {
        const int gw = bx * NWAVES + wave, NGW = G * NWAVES; const float* wf = args.in[18];
        f32x4 wv[4];
#pragma unroll
        for (int j = 0; j < 4; ++j) wv[j] = *((const f32x4*)wf + lane + 64 * j);
        for (int m = gw; m < MROWS; m += NGW) { const float rs = rsqrtf(SS[4 * MROWS + m] * (1.0f / 1024.0f) + 1e-6f); f32x4* yr = (f32x4*)(X + (size_t)m * 1024); const v2u* xr = (const v2u*)(Xb + (size_t)m * 1024);
#pragma unroll
            for (int j = 0; j < 4; ++j) { const v2u x = xr[lane + 64 * j]; yr[lane + 64 * j] = (f32x4){bflo(x.x), bfhi(x.x), bflo(x.y), bfhi(x.y)} * rs * wv[j]; } }
    }
#undef IN
#undef SEAM
}

extern "C" void kernel_launch(void* const* d_in, const int* in_sizes, int n_in, void* d_out, int out_size, void* d_ws, size_t ws_size, hipStream_t stream) {
    static int grid = 0;
    if (grid == 0) {
        if (n_in != 19 || out_size != (int)OUT_END || ws_size < WS_END) { fprintf(stderr, "kernel_launch: unexpected shapes: n_in %d out %d ws %zu\n", n_in, out_size, ws_size); grid = -1; return; }
        int dev = 0, cus = 0, per_cu = 0;
        if (hipGetDevice(&dev) != hipSuccess || hipDeviceGetAttribute(&cus, hipDeviceAttributeMultiprocessorCount, dev) != hipSuccess) { grid = -1; return; }
        if (hipFuncSetAttribute((const void*)trunk_fwd, hipFuncAttributeMaxDynamicSharedMemorySize, LDS_BYTES) != hipSuccess) { fprintf(stderr, "kernel_launch: hipFuncSetAttribute failed\n"); grid = -1; return; }
        if (hipOccupancyMaxActiveBlocksPerMultiprocessor(&per_cu, (const void*)trunk_fwd, NWAVES * 64, LDS_BYTES) != hipSuccess || per_cu < 1) { fprintf(stderr, "kernel_launch: occupancy query says %d blocks per CU\n", per_cu); grid = -1; return; }
        (void)hipGetLastError();
        grid = cus;
    }
    if (grid < 0) return;
    (void)hipMemsetAsync((char*)d_ws + WS_CTL, 0, CTL_ZERO_BYTES, stream);
    Args a{};
    for (int i = 0; i < 19; ++i) a.in[i] = (const float*)d_in[i];
    a.out = (float*)d_out; a.ws = (unsigned char*)d_ws;
#if MK_N_LAUNCHES == 1
    a.ph_lo = 0; a.ph_hi = N_PHASES; a.li = 0;
    hipLaunchKernelGGL(trunk_fwd, dim3(grid), dim3(NWAVES * 64), LDS_BYTES, stream, a);
#else
    for (int li = 0; li < N_PHASES; ++li) { a.ph_lo = li; a.ph_hi = li + 1; a.li = li; hipLaunchKernelGGL(trunk_fwd, dim3(grid), dim3(NWAVES * 64), LDS_BYTES, stream, a); }
#endif
}
```

```cpp
#include <hip/hip_runtime.h>
#include <cstdio>
#include <cstdint>
#include <cmath>
namespace pg8 {
#define PG8_LAS __attribute__((address_space(3)))
typedef unsigned short bf16_t;
typedef short bf16x8 __attribute__((ext_vector_type(8)));
typedef float f32x4 __attribute__((ext_vector_type(4)));
typedef unsigned u32x4 __attribute__((ext_vector_type(4)));
constexpr int BM = 256, BK = 64, HALF = 128, HTB = HALF * BK * 2  , STAGE_BYTES = 8 * HTB, NXCD = 8, WGM = 8;

__host__ __device__ __forceinline__ int lds_byte(int r, int c) { const int st = (r >> 4) * 2 + (c >> 5), rr = r & 15, cc = c & 31, ob = rr * 64 + cc * 2; return st * 1024 + (ob ^ (((ob >> 9) & 1) << 5)); }
__host__ __device__ __forceinline__ void stage_rc(int b, int& R, int& C) { const int st = b / 1024, sb = b % 1024, swz = sb ^ (((sb >> 9) & 1) << 5); R = (st >> 1) * 16 + swz / 64; C = (st & 1) * 32 + (swz % 64) / 2; }
__host__ __device__ __forceinline__ int perm32(int rho) { const int n = rho >> 4, i = rho & 15; return 8 * (i >> 2) + 4 * n + (i & 3); }

struct Unit { int pm, pn; };
struct Gemm { const bf16_t* A; const bf16_t* Bt; int M, N, K; };

struct StaticOrder {
    int nM, nN, nwg, G, c;
    __host__ __device__ void init(int M, int N, int G_, int c_) { nM = M / BM; nN = N / BM; nwg = nM * nN; G = G_; c = c_; }
    __host__ __device__ bool next(int i, Unit& u) const {
        const long L = (long)i * G + c; if (L >= nwg) return false;
        int wgid = (int)L; { const int q = nwg / NXCD, r = nwg % NXCD, xcd = wgid % NXCD, off = wgid / NXCD; wgid = (xcd < r ? xcd * (q + 1) : r * (q + 1) + (xcd - r) * q) + off; }
        const int nig = WGM * nN, gid = wgid / nig, fm = gid * WGM, gsz = (nM - fm) < WGM ? (nM - fm) : WGM;
        u.pm = fm + ((wgid % nig) % gsz); u.pn = (wgid % nig) / gsz; return true;
    }
    __device__ __forceinline__ void a_ready(const Unit&) const {}
    __device__ __forceinline__ void done(const Unit&) const {}
};

typedef unsigned u32x2 __attribute__((ext_vector_type(2)));
__device__ __forceinline__ unsigned f2bf_(float f) { unsigned u = __builtin_bit_cast(unsigned, f); return (u + 0x7fffu + ((u >> 16) & 1u)) >> 16; }
typedef float f32x2c_ __attribute__((ext_vector_type(2))); typedef __bf16 bf16x2c_ __attribute__((ext_vector_type(2)));
__device__ __forceinline__ unsigned pkbf(float lo, float hi) { f32x2c_ v = {lo, hi}; bf16x2c_ b = __builtin_convertvector(v, bf16x2c_); return __builtin_bit_cast(unsigned, b); }
__device__ __forceinline__ unsigned pkh(float lo, float hi) { const _Float16 a = (_Float16)lo, b = (_Float16)hi; return (unsigned)__builtin_bit_cast(unsigned short, a) | ((unsigned)__builtin_bit_cast(unsigned short, b) << 16); }
__device__ __forceinline__ float sigm(float x) { return __builtin_amdgcn_rcpf(1.0f + __expf(-x)); }
constexpr float NORM_EPS = 1e-6f;
constexpr int XROW0 = 16384;

struct EpiHgrnIn {
    static constexpr bool PERM = true, AFTER_DRAIN = false;
    bf16_t* Q; bf16_t* LF; bf16_t* V; bf16_t* G; const float* ss; const float* lb;
    template <int GRP> __device__ __forceinline__ void run(const f32x4 (&acc)[2][2][4][2], const Unit& u, int wr, int wc, int fr, int fq) const {
        const int row0 = u.pm * BM + wr * 64 + fr, gc0 = (u.pn & 3) * BM + wc * 32 + 8 * fq;
        bf16_t* dst = GRP == 0 ? Q : GRP == 1 ? LF : GRP == 2 ? V : G;
        f32x4 lbv[2][2];
        if (GRP == 1) {
#pragma unroll
            for (int bj = 0; bj < 2; ++bj)
#pragma unroll
                for (int n = 0; n < 2; ++n) lbv[bj][n] = *(const f32x4*)(lb + gc0 + bj * HALF + 4 * n);
        }
#pragma unroll
        for (int ai = 0; ai < 2; ++ai)
#pragma unroll
            for (int m = 0; m < 4; ++m) { const int row = row0 + ai * HALF + m * 16; const float rs = rsqrtf(ss[row] * (1.0f / 1024.0f) + NORM_EPS);
                bf16_t* rowp = dst + (size_t)row * 1024 + gc0;
#pragma unroll
                for (int bj = 0; bj < 2; ++bj) { float x[8];
#pragma unroll
                    for (int n = 0; n < 2; ++n)
#pragma unroll
                        for (int j = 0; j < 4; ++j) x[4 * n + j] = acc[ai][bj][m][n][j] * rs;
                    u32x4 w;
                    if (GRP == 0 || GRP == 3) {
#pragma unroll
                        for (int j = 0; j < 8; ++j) x[j] = x[j] * sigm(x[j]);
                    }
                    if (GRP == 1) {
#pragma unroll
                        for (int j = 0; j < 8; ++j) { const float l = lbv[bj][j >> 2][j & 3]; x[j] = __logf(l + (1.0f - l) * sigm(x[j])); }
                        w.x = pkh(x[0], x[1]); w.y = pkh(x[2], x[3]); w.z = pkh(x[4], x[5]); w.w = pkh(x[6], x[7]);
                    } else { w.x = pkbf(x[0], x[1]); w.y = pkbf(x[2], x[3]); w.z = pkbf(x[4], x[5]); w.w = pkbf(x[6], x[7]); }
                    *(u32x4*)(rowp + bj * HALF) = w; } }
    }
    __device__ __forceinline__ void operator()(const f32x4 (&acc)[2][2][4][2], const Unit& u, int wr, int wc, int fr, int fq) const {
        const int grp = u.pn >> 2;
        if (grp == 0) run<0>(acc, u, wr, wc, fr, fq); else if (grp == 1) run<1>(acc, u, wr, wc, fr, fq); else if (grp == 2) run<2>(acc, u, wr, wc, fr, fq); else run<3>(acc, u, wr, wc, fr, fq);
    }
    __device__ __forceinline__ void extra(const f32x4 (&accE)[2], const Unit& u, int wr, int wc, int fr, int fq) const {
        const int grp = u.pn >> 2, row = XROW0 + 16 * u.pm + fr, gc0 = (u.pn & 3) * BM + wr * HALF + wc * 32 + 8 * fq;
        const float rs = rsqrtf(ss[row] * (1.0f / 1024.0f) + NORM_EPS);
        float x[8];
#pragma unroll
        for (int j = 0; j < 8; ++j) x[j] = accE[j >> 2][j & 3] * rs;
        bf16_t* dst = grp == 0 ? Q : grp == 1 ? LF : grp == 2 ? V : G;
        u32x4 w;
        if (grp == 0 || grp == 3) {
#pragma unroll
            for (int j = 0; j < 8; ++j) x[j] = x[j] * sigm(x[j]);
        }
        if (grp == 1) {
#pragma unroll
            for (int j = 0; j < 8; ++j) { const float l = lb[gc0 + j]; x[j] = __logf(l + (1.0f - l) * sigm(x[j])); }
            w.x = pkh(x[0], x[1]); w.y = pkh(x[2], x[3]); w.z = pkh(x[4], x[5]); w.w = pkh(x[6], x[7]);
        } else { w.x = pkbf(x[0], x[1]); w.y = pkbf(x[2], x[3]); w.z = pkbf(x[4], x[5]); w.w = pkbf(x[6], x[7]); }
        *(u32x4*)(dst + (size_t)row * 1024 + gc0) = w;
    }
};

struct EpiMlstmIn {
    static constexpr bool PERM = true, AFTER_DRAIN = false;
    bf16_t* Qm; bf16_t* Km; bf16_t* Vm; bf16_t* Om; float* GT; const float* ss; const float* gb;
    template <int GRP> __device__ __forceinline__ void run(const f32x4 (&acc)[2][2][4][2], const Unit& u, int wr, int wc, int fr, int fq) const {
        const int row0 = u.pm * BM + wr * 64 + fr;
        const int ld = GRP < 2 ? 512 : 1024;
        const int tb = GRP == 0 ? 0 : GRP == 1 ? 2 : GRP == 2 ? 4 : 8;
        const int gc0 = (u.pn - tb) * BM + wc * 32 + 8 * fq;
        bf16_t* dst = GRP == 0 ? Qm : GRP == 1 ? Km : GRP == 2 ? Vm : Om;
#pragma unroll
        for (int ai = 0; ai < 2; ++ai)
#pragma unroll
            for (int m = 0; m < 4; ++m) { const int row = row0 + ai * HALF + m * 16; const float rs = rsqrtf(ss[row] * (1.0f / 1024.0f) + NORM_EPS);
                bf16_t* rowp = dst + (size_t)row * ld + gc0;
#pragma unroll
                for (int bj = 0; bj < 2; ++bj) { float x[8];
#pragma unroll
                    for (int n = 0; n < 2; ++n)
#pragma unroll
                        for (int j = 0; j < 4; ++j) x[4 * n + j] = acc[ai][bj][m][n][j] * rs;
                    if (GRP == 0) {
#pragma unroll
                        for (int j = 0; j < 8; ++j) x[j] *= 0.125f;
                    }
                    if (GRP == 3) {
#pragma unroll
                        for (int j = 0; j < 8; ++j) x[j] = sigm(x[j]);
                    }
                    u32x4 w; w.x = pkbf(x[0], x[1]); w.y = pkbf(x[2], x[3]); w.z = pkbf(x[4], x[5]); w.w = pkbf(x[6], x[7]);
                    *(u32x4*)(rowp + bj * HALF) = w; } }
    }
    __device__ __forceinline__ void gates(const f32x4 (&acc)[2][2][4][2], const Unit& u, int wr, int wc, int fr, int fq) const {
        if (wc != 0 || fq >= 2) return;
        const int row0 = u.pm * BM + wr * 64 + fr;
#pragma unroll
        for (int ai = 0; ai < 2; ++ai)
#pragma unroll
            for (int m = 0; m < 4; ++m) { const int row = row0 + ai * HALF + m * 16; const float rs = rsqrtf(ss[row] * (1.0f / 1024.0f) + NORM_EPS);
                float x[8];
#pragma unroll
                for (int n = 0; n < 2; ++n)
#pragma unroll
                    for (int j = 0; j < 4; ++j) x[4 * n + j] = acc[ai][0][m][n][j] * rs;
#pragma unroll
                for (int j = 0; j < 8; ++j) { const float y2 = (x[j] + gb[8 * fq + j]) * (2.0f / 15.0f); const float z = 15.0f - 30.0f * __builtin_amdgcn_rcpf(__expf(y2) + 1.0f); x[j] = fq == 0 ? z : -__logf(1.0f + __expf(-z)); }
                float* o = GT + (size_t)row * 16 + 8 * fq;
                *(f32x4*)o = (f32x4){x[0], x[1], x[2], x[3]}; *(f32x4*)(o + 4) = (f32x4){x[4], x[5], x[6], x[7]}; }
    }
    __device__ __forceinline__ void operator()(const f32x4 (&acc)[2][2][4][2], const Unit& u, int wr, int wc, int fr, int fq) const {
        const int pn = u.pn;
        if (pn < 2) run<0>(acc, u, wr, wc, fr, fq); else if (pn < 4) run<1>(acc, u, wr, wc, fr, fq); else if (pn < 8) run<2>(acc, u, wr, wc, fr, fq); else if (pn < 12) run<3>(acc, u, wr, wc, fr, fq); else gates(acc, u, wr, wc, fr, fq);
    }
    __device__ __forceinline__ void extra(const f32x4 (&accE)[2], const Unit& u, int wr, int wc, int fr, int fq) const {
        const int pn = u.pn, row = XROW0 + 16 * u.pm + fr;
        const float rs = rsqrtf(ss[row] * (1.0f / 1024.0f) + NORM_EPS);
        float x[8];
#pragma unroll
        for (int j = 0; j < 8; ++j) x[j] = accE[j >> 2][j & 3] * rs;
        if (pn == 12) {
            if (wr != 0 || wc != 0 || fq >= 2) return;
#pragma unroll
            for (int j = 0; j < 8; ++j) { const float y2 = (x[j] + gb[8 * fq + j]) * (2.0f / 15.0f); const float z = 15.0f - 30.0f * __builtin_amdgcn_rcpf(__expf(y2) + 1.0f); x[j] = fq == 0 ? z : -__logf(1.0f + __expf(-z)); }
            float* o = GT + (size_t)row * 16 + 8 * fq;
            *(f32x4*)o = (f32x4){x[0], x[1], x[2], x[3]}; *(f32x4*)(o + 4) = (f32x4){x[4], x[5], x[6], x[7]};
            return;
        }
        const int grp = pn < 2 ? 0 : pn < 4 ? 1 : pn < 8 ? 2 : 3, tb = grp == 0 ? 0 : grp == 1 ? 2 : grp == 2 ? 4 : 8, ld = grp < 2 ? 512 : 1024;
        const int gc0 = (pn - tb) * BM + wr * HALF + wc * 32 + 8 * fq;
        bf16_t* dst = grp == 0 ? Qm : grp == 1 ? Km : grp == 2 ? Vm : Om;
        if (grp == 0) {
#pragma unroll
            for (int j = 0; j < 8; ++j) x[j] *= 0.125f;
        }
        if (grp == 3) {
#pragma unroll
            for (int j = 0; j < 8; ++j) x[j] = sigm(x[j]);
        }
        u32x4 w; w.x = pkbf(x[0], x[1]); w.y = pkbf(x[2], x[3]); w.z = pkbf(x[4], x[5]); w.w = pkbf(x[6], x[7]);
        *(u32x4*)(dst + (size_t)row * ld + gc0) = w;
    }
};

struct EpiUp {
    static constexpr bool PERM = true, AFTER_DRAIN = false;
    bf16_t* U; const float* ss;
    __device__ __forceinline__ void operator()(const f32x4 (&acc)[2][2][4][2], const Unit& u, int wr, int wc, int fr, int fq) const {
        const int row0 = u.pm * BM + wr * 64 + fr, c0 = u.pn * BM + wc * 32 + 8 * fq;
#pragma unroll
        for (int ai = 0; ai < 2; ++ai)
#pragma unroll
            for (int m = 0; m < 4; ++m) { const int row = row0 + ai * HALF + m * 16; const float rs = rsqrtf(ss[row] * (1.0f / 1024.0f) + NORM_EPS);
                bf16_t* rowp = U + (size_t)row * 4096 + c0;
#pragma unroll
                for (int bj = 0; bj < 2; ++bj) { float x[8];
#pragma unroll
                    for (int n = 0; n < 2; ++n)
#pragma unroll
                        for (int j = 0; j < 4; ++j) { const float a = fmaxf(acc[ai][bj][m][n][j] * rs, 0.0f); x[4 * n + j] = a * a; }
                    u32x4 w; w.x = pkbf(x[0], x[1]); w.y = pkbf(x[2], x[3]); w.z = pkbf(x[4], x[5]); w.w = pkbf(x[6], x[7]);
                    *(u32x4*)(rowp + bj * HALF) = w; } }
    }
    __device__ __forceinline__ void extra(const f32x4 (&accE)[2], const Unit& u, int wr, int wc, int fr, int fq) const {
        const int row = XROW0 + 16 * u.pm + fr, c0 = u.pn * BM + wr * HALF + wc * 32 + 8 * fq;
        const float rs = rsqrtf(ss[row] * (1.0f / 1024.0f) + NORM_EPS);
        float x[8];
#pragma unroll
        for (int j = 0; j < 8; ++j) { const float a = fmaxf(accE[j >> 2][j & 3] * rs, 0.0f); x[j] = a * a; }
        u32x4 w; w.x = pkbf(x[0], x[1]); w.y = pkbf(x[2], x[3]); w.z = pkbf(x[4], x[5]); w.w = pkbf(x[6], x[7]);
        *(u32x4*)(U + (size_t)row * 4096 + c0) = w;
    }
};

struct EpiDummy {
    static constexpr bool PERM = true, AFTER_DRAIN = false;
    bf16_t* O;
    __device__ __forceinline__ void operator()(const f32x4 (&acc)[2][2][4][2], const Unit& u, int wr, int wc, int fr, int fq) const {
        const int row0 = u.pm * BM + wr * 64 + fr, c0 = u.pn * BM + wc * 32 + 8 * fq;
#pragma unroll
        for (int ai = 0; ai < 2; ++ai)
#pragma unroll
            for (int m = 0; m < 4; ++m) { bf16_t* rowp = O + (size_t)(row0 + ai * HALF + m * 16) * 1024 + c0;
#pragma unroll
                for (int bj = 0; bj < 2; ++bj) { u32x4 w; w.x = pkbf(acc[ai][bj][m][0][0], acc[ai][bj][m][0][1]); w.y = pkbf(acc[ai][bj][m][0][2], acc[ai][bj][m][0][3]); w.z = pkbf(acc[ai][bj][m][1][0], acc[ai][bj][m][1][1]); w.w = pkbf(acc[ai][bj][m][1][2], acc[ai][bj][m][1][3]);
                    *(u32x4*)(rowp + bj * HALF) = w; } }
    }
    __device__ __forceinline__ void extra(const f32x4 (&accE)[2], const Unit& u, int wr, int wc, int fr, int fq) const {
        const int row = XROW0 + 16 * u.pm + fr, c0 = u.pn * BM + wr * HALF + wc * 32 + 8 * fq;
        u32x4 w; w.x = pkbf(accE[0][0], accE[0][1]); w.y = pkbf(accE[0][2], accE[0][3]); w.z = pkbf(accE[1][0], accE[1][1]); w.w = pkbf(accE[1][2], accE[1][3]);
        *(u32x4*)(O + (size_t)row * 1024 + c0) = w;
    }
};
template <bool BASE_F32> struct EpiResid {
    static constexpr bool PERM = true, AFTER_DRAIN = false;
    const float* base0; const float* base1; bf16_t* Xb; float* ssq;
    __device__ __forceinline__ void row8(const float* brow, size_t off, const f32x4& a0, const f32x4& a1, float& s) const {
        float v[8];
        if (BASE_F32) { const f32x4 b0 = *(const f32x4*)(brow + off), b1 = *(const f32x4*)(brow + off + 4);
#pragma unroll
            for (int j = 0; j < 4; ++j) { v[j] = b0[j] + a0[j]; v[4 + j] = b1[j] + a1[j]; } }
        else { const u32x4 b = *(const u32x4*)(Xb + off);
#pragma unroll
            for (int j = 0; j < 4; ++j) { v[j] = __builtin_bit_cast(float, (j & 1) ? (b[j >> 1] & 0xffff0000u) : (b[j >> 1] << 16)) + a0[j]; v[4 + j] = __builtin_bit_cast(float, (j & 1) ? (b[2 + (j >> 1)] & 0xffff0000u) : (b[2 + (j >> 1)] << 16)) + a1[j]; } }
        u32x4 w; w.x = pkbf(v[0], v[1]); w.y = pkbf(v[2], v[3]); w.z = pkbf(v[4], v[5]); w.w = pkbf(v[6], v[7]);
        *(u32x4*)(Xb + off) = w;
#pragma unroll
        for (int j = 0; j < 8; ++j) s += v[j] * v[j];
    }
    __device__ __forceinline__ void operator()(const f32x4 (&acc)[2][2][4][2], const Unit& u, int wr, int wc, int fr, int fq) const {
        const int row0 = u.pm * BM + wr * 64 + fr, c0 = u.pn * BM + wc * 32 + 8 * fq;
#pragma unroll
        for (int ai = 0; ai < 2; ++ai)
#pragma unroll
            for (int m = 0; m < 4; ++m) { const int row = row0 + ai * HALF + m * 16; const size_t off = (size_t)row * 1024 + c0; float s = 0.f;
#pragma unroll
                for (int bj = 0; bj < 2; ++bj) row8(base0, off + bj * HALF, acc[ai][bj][m][0], acc[ai][bj][m][1], s);
                s += __shfl_xor(s, 16); s += __shfl_xor(s, 32);
                if (fq == 0) atomicAdd(ssq + row, s); }
    }
    __device__ __forceinline__ void extra(const f32x4 (&accE)[2], const Unit& u, int wr, int wc, int fr, int fq) const {
        const int row = XROW0 + 16 * u.pm + fr, c0 = u.pn * BM + wr * HALF + wc * 32 + 8 * fq;
        float s = 0.f; row8(base1 - (size_t)XROW0 * 1024, (size_t)row * 1024 + c0, accE[0], accE[1], s);
        s += __shfl_xor(s, 16); s += __shfl_xor(s, 32);
        if (fq == 0) atomicAdd(ssq + row, s);
    }
};
template <class Epi, class Sched, bool ALIGN_EPI = false, bool SP2 = false>
__device__ __forceinline__ void gemm_phase(PG8_LAS unsigned char* lds, const Gemm g, const Sched& S, const Epi& E) {
    const int tid = threadIdx.x, wid = __builtin_amdgcn_readfirstlane(tid >> 6), lane = tid & 63, wr = wid >> 2, wc = wid & 3, fr = lane & 15, fq = lane >> 4;
    const int K = g.K, nt = K / BK;
    unsigned voffA[2], voffB[2];
#pragma unroll
    for (int i = 0; i < 2; ++i) { int R, C; stage_rc(tid * 16 + i * 8192, R, C); const int Rb = Epi::PERM ? ((R & ~31) + perm32(R & 31)) : R;
        voffA[i] = (unsigned)(R * K + C) * 2u; voffB[i] = (unsigned)(Rb * K + C) * 2u; }
    const size_t kstep = (size_t)(BK * 2);
    const size_t hstep = (size_t)HALF * K * 2;
    const size_t tstep = 2 * hstep;
    const unsigned ldsw = (unsigned)wid * 1024u;
    const int aoff = lds_byte(wr * 64 + fr, fq * 8), boff = lds_byte(wc * 32 + fr, fq * 8);
#define PG8_SA(b, h) (((b) * 2 + (h)) * HTB)
#define PG8_SB(b, h) ((4 + (b) * 2 + (h)) * HTB)
#define PG8_STAGE(bufoff, gbase, voff) do { _Pragma("unroll") for (int _i = 0; _i < 2; ++_i) \
        __builtin_amdgcn_global_load_lds((const unsigned*)((const char*)(gbase) + (voff)[_i]), (PG8_LAS unsigned*)(lds + (bufoff) + ldsw + _i * 8192), 16, 0, 0); } while (0)
#define PG8_LDA(dst, b, h) do { _Pragma("unroll") for (int m = 0; m < 4; ++m) _Pragma("unroll") for (int k = 0; k < 2; ++k) dst[m][k] = *(const PG8_LAS bf16x8*)(lds + PG8_SA(b, h) + aoff + m * 2048 + k * 1024); } while (0)
#define PG8_LDB(dst, b, h) do { _Pragma("unroll") for (int n = 0; n < 2; ++n) _Pragma("unroll") for (int k = 0; k < 2; ++k) dst[n][k] = *(const PG8_LAS bf16x8*)(lds + PG8_SB(b, h) + boff + n * 2048 + k * 1024); } while (0)
#define PG8_MMA(ai, bj, At, Bt) do { __builtin_amdgcn_s_setprio(1); _Pragma("unroll") for (int m = 0; m < 4; ++m) _Pragma("unroll") for (int n = 0; n < 2; ++n) _Pragma("unroll") for (int k = 0; k < 2; ++k) \
        acc[ai][bj][m][n] = __builtin_amdgcn_mfma_f32_16x16x32_bf16(Bt[n][k], At[m][k], acc[ai][bj][m][n], 0, 0, 0); __builtin_amdgcn_s_setprio(0); } while (0)
#define PG8_WAIT_V(n) asm volatile("s_waitcnt vmcnt(" #n ")" ::: "memory")
#define PG8_WAIT_L(n) asm volatile("s_waitcnt lgkmcnt(" #n ")" ::: "memory")
#define PG8_BAR __builtin_amdgcn_s_barrier()
#define PG8_SCHED __builtin_amdgcn_sched_barrier(0)
    Unit cur, nxt; int ui = 0;
    if (!S.next(0, cur)) return;
    f32x4 acc[2][2][4][2];
#pragma unroll
    for (int a = 0; a < 2; ++a)
#pragma unroll
        for (int b = 0; b < 2; ++b)
#pragma unroll
            for (int m = 0; m < 4; ++m)
#pragma unroll
                for (int n = 0; n < 2; ++n) acc[a][b][m][n] = (f32x4){0.f, 0.f, 0.f, 0.f};
    bf16x8 At[4][2], B0[2][2], B1[2][2];
    const char* cA = (const char*)g.A + (size_t)cur.pm * tstep; const char* cB = (const char*)g.Bt + (size_t)cur.pn * tstep;
    S.a_ready(cur);
    if constexpr (SP2) {
        PG8_STAGE(PG8_SB(0, 0), cB, voffB); PG8_STAGE(PG8_SB(0, 1), cB + hstep, voffB); PG8_STAGE(PG8_SA(0, 0), cA, voffA); PG8_STAGE(PG8_SA(0, 1), cA + hstep, voffA);
        if (wr == 1) PG8_BAR;
        PG8_WAIT_V(2); PG8_BAR;
        PG8_STAGE(PG8_SB(1, 0), cB + kstep, voffB); PG8_STAGE(PG8_SA(1, 0), cA + kstep, voffA); PG8_STAGE(PG8_SB(1, 1), cB + hstep + kstep, voffB);
        PG8_WAIT_V(6); PG8_BAR;
    } else {
        PG8_STAGE(PG8_SB(0, 0), cB, voffB); PG8_STAGE(PG8_SA(0, 0), cA, voffA); PG8_STAGE(PG8_SB(0, 1), cB + hstep, voffB); PG8_STAGE(PG8_SA(0, 1), cA + hstep, voffA);
        if (wr == 1) PG8_BAR;
        PG8_WAIT_V(4); PG8_BAR;
        PG8_STAGE(PG8_SB(1, 0), cB + kstep, voffB); PG8_STAGE(PG8_SA(1, 0), cA + kstep, voffA); PG8_STAGE(PG8_SB(1, 1), cB + hstep + kstep, voffB);
        PG8_WAIT_V(6); PG8_BAR;
    }
    for (;;) {
        const bool has_next = S.next(ui + 1, nxt);
        const char* nA = has_next ? (const char*)g.A + (size_t)nxt.pm * tstep : cA; const char* nB = has_next ? (const char*)g.Bt + (size_t)nxt.pn * tstep : cB;
        for (int t = 0; t < nt; t += 2) {
            const bool last = (t == nt - 2);
            const char* a1 = cA + (size_t)(t + 1) * kstep;
            const char* a2 = last ? nA : cA + (size_t)(t + 2) * kstep; const char* b2 = last ? nB : cB + (size_t)(t + 2) * kstep;
            const char* a3 = a2 + kstep; const char* b3 = b2 + kstep;
            if (last && has_next) S.a_ready(nxt);
            if constexpr (SP2) {
            PG8_LDB(B0, 0, 0); PG8_LDB(B1, 0, 1); PG8_SCHED; PG8_LDA(At, 0, 0); PG8_STAGE(PG8_SA(1, 1), a1 + hstep, voffA);
            PG8_WAIT_V(8); PG8_WAIT_L(0); PG8_BAR; PG8_MMA(0, 0, At, B0); PG8_MMA(0, 1, At, B1); PG8_BAR; PG8_SCHED;
            PG8_LDA(At, 0, 1); PG8_STAGE(PG8_SB(0, 0), b2, voffB); PG8_STAGE(PG8_SB(0, 1), b2 + hstep, voffB); PG8_STAGE(PG8_SA(0, 0), a2, voffA);
            PG8_WAIT_V(8); PG8_WAIT_L(0); PG8_BAR; PG8_MMA(1, 0, At, B0); PG8_MMA(1, 1, At, B1); PG8_BAR; PG8_SCHED;
            PG8_LDB(B0, 1, 0); PG8_LDB(B1, 1, 1); PG8_SCHED; PG8_LDA(At, 1, 0); PG8_STAGE(PG8_SA(0, 1), a2 + hstep, voffA);
            PG8_WAIT_V(8); PG8_WAIT_L(0); PG8_BAR; PG8_MMA(0, 0, At, B0); PG8_MMA(0, 1, At, B1); PG8_BAR; PG8_SCHED;
            PG8_LDA(At, 1, 1); PG8_STAGE(PG8_SB(1, 0), b3, voffB); PG8_STAGE(PG8_SB(1, 1), b3 + hstep, voffB); PG8_STAGE(PG8_SA(1, 0), a3, voffA);
            PG8_WAIT_V(8); PG8_WAIT_L(0); PG8_BAR; PG8_MMA(1, 0, At, B0); PG8_MMA(1, 1, At, B1); PG8_BAR; PG8_SCHED;
            } else {
            PG8_LDB(B0, 0, 0); PG8_SCHED; PG8_LDA(At, 0, 0); PG8_STAGE(PG8_SA(1, 1), a1 + hstep, voffA);
            PG8_WAIT_L(8); PG8_BAR; PG8_WAIT_L(0); PG8_MMA(0, 0, At, B0); PG8_BAR; PG8_SCHED;
            PG8_LDB(B1, 0, 1); PG8_STAGE(PG8_SB(0, 0), b2, voffB);
            PG8_BAR; PG8_WAIT_L(0); PG8_MMA(0, 1, At, B1); PG8_BAR;
            PG8_LDA(At, 0, 1); PG8_STAGE(PG8_SA(0, 0), a2, voffA);
            PG8_BAR; PG8_WAIT_L(0); PG8_MMA(1, 0, At, B0); PG8_BAR; PG8_SCHED;
            PG8_STAGE(PG8_SB(0, 1), b2 + hstep, voffB);
            PG8_WAIT_V(6); PG8_BAR; PG8_MMA(1, 1, At, B1); PG8_BAR;
            PG8_LDB(B0, 1, 0); PG8_SCHED; PG8_LDA(At, 1, 0); PG8_STAGE(PG8_SA(0, 1), a2 + hstep, voffA);
            PG8_WAIT_L(8); PG8_BAR; PG8_WAIT_L(0); PG8_MMA(0, 0, At, B0); PG8_BAR; PG8_SCHED;
            PG8_LDB(B1, 1, 1); PG8_STAGE(PG8_SB(1, 0), b3, voffB);
            PG8_BAR; PG8_WAIT_L(0); PG8_MMA(0, 1, At, B1); PG8_BAR;
            PG8_LDA(At, 1, 1); PG8_STAGE(PG8_SA(1, 0), a3, voffA);
            PG8_BAR; PG8_WAIT_L(0); PG8_MMA(1, 0, At, B0); PG8_BAR; PG8_SCHED;
            PG8_STAGE(PG8_SB(1, 1), b3 + hstep, voffB);
            PG8_WAIT_V(6); PG8_BAR; PG8_MMA(1, 1, At, B1); PG8_BAR;
            }
        }
        if constexpr (ALIGN_EPI) { if (wr == 0) PG8_BAR; }
        if constexpr (!Epi::AFTER_DRAIN) { E(acc, cur, wr, wc, fr, fq); S.done(cur); }
        if (!has_next) break;
#pragma unroll
        for (int a = 0; a < 2; ++a)
#pragma unroll
            for (int b = 0; b < 2; ++b)
#pragma unroll
                for (int m = 0; m < 4; ++m)
#pragma unroll
                    for (int n = 0; n < 2; ++n) acc[a][b][m][n] = (f32x4){0.f, 0.f, 0.f, 0.f};
        cur = nxt; cA = nA; cB = nB; ++ui;
        if constexpr (ALIGN_EPI) { if (wr == 1) PG8_BAR; }
    }
    PG8_WAIT_V(0);
    if constexpr (!ALIGN_EPI) { if (wr == 0) PG8_BAR; }
    PG8_BAR;
    if constexpr (Epi::AFTER_DRAIN) { E.fused(acc, cur, wr, wc, fr, fq, lds, wid, lane); S.done(cur); }
#undef PG8_SA
#undef PG8_SB
#undef PG8_STAGE
#undef PG8_LDA
#undef PG8_LDB
#undef PG8_MMA
#undef PG8_WAIT_V
#undef PG8_WAIT_L
#undef PG8_BAR
#undef PG8_SCHED
}
template <class Epi, class Sched>
__device__ __forceinline__ void gemm_phase_x(PG8_LAS unsigned char* lds, const Gemm g, const int Mx, const Sched& S, const Epi& E) {
    const int tid = threadIdx.x, wid = __builtin_amdgcn_readfirstlane(tid >> 6), lane = tid & 63, wr = wid >> 2, wc = wid & 3, fr = lane & 15, fq = lane >> 4;
    const int K = g.K, nt = K / BK;
    unsigned voffA, voffB, voffE;
    { int R, C; stage_rc(tid * 16, R, C); const int Rb = Epi::PERM ? ((R & ~31) + perm32(R & 31)) : R;
        voffA = (unsigned)(R * K + C) * 2u; voffB = (unsigned)(Rb * K + C) * 2u; }
    { const int b = tid * 4; int R, C; stage_rc(b & ~15, R, C); C += (b & 15) >> 1; voffE = (unsigned)(R * K + C) * 2u; }
    const size_t kstep = (size_t)(BK * 2);
    const size_t hstep = (size_t)HALF * K * 2;
    const size_t tstep = 2 * hstep;
    const size_t qstep = (size_t)64 * K * 2;
    const size_t estep = (size_t)16 * K * 2;
    const unsigned ldsw = (unsigned)wid * 1024u;
    const int aoff = lds_byte(wr * 64 + fr, fq * 8), boff = lds_byte(wc * 32 + fr, fq * 8), eoff = lds_byte(fr, fq * 8);
    constexpr int ES0 = 135168;
#define PG8_SA(b, h) (((b) * 2 + (h)) * HTB)
#define PG8_SB(b, h) ((4 + (b) * 2 + (h)) * HTB)
#define PG8_STAGE(bufoff, gbase, voff) do { _Pragma("unroll") for (int _i = 0; _i < 2; ++_i) \
        __builtin_amdgcn_global_load_lds((const unsigned*)((const char*)(gbase) + (size_t)_i * qstep + (voff)), (PG8_LAS unsigned*)(lds + (bufoff) + ldsw + _i * 8192), 16, 0, 0); } while (0)
#define PG8_STAGE_E(b, gbase) __builtin_amdgcn_global_load_lds((const unsigned*)((const char*)(gbase) + voffE), (PG8_LAS unsigned*)(lds + ES0 + (b) * 2048 + wid * 256), 4, 0, 0)
#define PG8_LDA(dst, b, h) do { _Pragma("unroll") for (int m = 0; m < 4; ++m) _Pragma("unroll") for (int k = 0; k < 2; ++k) dst[m][k] = *(const PG8_LAS bf16x8*)(lds + PG8_SA(b, h) + aoff + m * 2048 + k * 1024); } while (0)
#define PG8_LDB(dst, b, h) do { _Pragma("unroll") for (int n = 0; n < 2; ++n) _Pragma("unroll") for (int k = 0; k < 2; ++k) dst[n][k] = *(const PG8_LAS bf16x8*)(lds + PG8_SB(b, h) + boff + n * 2048 + k * 1024); } while (0)
#define PG8_LDE(dst, b) do { _Pragma("unroll") for (int k = 0; k < 2; ++k) dst[k] = *(const PG8_LAS bf16x8*)(lds + ES0 + (b) * 2048 + eoff + k * 1024); } while (0)
#define PG8_MMA(ai, bj, At, Bt) do { __builtin_amdgcn_s_setprio(1); _Pragma("unroll") for (int m = 0; m < 4; ++m) _Pragma("unroll") for (int n = 0; n < 2; ++n) _Pragma("unroll") for (int k = 0; k < 2; ++k) \
        acc[ai][bj][m][n] = __builtin_amdgcn_mfma_f32_16x16x32_bf16(Bt[n][k], At[m][k], acc[ai][bj][m][n], 0, 0, 0); __builtin_amdgcn_s_setprio(0); } while (0)
#define PG8_MMA_E(Bt) do { _Pragma("unroll") for (int n = 0; n < 2; ++n) _Pragma("unroll") for (int k = 0; k < 2; ++k) accE[n] = __builtin_amdgcn_mfma_f32_16x16x32_bf16(Bt[n][k], Et[k], accE[n], 0, 0, 0); } while (0)
#define PG8_WAIT_V(n) asm volatile("s_waitcnt vmcnt(" #n ")" ::: "memory")
#define PG8_WAIT_L(n) asm volatile("s_waitcnt lgkmcnt(" #n ")" ::: "memory")
#define PG8_BAR __builtin_amdgcn_s_barrier()
#define PG8_SCHED __builtin_amdgcn_sched_barrier(0)
    Unit cur, nxt; int ui = 0;
    if (!S.next(0, cur)) return;
    f32x4 acc[2][2][4][2], accE[2];
#pragma unroll
    for (int a = 0; a < 2; ++a)
#pragma unroll
        for (int b = 0; b < 2; ++b)
#pragma unroll
            for (int m = 0; m < 4; ++m)
#pragma unroll
                for (int n = 0; n < 2; ++n) acc[a][b][m][n] = (f32x4){0.f, 0.f, 0.f, 0.f};
    accE[0] = (f32x4){0.f, 0.f, 0.f, 0.f}; accE[1] = accE[0];
    bf16x8 At[4][2], B0[2][2], B1[2][2], Et[2];
    const char* cA = (const char*)g.A + (size_t)cur.pm * tstep; const char* cB = (const char*)g.Bt + (size_t)cur.pn * tstep;
    const char* cE = (const char*)g.A + (size_t)Mx * K * 2 + (size_t)cur.pm * estep;
    S.a_ready(cur);
    PG8_STAGE(PG8_SB(0, 0), cB, voffB); PG8_STAGE(PG8_SB(0, 1), cB + hstep, voffB); PG8_STAGE(PG8_SA(0, 0), cA, voffA); PG8_STAGE_E(0, cE); PG8_STAGE(PG8_SA(0, 1), cA + hstep, voffA);
    if (wr == 1) PG8_BAR;
    PG8_WAIT_V(2); PG8_BAR;
    PG8_STAGE(PG8_SB(1, 0), cB + kstep, voffB); PG8_STAGE(PG8_SA(1, 0), cA + kstep, voffA); PG8_STAGE(PG8_SB(1, 1), cB + hstep + kstep, voffB);
    PG8_WAIT_V(6); PG8_BAR;
    for (;;) {
        const bool has_next = S.next(ui + 1, nxt);
        const char* nA = has_next ? (const char*)g.A + (size_t)nxt.pm * tstep : cA; const char* nB = has_next ? (const char*)g.Bt + (size_t)nxt.pn * tstep : cB;
        const char* nE = has_next ? (const char*)g.A + (size_t)Mx * K * 2 + (size_t)nxt.pm * estep : cE;
        for (int t = 0; t < nt; t += 2) {
            const bool last = (t == nt - 2);
            const char* a1 = cA + (size_t)(t + 1) * kstep;
            const char* a2 = last ? nA : cA + (size_t)(t + 2) * kstep; const char* b2 = last ? nB : cB + (size_t)(t + 2) * kstep; const char* e2 = last ? nE : cE + (size_t)(t + 2) * kstep;
            const char* a3 = a2 + kstep; const char* b3 = b2 + kstep; const char* e1 = cE + (size_t)(t + 1) * kstep;
            if (last && has_next) S.a_ready(nxt);
            PG8_LDB(B0, 0, 0); PG8_LDB(B1, 0, 1); PG8_SCHED; PG8_LDA(At, 0, 0); PG8_STAGE_E(1, e1); PG8_STAGE(PG8_SA(1, 1), a1 + hstep, voffA);
            PG8_WAIT_V(9); PG8_WAIT_L(0); PG8_BAR; PG8_MMA(0, 0, At, B0); PG8_MMA(0, 1, At, B1); PG8_SCHED; PG8_LDE(Et, 0); PG8_WAIT_L(0); if (wr == 0) PG8_MMA_E(B0); else PG8_MMA_E(B1); PG8_BAR; PG8_SCHED;
            PG8_LDA(At, 0, 1); PG8_STAGE(PG8_SB(0, 0), b2, voffB); PG8_STAGE(PG8_SB(0, 1), b2 + hstep, voffB); PG8_STAGE(PG8_SA(0, 0), a2, voffA);
            PG8_WAIT_V(8); PG8_WAIT_L(0); PG8_BAR; PG8_MMA(1, 0, At, B0); PG8_MMA(1, 1, At, B1); PG8_BAR; PG8_SCHED;
            PG8_LDB(B0, 1, 0); PG8_LDB(B1, 1, 1); PG8_SCHED; PG8_LDA(At, 1, 0); PG8_STAGE_E(0, e2); PG8_STAGE(PG8_SA(0, 1), a2 + hstep, voffA);
            PG8_WAIT_V(9); PG8_WAIT_L(0); PG8_BAR; PG8_MMA(0, 0, At, B0); PG8_MMA(0, 1, At, B1); PG8_SCHED; PG8_LDE(Et, 1); PG8_WAIT_L(0); if (wr == 0) PG8_MMA_E(B0); else PG8_MMA_E(B1); PG8_BAR; PG8_SCHED;
            PG8_LDA(At, 1, 1); PG8_STAGE(PG8_SB(1, 0), b3, voffB); PG8_STAGE(PG8_SB(1, 1), b3 + hstep, voffB); PG8_STAGE(PG8_SA(1, 0), a3, voffA);
            PG8_WAIT_V(8); PG8_WAIT_L(0); PG8_BAR; PG8_MMA(1, 0, At, B0); PG8_MMA(1, 1, At, B1); PG8_BAR; PG8_SCHED;
        }
        if (wr == 0) PG8_BAR;
        E(acc, cur, wr, wc, fr, fq); E.extra(accE, cur, wr, wc, fr, fq); S.done(cur);
        if (!has_next) break;
#pragma unroll
        for (int a = 0; a < 2; ++a)
#pragma unroll
            for (int b = 0; b < 2; ++b)
#pragma unroll
                for (int m = 0; m < 4; ++m)
#pragma unroll
                    for (int n = 0; n < 2; ++n) acc[a][b][m][n] = (f32x4){0.f, 0.f, 0.f, 0.f};
        accE[0] = (f32x4){0.f, 0.f, 0.f, 0.f}; accE[1] = accE[0];
        cur = nxt; cA = nA; cB = nB; cE = nE; ++ui;
        if (wr == 1) PG8_BAR;
    }
    PG8_WAIT_V(0);
    PG8_BAR;
#undef PG8_SA
#undef PG8_SB
#undef PG8_STAGE
#undef PG8_STAGE_E
#undef PG8_LDA
#undef PG8_LDB
#undef PG8_LDE
#undef PG8_MMA
#undef PG8_MMA_E
#undef PG8_WAIT_V
#undef PG8_WAIT_L
#undef PG8_BAR
#undef PG8_SCHED
}
}
constexpr int NWAVES = 8;
#ifndef MK_N_LAUNCHES
#define MK_N_LAUNCHES 1
#endif
constexpr int N_PHASES = 14;
constexpr int MROWS = 17408, MP = 16384, DM = 1024, DFF = 4096, NIN1 = 3088, NIN1P = 3328;
constexpr size_t MiB = 1u << 20;
constexpr size_t WS_CTL = 0, CTL_ZERO_BYTES = 1 * MiB;
constexpr size_t WS_SS = 128 * 1024;
constexpr size_t WS_LB = 1 * MiB;
constexpr size_t WS_WIN0 = 2 * MiB, WS_WOUT0 = 10 * MiB, WS_WUP0 = 12 * MiB, WS_WDN0 = 20 * MiB, WS_WIN1 = 28 * MiB, WS_WOUT1 = 35 * MiB, WS_WUP1 = 37 * MiB, WS_WDN1 = 45 * MiB;
constexpr size_t WS_XB = 53 * MiB;
constexpr size_t WS_ACT = 87 * MiB;
constexpr size_t ACT_T = (size_t)MROWS * 1024 * 2;
constexpr size_t WS_Q = WS_ACT, WS_LF = WS_ACT + ACT_T, WS_V = WS_ACT + 2 * ACT_T, WS_G = WS_ACT + 3 * ACT_T;
constexpr size_t WS_QM = WS_ACT, WS_KM = WS_ACT + ACT_T / 2, WS_VM = WS_ACT + ACT_T, WS_OM = WS_ACT + 2 * ACT_T, WS_GT = WS_ACT + 3 * ACT_T;
constexpr size_t WS_END = WS_ACT + 4 * ACT_T;
static_assert(WS_END <= 224 * MiB, "d_ws map");
constexpr int CW_BAR = 4096;
constexpr size_t OUT_Y = 0, OUT_SP = 17825792, OUT_CP = 18874368, OUT_NP = 19398656, OUT_MP = 19402752, OUT_SS = 19402816, OUT_CS = 36180032, OUT_NS = 44568640, OUT_MS = 44634176, OUT_END = 44635200;
constexpr int RING_BYTES = 131072, LDSCTL_OFF = RING_BYTES, MISC_OFF = LDSCTL_OFF + 320, LDS_BYTES = 147456;

#define GAS __attribute__((address_space(1)))
#define LAS __attribute__((address_space(3)))
typedef unsigned short bf16;
typedef unsigned v4u __attribute__((ext_vector_type(4)));
typedef unsigned v2u __attribute__((ext_vector_type(2)));
typedef float f32x4 __attribute__((ext_vector_type(4)));
typedef float f32x2 __attribute__((ext_vector_type(2)));
typedef short bf16x8 __attribute__((ext_vector_type(8)));
typedef GAS unsigned gu32;
#define RLX_AGENT __ATOMIC_RELAXED, __HIP_MEMORY_SCOPE_AGENT
#define LDS_WAIT() asm volatile("s_waitcnt lgkmcnt(0)" ::: "memory")
#define VM_WAIT() asm volatile("s_waitcnt vmcnt(0)" ::: "memory")
__device__ __forceinline__ unsigned f2bf(float f) { unsigned u = __builtin_bit_cast(unsigned, f); return (u + 0x7fffu + ((u >> 16) & 1u)) >> 16; }
typedef __bf16 bf16x2c __attribute__((ext_vector_type(2)));
__device__ __forceinline__ unsigned pk2(float lo, float hi) { f32x2 v = {lo, hi}; bf16x2c b = __builtin_convertvector(v, bf16x2c); return __builtin_bit_cast(unsigned, b); }
__device__ __forceinline__ float bflo(unsigned w) { return __builtin_bit_cast(float, w << 16); }
__device__ __forceinline__ float bfhi(unsigned w) { return __builtin_bit_cast(float, w & 0xffff0000u); }
__device__ __forceinline__ float bf1(unsigned short h) { return __builtin_bit_cast(float, (unsigned)h << 16); }
__device__ __forceinline__ float hlo(unsigned w) { return (float)__builtin_bit_cast(_Float16, (unsigned short)(w & 0xffffu)); }
__device__ __forceinline__ float hhi(unsigned w) { return (float)__builtin_bit_cast(_Float16, (unsigned short)(w >> 16)); }
__device__ __forceinline__ float h1(unsigned short h) { return (float)__builtin_bit_cast(_Float16, h); }

#define XB_TMO      128
#define XB_XCNT(j)  (256  + 64 * (j))
#define XB_XSUB(j)  (1280 + 64 * (j))
#define XB_XGEN(j)  (2304 + 64 * (j))
#define XB_TOP      3328
#define XB_TOPGEN   3392
#define XCD_BAR_WORDS 3456
#define XB_SPIN_CAP (1u << 18)
__device__ __forceinline__ unsigned xb_ld(unsigned* p)              { return __hip_atomic_load(p, __ATOMIC_RELAXED, __HIP_MEMORY_SCOPE_AGENT); }
__device__ __forceinline__ unsigned xb_add(unsigned* p, unsigned v) { return __hip_atomic_fetch_add(p, v, __ATOMIC_RELAXED, __HIP_MEMORY_SCOPE_AGENT); }
__device__ __forceinline__ unsigned xb_xcc_id() { return (unsigned)__builtin_amdgcn_s_getreg((3 << 11) | 20) & 0xFu; }
#define XB_SPIN(cond, bar) do { unsigned _sp = 0; while (cond) { __builtin_amdgcn_s_sleep(1); \
    if ((++_sp & 255u) == 0u) { if (xb_ld(&(bar)[XB_TMO])) break; if (_sp > XB_SPIN_CAP) { atomicAdd(&(bar)[XB_TMO], 1u); break; } } } } while (0)
struct XcdBarrier { unsigned* bar; unsigned x; volatile LAS unsigned* st; };
__device__ __forceinline__ XcdBarrier xcd_barrier_post(unsigned* bar, volatile LAS unsigned* st) {
    XcdBarrier b; b.bar = bar; b.x = xb_xcc_id(); b.st = st;
    if (threadIdx.x == 0) (void)xb_add(&bar[XB_XCNT(b.x)], 1u);
    return b;
}
__device__ __forceinline__ void xcd_barrier_complete(unsigned* bar, unsigned x, unsigned& nloc, unsigned& nx) {
    const unsigned G = gridDim.x * gridDim.y * gridDim.z;
    unsigned sum, cnt, mine, sp = 0u;
    for (;;) {
        sum = 0u; cnt = 0u; mine = 0u;
#pragma unroll
        for (unsigned j = 0; j < 16; ++j) { const unsigned c = xb_ld(&bar[XB_XCNT(j)]); sum += c; cnt += (c > 0u) ? 1u : 0u; mine = (j == x) ? c : mine; }
        if (sum == G) break;
        __builtin_amdgcn_s_sleep(1);
        if ((++sp & 255u) == 0u) { if (xb_ld(&bar[XB_TMO])) break; if (sp > XB_SPIN_CAP) { atomicAdd(&bar[XB_TMO], 1u); break; } }
    }
    nloc = mine > 0u ? mine : 1u; nx = cnt > 0u ? cnt : 1u;
}
__device__ __forceinline__ void xcd_barrier(const XcdBarrier& b) {
    asm volatile("s_waitcnt vmcnt(0)" ::: "memory");
    __syncthreads();
    if (threadIdx.x == 0) {
        unsigned* bar = b.bar;
        __builtin_amdgcn_s_waitcnt(0);
        unsigned nloc = b.st[0], nx = b.st[1];
        if (nloc == 0u) { xcd_barrier_complete(bar, b.x, nloc, nx); b.st[0] = nloc; b.st[1] = nx; }
        const unsigned old = xb_add(&bar[XB_XSUB(b.x)], 1u);
        const unsigned gen = old / nloc;
        if (old + 1u == (gen + 1u) * nloc) {
            __builtin_amdgcn_fence(__ATOMIC_RELEASE, "agent");
            asm volatile("s_waitcnt vmcnt(0)" ::: "memory");
            const unsigned og = xb_add(&bar[XB_TOP], 1u);
            const unsigned tg = og / nx;
            if (og + 1u == (tg + 1u) * nx) xb_add(&bar[XB_TOPGEN], 1u);
            else XB_SPIN(xb_ld(&bar[XB_TOPGEN]) == tg, bar);
            __builtin_amdgcn_fence(__ATOMIC_ACQUIRE, "agent");
            xb_add(&bar[XB_XGEN(b.x)], 1u);
            asm volatile("s_waitcnt vmcnt(0)" ::: "memory");
        } else {
            XB_SPIN(xb_ld(&bar[XB_XGEN(b.x)]) == gen, bar);
            __builtin_amdgcn_fence(__ATOMIC_ACQUIRE, "agent");
            asm volatile("s_waitcnt vmcnt(0)" ::: "memory");
        }
    }
    __syncthreads();
}

__device__ __forceinline__ float wave_sum(float v) {
#pragma unroll
    for (int o = 1; o < 64; o <<= 1) v += __shfl_xor(v, o);
    return v;
}
__device__ __forceinline__ void p0_transpose_item(const float* W, int K, int N, const float* sc, bf16* WT, LAS float* scr, int item, int lane) {
    const int nblk = (N + 31) / 32, kb = item / nblk, nb = item % nblk, k0 = 64 * kb, n0 = 32 * nb;
    const bool nok = (n0 + (lane & 31)) < N;
    float wv[32];
#pragma unroll
    for (int i = 0; i < 32; ++i) { const int kk = 2 * i + (lane >> 5); wv[i] = nok ? W[(size_t)(k0 + kk) * N + n0 + (lane & 31)] : 0.f; }
    const float s0 = sc ? sc[k0 + lane] : 1.0f;
#pragma unroll
    for (int i = 0; i < 32; ++i) { const int kk = 2 * i + (lane >> 5); scr[kk * 33 + (lane & 31)] = wv[i] * __shfl(s0, kk); }
    LDS_WAIT(); asm volatile("" ::: "memory");
    const int c = lane & 7;
#pragma unroll
    for (int j = 0; j < 4; ++j) { const int n = (lane >> 3) + 8 * j; const LAS float* s = scr + (8 * c) * 33 + n;
        v4u o; o.x = pk2(s[0 * 33], s[1 * 33]); o.y = pk2(s[2 * 33], s[3 * 33]); o.z = pk2(s[4 * 33], s[5 * 33]); o.w = pk2(s[6 * 33], s[7 * 33]);
        *(GAS v4u*)(WT + (size_t)(n0 + n) * K + k0 + 8 * c) = o; }
    LDS_WAIT(); asm volatile("" ::: "memory");
}
#define MFMA16(a, b, c) __builtin_amdgcn_mfma_f32_16x16x32_bf16((a), (b), (c), 0, 0, 0)
#define LDSV(T, off) (*(LAS T*)(lds + (off)))
#define LDSF(off) (*(const LAS bf16x8*)(lds + (off)))
#define BAR_LDS() do { asm volatile("s_waitcnt lgkmcnt(0)" ::: "memory"); __builtin_amdgcn_s_barrier(); asm volatile("" ::: "memory"); } while (0)
namespace hg {
constexpr int QP = 0, KP = QP + 64 * 272, KPPT = KP + 64 * 272, VT = KPPT + 128 * 144, AM = VT + 128 * 144, ST = AM + 64 * 144, GT = ST + 128 * 272, DEC = GT + 8 * 128 * 4, NP = DEC + 512, END = NP + 512;
static_assert(END <= RING_BYTES, "hgrn LDS");
}
template <bool STATE_ONLY>
__device__ __forceinline__ void hgrn_seg_item(LAS unsigned char* lds, int b, int h, int g, const bf16* Qb, const bf16* LFb, const bf16* Vb, const bf16* Gb, bf16* Ob, const float* onw, float* Escr, float* Dscr, float* S_out) {
    using namespace hg;
    constexpr int NCH = 8;
    const int tid = threadIdx.x, lane = tid & 63, w = __builtin_amdgcn_readfirstlane(tid >> 6), fr = lane & 15, fq = lane >> 4;
    const int tb = w & 3, wh = w >> 2;
    const size_t rowb = (size_t)b * 2048 + (size_t)g * 512;
    const int colp = h * 128 + 2 * lane;
    const int item0 = (b * 8 + h) * 4;
    __syncthreads();
    f32x4 sacc[8];
#pragma unroll
    for (int j = 0; j < 8; ++j) sacc[j] = (f32x4){0.f, 0.f, 0.f, 0.f};
    if (!STATE_ONLY && g > 0) {
#pragma unroll
        for (int j = 0; j < 8; ++j) sacc[j] = *(const f32x4*)(Escr + ((size_t)item0 * 16384) + ((w * 8 + j) * 64 + lane) * 4);
        for (int gg = 1; gg < g; ++gg) { const f32x4 dec = *(const f32x4*)(Dscr + (item0 + gg) * 128 + 16 * w + 4 * fq);
#pragma unroll
            for (int j = 0; j < 8; ++j) sacc[j] = sacc[j] * dec + *(const f32x4*)(Escr + ((size_t)(item0 + gg) * 16384) + ((w * 8 + j) * 64 + lane) * 4); }
#pragma unroll
        for (int j = 0; j < 8; ++j) LDSV(v2u, ST + (j * 16 + fr) * 272 + (16 * w + 4 * fq) * 2) = (v2u){pk2(sacc[j][0], sacc[j][1]), pk2(sacc[j][2], sacc[j][3])};
    } else if (!STATE_ONLY) {
        for (int i = tid; i < 128 * 272 / 4; i += 512) LDSV(unsigned, ST + 4 * i) = 0u;
    }
    __syncthreads();
    f32x4 wn[4];
#pragma unroll
    for (int j = 0; j < 4; ++j) wn[j] = *(const f32x4*)(onw + h * 128 + (4 * wh + j) * 16 + 4 * fq);
    unsigned rq[8], rl[8], rv[8]; float bp0 = 0.f, bp1 = 0.f;
#pragma unroll
    for (int i = 0; i < 8; ++i) { const size_t e = (rowb + 8 * w + i) * 1024 + colp; if (!STATE_ONLY) rq[i] = *(const unsigned*)(Qb + e); rl[i] = *(const unsigned*)(LFb + e); rv[i] = *(const unsigned*)(Vb + e); }
    for (int c = 0; c < NCH; ++c) {
        float c0[8], c1[8]; { float a0 = 0.f, a1 = 0.f;
#pragma unroll
            for (int i = 0; i < 8; ++i) { a0 += hlo(rl[i]); a1 += hhi(rl[i]); c0[i] = a0; c1[i] = a1; }
            LDSV(f32x2, GT + (w * 128 + 2 * lane) * 4) = (f32x2){a0, a1}; }
        BAR_LDS();
        float pre0 = 0.f, pre1 = 0.f, tot0 = 0.f, tot1 = 0.f;
#pragma unroll
        for (int gi = 0; gi < 8; ++gi) { const f32x2 x = LDSV(f32x2, GT + (gi * 128 + 2 * lane) * 4); tot0 += x.x; tot1 += x.y; if (gi < w) { pre0 += x.x; pre1 += x.y; } }
        if (w == 0) LDSV(f32x2, DEC + 2 * lane * 4) = (f32x2){__expf(tot0), __expf(tot1)};
        bp0 += tot0; bp1 += tot1;
        { unsigned kk0[4], kk1[4], vv0[4], vv1[4]; float pk0 = 0.f, pk1 = 0.f;
#pragma unroll
            for (int i = 0; i < 8; ++i) {
                const float b0 = pre0 + c0[i], b1 = pre1 + c1[i];
                const float k0 = 1.0f - __expf(hlo(rl[i])), k1 = 1.0f - __expf(hhi(rl[i]));
                const float l0 = __expf(tot0 - b0), l1 = __expf(tot1 - b1);
                if (!STATE_ONLY) { const float e0 = __expf(b0), e1 = __expf(b1), n0 = __expf(-b0), n1 = __expf(-b1);
                    LDSV(unsigned, QP + (8 * w + i) * 272 + 4 * lane) = pk2(bflo(rq[i]) * e0, bfhi(rq[i]) * e1);
                    LDSV(unsigned, KP + (8 * w + i) * 272 + 4 * lane) = pk2(k0 * n0, k1 * n1); }
                const float x0 = k0 * l0, x1 = k1 * l1;
                if (i & 1) { kk0[i >> 1] = pk2(pk0, x0); kk1[i >> 1] = pk2(pk1, x1); vv0[i >> 1] = (rv[i - 1] & 0xffffu) | (rv[i] << 16); vv1[i >> 1] = (rv[i - 1] >> 16) | (rv[i] & 0xffff0000u); }
                else { pk0 = x0; pk1 = x1; }
            }
            LDSV(v4u, KPPT + (2 * lane) * 144 + 16 * w) = (v4u){kk0[0], kk0[1], kk0[2], kk0[3]};
            LDSV(v4u, KPPT + (2 * lane + 1) * 144 + 16 * w) = (v4u){kk1[0], kk1[1], kk1[2], kk1[3]};
            LDSV(v4u, VT + (2 * lane) * 144 + 16 * w) = (v4u){vv0[0], vv0[1], vv0[2], vv0[3]};
            LDSV(v4u, VT + (2 * lane + 1) * 144 + 16 * w) = (v4u){vv1[0], vv1[1], vv1[2], vv1[3]}; }
        const size_t orow = (rowb + (size_t)c * 64 + tb * 16 + fr) * 1024 + h * 128 + 4 * fq;
        v2u rg[4];
        if (!STATE_ONLY) {
#pragma unroll
            for (int j = 0; j < 4; ++j) rg[j] = *(const v2u*)(Gb + orow + (4 * wh + j) * 16);
        }
        if (c + 1 < NCH) {
#pragma unroll
            for (int i = 0; i < 8; ++i) { const size_t e = (rowb + (size_t)(c + 1) * 64 + 8 * w + i) * 1024 + colp; if (!STATE_ONLY) rq[i] = *(const unsigned*)(Qb + e); rl[i] = *(const unsigned*)(LFb + e); rv[i] = *(const unsigned*)(Vb + e); }
        }
        BAR_LDS();
        f32x4 oacc[4];
        if (!STATE_ONLY) {
#pragma unroll
        for (int j = 0; j < 2; ++j) { const int sb = 2 * wh + j; f32x4 a = (f32x4){0.f, 0.f, 0.f, 0.f};
            if (sb <= tb) {
#pragma unroll
                for (int kk = 0; kk < 4; ++kk) a = MFMA16(LDSF(KP + (sb * 16 + fr) * 272 + kk * 64 + fq * 16), LDSF(QP + (tb * 16 + fr) * 272 + kk * 64 + fq * 16), a);
                const int t = tb * 16 + fr, s0 = sb * 16 + 4 * fq;
#pragma unroll
                for (int r = 0; r < 4; ++r) if (s0 + r > t) a[r] = 0.f;
            }
            LDSV(v2u, AM + (tb * 16 + fr) * 144 + (sb * 16 + 4 * fq) * 2) = (v2u){pk2(a[0], a[1]), pk2(a[2], a[3])}; }
        BAR_LDS();
        { bf16x8 bA[2], bQ[4];
#pragma unroll
            for (int kk = 0; kk < 2; ++kk) bA[kk] = LDSF(AM + (tb * 16 + fr) * 144 + kk * 64 + fq * 16);
#pragma unroll
            for (int kk = 0; kk < 4; ++kk) bQ[kk] = LDSF(QP + (tb * 16 + fr) * 272 + kk * 64 + fq * 16);
#pragma unroll
            for (int j = 0; j < 4; ++j) { const int dvb = 4 * wh + j; f32x4 a = (f32x4){0.f, 0.f, 0.f, 0.f};
#pragma unroll
                for (int kk = 0; kk < 2; ++kk) a = MFMA16(LDSF(VT + (dvb * 16 + fr) * 144 + kk * 64 + fq * 16), bA[kk], a);
#pragma unroll
                for (int kk = 0; kk < 4; ++kk) a = MFMA16(LDSF(ST + (dvb * 16 + fr) * 272 + kk * 64 + fq * 16), bQ[kk], a);
                oacc[j] = a; } }
        { float ss = 0.f;
#pragma unroll
            for (int j = 0; j < 4; ++j) ss += (oacc[j][0] * oacc[j][0] + oacc[j][1] * oacc[j][1]) + (oacc[j][2] * oacc[j][2] + oacc[j][3] * oacc[j][3]);
            ss += __shfl_xor(ss, 16); ss += __shfl_xor(ss, 32);
            if (fq == 0) LDSV(float, NP + ((tb * 16 + fr) * 2 + wh) * 4) = ss; }
        }
        { const f32x4 dec = LDSV(f32x4, DEC + (16 * w + 4 * fq) * 4); bf16x8 aK[2];
#pragma unroll
            for (int kk = 0; kk < 2; ++kk) aK[kk] = LDSF(KPPT + (16 * w + fr) * 144 + kk * 64 + fq * 16);
#pragma unroll
            for (int j = 0; j < 8; ++j) { f32x4 a = sacc[j] * dec;
#pragma unroll
                for (int kk = 0; kk < 2; ++kk) a = MFMA16(aK[kk], LDSF(VT + (j * 16 + fr) * 144 + kk * 64 + fq * 16), a);
                sacc[j] = a; } }
        BAR_LDS();
        if (!STATE_ONLY) {
        { const f32x2 p = LDSV(f32x2, NP + (tb * 16 + fr) * 8); const float rstd = rsqrtf((p.x + p.y) * (1.0f / 128.0f) + 1e-6f);
#pragma unroll
            for (int j = 0; j < 4; ++j) { const f32x4 o = oacc[j] * rstd * wn[j];
                *(v2u*)(Ob + orow + (4 * wh + j) * 16) = (v2u){pk2(o[0] * bflo(rg[j].x), o[1] * bfhi(rg[j].x)), pk2(o[2] * bflo(rg[j].y), o[3] * bfhi(rg[j].y))}; } }
#pragma unroll
        for (int j = 0; j < 8; ++j) LDSV(v2u, ST + (j * 16 + fr) * 272 + (16 * w + 4 * fq) * 2) = (v2u){pk2(sacc[j][0], sacc[j][1]), pk2(sacc[j][2], sacc[j][3])};
        }
    }
    if (STATE_ONLY) {
#pragma unroll
        for (int j = 0; j < 8; ++j) *(f32x4*)(Escr + ((size_t)(item0 + g) * 16384) + ((w * 8 + j) * 64 + lane) * 4) = sacc[j];
        if (w == 0) *(f32x2*)(Dscr + (item0 + g) * 128 + 2 * lane) = (f32x2){__expf(bp0), __expf(bp1)};
    } else if (g == 3) {
        float* so = S_out + (size_t)(b * 8 + h) * 128 * 128;
#pragma unroll
        for (int j = 0; j < 8; ++j)
#pragma unroll
            for (int r = 0; r < 4; ++r) so[(size_t)(16 * w + 4 * fq + r) * 128 + j * 16 + fr] = sacc[j][r];
    }
}
__device__ __forceinline__ void hgrn_sample_item(LAS unsigned char* lds, int b, int h, const bf16* Qb, const bf16* LFb, const bf16* Vb, const bf16* Gb, bf16* Ob, const float* onw, const float* S_in, float* S_out) {
    constexpr int FKQ = 0, VS = 16384, RED = 20480;
    const int tid = threadIdx.x, lane = tid & 63, w = __builtin_amdgcn_readfirstlane(tid >> 6), c4 = tid & 31, dg = tid >> 5;
    const size_t rowb = (size_t)MP + (size_t)b * 8;
    __syncthreads();
#pragma unroll
    for (int e = tid; e < 1024; e += 512) { const int t = e >> 7, d = e & 127; const size_t g = (rowb + t) * 1024 + h * 128 + d;
        const float f = __expf(h1(LFb[g])); LDSV(f32x4, FKQ + e * 16) = (f32x4){f, 1.0f - f, bf1(Qb[g]), 0.f}; LDSV(float, VS + e * 4) = bf1(Vb[g]); }
    const size_t sbase = ((size_t)(b * 8 + h) * 128 + 8 * dg) * 128 + 4 * c4;
    f32x4 s[8], po[8];
#pragma unroll
    for (int i = 0; i < 8; ++i) s[i] = *(const f32x4*)(S_in + sbase + (size_t)i * 128);
    __syncthreads();
#pragma unroll
    for (int t = 0; t < 8; ++t) { const f32x4 vv = LDSV(f32x4, VS + (t * 128 + 4 * c4) * 4); f32x4 p = (f32x4){0.f, 0.f, 0.f, 0.f};
#pragma unroll
        for (int i = 0; i < 8; ++i) { const f32x4 x = LDSV(f32x4, FKQ + (t * 128 + 8 * dg + i) * 16); s[i] = s[i] * x[0] + vv * x[1]; p += s[i] * x[2]; }
        po[t] = p; }
#pragma unroll
    for (int t = 0; t < 8; ++t) LDSV(f32x4, RED + ((dg * 8 + t) * 128 + 4 * c4) * 4) = po[t];
#pragma unroll
    for (int i = 0; i < 8; ++i) *(f32x4*)(S_out + sbase + (size_t)i * 128) = s[i];
    __syncthreads();
    { const int t = w; float o0 = 0.f, o1 = 0.f;
#pragma unroll
        for (int g = 0; g < 16; ++g) { const f32x2 x = LDSV(f32x2, RED + ((g * 8 + t) * 128 + 2 * lane) * 4); o0 += x.x; o1 += x.y; }
        const float rstd = rsqrtf(wave_sum(o0 * o0 + o1 * o1) * (1.0f / 128.0f) + 1e-6f);
        const size_t g = (rowb + t) * 1024 + h * 128 + 2 * lane; const unsigned gg = *(const unsigned*)(Gb + g);
        *(unsigned*)(Ob + g) = pk2(o0 * rstd * onw[h * 128 + 2 * lane] * bflo(gg), o1 * rstd * onw[h * 128 + 2 * lane + 1] * bfhi(gg)); }
}
namespace ml {
constexpr int Q = 0, K = Q + 64 * 144, KWT = K + 64 * 144, AM = KWT + 64 * 144, VTE = AM + 64 * 144, CTE = VTE + 144 * 144, AS = CTE + 144 * 144, MT = AS + 256, WI = MT + 256, EM = WI + 256, WS = EM + 256, DEN = WS + 256, SC = DEN + 256, NP = SC + 16, END = NP + 512;
static_assert(END <= RING_BYTES, "mlstm LDS");
}
template <bool STATE_ONLY>
__device__ __forceinline__ void mlstm_seg_item(LAS unsigned char* lds, int b, int h, int g, const bf16* Qm, const bf16* Km, const bf16* Vm, const bf16* Om, const float* GTg, bf16* Hb, const float* onw,
                                               float* Escr, float* Mscr, float* C_out, float* n_out, float* m_out) {
    using namespace ml;
    constexpr int NCH = 8;
    const int tid = threadIdx.x, lane = tid & 63, w = __builtin_amdgcn_readfirstlane(tid >> 6), fr = lane & 15, fq = lane >> 4;
    const int tb = w & 3, wh = w >> 2;
    const size_t rowb = (size_t)b * 2048 + (size_t)g * 512;
    const int dp = tid & 31, tg4 = tid >> 5;
    const int item0 = (b * 8 + h) * 4;
    __syncthreads();
    for (int i = tid; i < 144 * 144 / 4; i += 512) { LDSV(unsigned, CTE + 4 * i) = 0u; const int row = (4 * i) / 144; LDSV(unsigned, VTE + 4 * i) = row == 128 ? 0x3f803f80u : 0u; }
    __syncthreads();
    f32x4 cacc[5];
#pragma unroll
    for (int j = 0; j < 5; ++j) cacc[j] = (f32x4){0.f, 0.f, 0.f, 0.f};
    float m_prev = (STATE_ONLY && g > 0) ? -INFINITY : 0.f, btot = 0.f;
    if (!STATE_ONLY && g > 0) {
#pragma unroll
        for (int j = 0; j < 5; ++j) cacc[j] = *(const f32x4*)(Escr + (size_t)item0 * 10240 + ((w * 5 + j) * 64 + lane) * 4);
        m_prev = Mscr[item0 * 2];
        for (int gg = 1; gg < g; ++gg) { const float mE = Mscr[(item0 + gg) * 2], Bt = Mscr[(item0 + gg) * 2 + 1]; const float mn = fmaxf(m_prev + Bt, mE), f1 = __expf(m_prev + Bt - mn), f2 = __expf(mE - mn);
#pragma unroll
            for (int j = 0; j < 5; ++j) cacc[j] = cacc[j] * f1 + *(const f32x4*)(Escr + (size_t)(item0 + gg) * 10240 + ((w * 5 + j) * 64 + lane) * 4) * f2;
            m_prev = mn; }
#pragma unroll
        for (int j = 0; j < 5; ++j) { if (j == 4 && wh != 0) break; const int dvb = j == 4 ? 8 : 4 * wh + j;
            LDSV(v2u, CTE + (dvb * 16 + fr) * 144 + (16 * tb + 4 * fq) * 2) = (v2u){pk2(cacc[j][0], cacc[j][1]), pk2(cacc[j][2], cacc[j][3])}; }
    }
    f32x4 wn[4];
#pragma unroll
    for (int j = 0; j < 4; ++j) wn[j] = *(const f32x4*)(onw + h * 128 + (4 * wh + j) * 16 + 4 * fq);
    unsigned rq[4], rk[4], rv[8]; float gli = 0.f, glf = 0.f;
#pragma unroll
    for (int i = 0; i < 4; ++i) { const size_t e = (rowb + 4 * tg4 + i) * 512 + h * 64 + 2 * dp; if (!STATE_ONLY) rq[i] = *(const unsigned*)(Qm + e); rk[i] = *(const unsigned*)(Km + e); }
#pragma unroll
    for (int i = 0; i < 8; ++i) rv[i] = *(const unsigned*)(Vm + (rowb + 8 * w + i) * 1024 + h * 128 + 2 * lane);
    if (w == 0) { gli = GTg[(rowb + lane) * 16 + h]; glf = GTg[(rowb + lane) * 16 + 8 + h]; }
    for (int c = 0; c < NCH; ++c) {
        if (w == 0) {
            float bs = glf;
#pragma unroll
            for (int o = 1; o < 64; o <<= 1) { const float x = __shfl_up(bs, o); if (lane >= o) bs += x; }
            const float a = gli - bs; float pm = a;
#pragma unroll
            for (int o = 1; o < 64; o <<= 1) { const float x = __shfl_up(pm, o); if (lane >= o) pm = fmaxf(pm, x); }
            const float Mt = fmaxf(m_prev, pm), M63 = __shfl(Mt, 63), b63 = __shfl(bs, 63);
            LDSV(float, AS + 4 * lane) = a; LDSV(float, MT + 4 * lane) = Mt; LDSV(float, WI + 4 * lane) = __expf(m_prev - Mt); LDSV(float, EM + 4 * lane) = __expf(-(bs + Mt)); LDSV(float, WS + 4 * lane) = __expf(a - M63);
            if (lane == 0) { LDSV(float, SC) = __expf(m_prev - M63); LDSV(float, SC + 4) = b63 + M63; LDSV(float, SC + 8) = b63; }
        }
        if (!STATE_ONLY) {
#pragma unroll
            for (int i = 0; i < 4; ++i) { LDSV(unsigned, Q + (4 * tg4 + i) * 144 + 4 * dp) = rq[i]; LDSV(unsigned, K + (4 * tg4 + i) * 144 + 4 * dp) = rk[i]; }
        }
        LDSV(v4u, VTE + (2 * lane) * 144 + 16 * w) = (v4u){(rv[0] & 0xffffu) | (rv[1] << 16), (rv[2] & 0xffffu) | (rv[3] << 16), (rv[4] & 0xffffu) | (rv[5] << 16), (rv[6] & 0xffffu) | (rv[7] << 16)};
        LDSV(v4u, VTE + (2 * lane + 1) * 144 + 16 * w) = (v4u){(rv[0] >> 16) | (rv[1] & 0xffff0000u), (rv[2] >> 16) | (rv[3] & 0xffff0000u), (rv[4] >> 16) | (rv[5] & 0xffff0000u), (rv[6] >> 16) | (rv[7] & 0xffff0000u)};
        BAR_LDS();
        { const f32x4 ws = LDSV(f32x4, WS + 16 * tg4);
            LDSV(v2u, KWT + (2 * dp) * 144 + 8 * tg4) = (v2u){pk2(bflo(rk[0]) * ws[0], bflo(rk[1]) * ws[1]), pk2(bflo(rk[2]) * ws[2], bflo(rk[3]) * ws[3])};
            LDSV(v2u, KWT + (2 * dp + 1) * 144 + 8 * tg4) = (v2u){pk2(bfhi(rk[0]) * ws[0], bfhi(rk[1]) * ws[1]), pk2(bfhi(rk[2]) * ws[2], bfhi(rk[3]) * ws[3])}; }
        const float wc = LDSV(float, SC), m_next = LDSV(float, SC + 4); btot += LDSV(float, SC + 8);
        const size_t orow = (rowb + (size_t)c * 64 + tb * 16 + fr) * 1024 + h * 128 + 4 * fq;
        v2u rg[4];
        if (!STATE_ONLY) {
#pragma unroll
            for (int j = 0; j < 4; ++j) rg[j] = *(const v2u*)(Om + orow + (4 * wh + j) * 16);
        }
        if (c + 1 < NCH) { const size_t r1 = rowb + (size_t)(c + 1) * 64;
#pragma unroll
            for (int i = 0; i < 4; ++i) { const size_t e = (r1 + 4 * tg4 + i) * 512 + h * 64 + 2 * dp; if (!STATE_ONLY) rq[i] = *(const unsigned*)(Qm + e); rk[i] = *(const unsigned*)(Km + e); }
#pragma unroll
            for (int i = 0; i < 8; ++i) rv[i] = *(const unsigned*)(Vm + (r1 + 8 * w + i) * 1024 + h * 128 + 2 * lane);
            if (w == 0) { gli = GTg[(r1 + lane) * 16 + h]; glf = GTg[(r1 + lane) * 16 + 8 + h]; }
        }
        BAR_LDS();
        f32x4 num[5];
        if (!STATE_ONLY) {
        { const float Mt = LDSV(float, MT + (tb * 16 + fr) * 4);
#pragma unroll
            for (int j = 0; j < 2; ++j) { const int sb = 2 * wh + j; f32x4 a = (f32x4){0.f, 0.f, 0.f, 0.f};
                if (sb <= tb) {
#pragma unroll
                    for (int kk = 0; kk < 2; ++kk) a = MFMA16(LDSF(K + (sb * 16 + fr) * 144 + kk * 64 + fq * 16), LDSF(Q + (tb * 16 + fr) * 144 + kk * 64 + fq * 16), a);
                    const int t = tb * 16 + fr, s0 = sb * 16 + 4 * fq; const f32x4 as = LDSV(f32x4, AS + s0 * 4);
#pragma unroll
                    for (int r = 0; r < 4; ++r) a[r] = (s0 + r > t) ? 0.f : a[r] * __expf(as[r] - Mt);
                }
                LDSV(v2u, AM + (tb * 16 + fr) * 144 + (sb * 16 + 4 * fq) * 2) = (v2u){pk2(a[0], a[1]), pk2(a[2], a[3])}; } }
        BAR_LDS();
        { bf16x8 bA[2], bQ[2]; const float wi = LDSV(float, WI + (tb * 16 + fr) * 4);
#pragma unroll
            for (int kk = 0; kk < 2; ++kk) { bA[kk] = LDSF(AM + (tb * 16 + fr) * 144 + kk * 64 + fq * 16); bQ[kk] = LDSF(Q + (tb * 16 + fr) * 144 + kk * 64 + fq * 16); }
#pragma unroll
            for (int j = 0; j < 5; ++j) { if (j == 4 && wh != 0) break; const int dvb = j == 4 ? 8 : 4 * wh + j; f32x4 a1 = (f32x4){0.f, 0.f, 0.f, 0.f}, a2 = a1;
#pragma unroll
                for (int kk = 0; kk < 2; ++kk) { a1 = MFMA16(LDSF(VTE + (dvb * 16 + fr) * 144 + kk * 64 + fq * 16), bA[kk], a1); a2 = MFMA16(LDSF(CTE + (dvb * 16 + fr) * 144 + kk * 64 + fq * 16), bQ[kk], a2); }
                num[j] = a1 + a2 * wi; }
            if (wh == 0 && fq == 0) LDSV(float, DEN + (tb * 16 + fr) * 4) = num[4][0]; }
        }
        { bf16x8 aK[2];
#pragma unroll
            for (int kk = 0; kk < 2; ++kk) aK[kk] = LDSF(KWT + (16 * tb + fr) * 144 + kk * 64 + fq * 16);
#pragma unroll
            for (int j = 0; j < 5; ++j) { if (j == 4 && wh != 0) break; const int dvb = j == 4 ? 8 : 4 * wh + j; f32x4 a = cacc[j] * wc;
#pragma unroll
                for (int kk = 0; kk < 2; ++kk) a = MFMA16(aK[kk], LDSF(VTE + (dvb * 16 + fr) * 144 + kk * 64 + fq * 16), a);
                cacc[j] = a; } }
        BAR_LDS();
        if (!STATE_ONLY) {
        { const float dn = fmaxf(fabsf(LDSV(float, DEN + (tb * 16 + fr) * 4)), LDSV(float, EM + (tb * 16 + fr) * 4)); const float inv = 1.0f / dn; float ss = 0.f;
#pragma unroll
            for (int j = 0; j < 4; ++j) { num[j] = num[j] * inv; ss += (num[j][0] * num[j][0] + num[j][1] * num[j][1]) + (num[j][2] * num[j][2] + num[j][3] * num[j][3]); }
            ss += __shfl_xor(ss, 16); ss += __shfl_xor(ss, 32);
            if (fq == 0) LDSV(float, NP + ((tb * 16 + fr) * 2 + wh) * 4) = ss; }
        BAR_LDS();
        { const f32x2 p = LDSV(f32x2, NP + (tb * 16 + fr) * 8); const float rstd = rsqrtf((p.x + p.y) * (1.0f / 128.0f) + 1e-6f);
#pragma unroll
            for (int j = 0; j < 4; ++j) { const f32x4 o = num[j] * rstd * wn[j];
                *(v2u*)(Hb + orow + (4 * wh + j) * 16) = (v2u){pk2(o[0] * bflo(rg[j].x), o[1] * bfhi(rg[j].x)), pk2(o[2] * bflo(rg[j].y), o[3] * bfhi(rg[j].y))}; } }
#pragma unroll
        for (int j = 0; j < 5; ++j) { if (j == 4 && wh != 0) break; const int dvb = j == 4 ? 8 : 4 * wh + j;
            LDSV(v2u, CTE + (dvb * 16 + fr) * 144 + (16 * tb + 4 * fq) * 2) = (v2u){pk2(cacc[j][0], cacc[j][1]), pk2(cacc[j][2], cacc[j][3])}; }
        }
        m_prev = m_next;
    }
    if (STATE_ONLY) {
#pragma unroll
        for (int j = 0; j < 5; ++j) *(f32x4*)(Escr + (size_t)(item0 + g) * 10240 + ((w * 5 + j) * 64 + lane) * 4) = cacc[j];
        if (tid == 0) { Mscr[(item0 + g) * 2] = m_prev; Mscr[(item0 + g) * 2 + 1] = btot; }
    } else if (g == 3) {
        float* co = C_out + (size_t)(b * 8 + h) * 64 * 128;
#pragma unroll
        for (int j = 0; j < 4; ++j)
#pragma unroll
            for (int r = 0; r < 4; ++r) co[(size_t)(16 * tb + 4 * fq + r) * 128 + (4 * wh + j) * 16 + fr] = cacc[j][r];
        if (wh == 0 && fr == 0) {
#pragma unroll
            for (int r = 0; r < 4; ++r) n_out[(size_t)(b * 8 + h) * 64 + 16 * tb + 4 * fq + r] = cacc[4][r]; }
        if (tid == 0) m_out[b * 8 + h] = m_prev;
    }
}
__device__ __forceinline__ void mlstm_sample_item(LAS unsigned char* lds, int b, int h, const bf16* Qm, const bf16* Km, const bf16* Vm, const bf16* Om, const float* GTg, bf16* Hb, const float* onw,
                                                  const float* C_in, const float* n_in, const float* m_in, float* C_out, float* n_out, float* m_out) {
    constexpr int KQ = 0, VS = 4096, SCL = 8192, DENR = 8320, RED = 20480;
    const int tid = threadIdx.x, lane = tid & 63, w = __builtin_amdgcn_readfirstlane(tid >> 6), c4 = tid & 31, dg = tid >> 5;
    const size_t rowb = (size_t)MP + (size_t)b * 8;
    __syncthreads();
    { const int t = tid >> 6, d = tid & 63; const size_t g = (rowb + t) * 512 + h * 64 + d; LDSV(f32x2, KQ + tid * 8) = (f32x2){bf1(Km[g]), bf1(Qm[g])}; }
#pragma unroll
    for (int e = tid; e < 1024; e += 512) { const int t = e >> 7, d = e & 127; LDSV(float, VS + e * 4) = bf1(Vm[(rowb + t) * 1024 + h * 128 + d]); }
    if (tid == 0) { float m = m_in[b * 8 + h];
        for (int t = 0; t < 8; ++t) { const float li = GTg[(rowb + t) * 16 + h], lf = GTg[(rowb + t) * 16 + 8 + h]; const float mn = fmaxf(lf + m, li);
            LDSV(f32x4, SCL + t * 16) = (f32x4){__expf(lf + m - mn), __expf(li - mn), __expf(-mn), 0.f}; m = mn; }
        m_out[b * 8 + h] = m; }
    const size_t cbase = ((size_t)(b * 8 + h) * 64 + 4 * dg) * 128 + 4 * c4;
    f32x4 cc[4], pn[8]; float nn[4], pd[8];
#pragma unroll
    for (int i = 0; i < 4; ++i) { cc[i] = *(const f32x4*)(C_in + cbase + (size_t)i * 128); nn[i] = n_in[(size_t)(b * 8 + h) * 64 + 4 * dg + i]; }
    __syncthreads();
#pragma unroll
    for (int t = 0; t < 8; ++t) { const f32x4 vv = LDSV(f32x4, VS + (t * 128 + 4 * c4) * 4); const f32x4 sc = LDSV(f32x4, SCL + t * 16); f32x4 p = (f32x4){0.f, 0.f, 0.f, 0.f}; float d = 0.f;
#pragma unroll
        for (int i = 0; i < 4; ++i) { const f32x2 kq = LDSV(f32x2, KQ + (t * 64 + 4 * dg + i) * 8); const float ik = sc[1] * kq.x;
            cc[i] = cc[i] * sc[0] + vv * ik; p += cc[i] * kq.y; nn[i] = nn[i] * sc[0] + ik; d += nn[i] * kq.y; }
        pn[t] = p; pd[t] = d; }
#pragma unroll
    for (int t = 0; t < 8; ++t) { LDSV(f32x4, RED + ((dg * 8 + t) * 128 + 4 * c4) * 4) = pn[t]; if (c4 == 0) LDSV(float, DENR + (dg * 8 + t) * 4) = pd[t]; }
#pragma unroll
    for (int i = 0; i < 4; ++i) { *(f32x4*)(C_out + cbase + (size_t)i * 128) = cc[i]; if (c4 == 0) n_out[(size_t)(b * 8 + h) * 64 + 4 * dg + i] = nn[i]; }
    __syncthreads();
    { const int t = w; float o0 = 0.f, o1 = 0.f, dn = 0.f;
#pragma unroll
        for (int g = 0; g < 16; ++g) { const f32x2 x = LDSV(f32x2, RED + ((g * 8 + t) * 128 + 2 * lane) * 4); o0 += x.x; o1 += x.y; dn += LDSV(float, DENR + (g * 8 + t) * 4); }
        const float inv = 1.0f / fmaxf(fabsf(dn), LDSV(f32x4, SCL + t * 16)[2]); o0 *= inv; o1 *= inv;
        const float rstd = rsqrtf(wave_sum(o0 * o0 + o1 * o1) * (1.0f / 128.0f) + 1e-6f);
        const size_t g = (rowb + t) * 1024 + h * 128 + 2 * lane; const unsigned gg = *(const unsigned*)(Om + g);
        *(unsigned*)(Hb + g) = pk2(o0 * rstd * onw[h * 128 + 2 * lane] * bflo(gg), o1 * rstd * onw[h * 128 + 2 * lane + 1] * bfhi(gg)); }
}

__device__ __forceinline__ void small_unit_resid(LAS unsigned char* lds, const bf16* A, const bf16* Bt, int K, int R0, int C0, const float* basep, float* X, bf16* Xb, float* ssq) {
    const int tid = threadIdx.x, lane = tid & 63, w = __builtin_amdgcn_readfirstlane(tid >> 6), fr = lane & 15, fq = lane >> 4;
    const int kw = K >> 3;
    const bf16* ap = A + (size_t)(R0 + fr) * K + w * kw + 8 * fq;
    const bf16* bp = Bt + (size_t)(C0 + fr) * K + w * kw + 8 * fq;
    const size_t rs16 = (size_t)16 * K;
    f32x4 acc[4][4];
#pragma unroll
    for (int i = 0; i < 4; ++i)
#pragma unroll
        for (int j = 0; j < 4; ++j) acc[i][j] = (f32x4){0.f, 0.f, 0.f, 0.f};
    bf16x8 a0[4], b0[4], a1[4], b1[4];
#pragma unroll
    for (int i = 0; i < 4; ++i) { a0[i] = *(const bf16x8*)(ap + i * rs16); b0[i] = *(const bf16x8*)(bp + i * rs16); }
    for (int ks = 0; ks < kw; ks += 64) {
#pragma unroll
        for (int i = 0; i < 4; ++i) { a1[i] = *(const bf16x8*)(ap + i * rs16 + ks + 32); b1[i] = *(const bf16x8*)(bp + i * rs16 + ks + 32); }
#pragma unroll
        for (int i = 0; i < 4; ++i)
#pragma unroll
            for (int j = 0; j < 4; ++j) acc[i][j] = MFMA16(b0[j], a0[i], acc[i][j]);
        if (ks + 64 < kw) {
#pragma unroll
            for (int i = 0; i < 4; ++i) { a0[i] = *(const bf16x8*)(ap + i * rs16 + ks + 64); b0[i] = *(const bf16x8*)(bp + i * rs16 + ks + 64); }
        }
#pragma unroll
        for (int i = 0; i < 4; ++i)
#pragma unroll
            for (int j = 0; j < 4; ++j) acc[i][j] = MFMA16(b1[j], a1[i], acc[i][j]);
    }
    __syncthreads();
#pragma unroll
    for (int i = 0; i < 4; ++i)
#pragma unroll
        for (int j = 0; j < 4; ++j) LDSV(f32x4, w * 16384 + (16 * i + fr) * 256 + (((4 * j + fq) ^ fr) << 4)) = acc[i][j];
    __syncthreads();
    { const int row = tid >> 3, cg = tid & 7; f32x4 x0 = (f32x4){0.f, 0.f, 0.f, 0.f}, x1 = x0;
#pragma unroll
        for (int g = 0; g < 8; ++g) { x0 += LDSV(f32x4, g * 16384 + row * 256 + (((2 * cg) ^ (row & 15)) << 4)); x1 += LDSV(f32x4, g * 16384 + row * 256 + (((2 * cg + 1) ^ (row & 15)) << 4)); }
        const size_t off = (size_t)(R0 + row) * 1024 + C0 + 8 * cg;
        const f32x4 v0 = *(const f32x4*)(basep + off) + x0, v1 = *(const f32x4*)(basep + off + 4) + x1;
        *(f32x4*)(X + off) = v0; *(f32x4*)(X + off + 4) = v1;
        *(v4u*)(Xb + off) = (v4u){pk2(v0[0], v0[1]), pk2(v0[2], v0[3]), pk2(v1[0], v1[1]), pk2(v1[2], v1[3])};
        float sq = (v0[0] * v0[0] + v0[1] * v0[1]) + (v0[2] * v0[2] + v0[3] * v0[3]) + (v1[0] * v1[0] + v1[1] * v1[1]) + (v1[2] * v1[2] + v1[3] * v1[3]);
        sq += __shfl_xor(sq, 1); sq += __shfl_xor(sq, 2); sq += __shfl_xor(sq, 4);
        if (cg == 0) atomicAdd(ssq + R0 + row, sq); }
}
struct Args { const float* in[19]; float* out; unsigned char* ws; int ph_lo, ph_hi, li, pad; };
#ifndef PG8_SP2
#define PG8_SP2 true
#endif
#ifndef PG8_ALIGN
#define PG8_ALIGN true
#endif
__global__ void __launch_bounds__(NWAVES * 64, 2) trunk_fwd(Args args) {
    extern __shared__ __attribute__((aligned(16))) unsigned char lds_raw[];
    LAS unsigned char* lds = (LAS unsigned char*)lds_raw;
    volatile LAS unsigned* MISC = (volatile LAS unsigned*)(lds + MISC_OFF);
    const int tid = threadIdx.x, lane = tid & 63, wave = __builtin_amdgcn_readfirstlane(tid >> 6);
    const int G = gridDim.x, bx = blockIdx.x;
    unsigned char* ws = args.ws; float* out = args.out;
    gu32* ctl = (gu32*)(ws + WS_CTL);
    float* SS = (float*)(ws + WS_SS); float* LB = (float*)(ws + WS_LB);
    bf16* Win0 = (bf16*)(ws + WS_WIN0); bf16* Wout0 = (bf16*)(ws + WS_WOUT0); bf16* Wup0 = (bf16*)(ws + WS_WUP0); bf16* Wdn0 = (bf16*)(ws + WS_WDN0);
    bf16* Win1 = (bf16*)(ws + WS_WIN1); bf16* Wout1 = (bf16*)(ws + WS_WOUT1); bf16* Wup1 = (bf16*)(ws + WS_WUP1); bf16* Wdn1 = (bf16*)(ws + WS_WDN1);
    bf16* Xb = (bf16*)(ws + WS_XB); bf16* U = (bf16*)(ws + WS_ACT);
    bf16* Qb = (bf16*)(ws + WS_Q); bf16* LFb = (bf16*)(ws + WS_LF); bf16* Vb = (bf16*)(ws + WS_V); bf16* Gb = (bf16*)(ws + WS_G);
    bf16* Qm = (bf16*)(ws + WS_QM); bf16* Km = (bf16*)(ws + WS_KM); bf16* Vm = (bf16*)(ws + WS_VM); bf16* Om = (bf16*)(ws + WS_OM); float* GTg = (float*)(ws + WS_GT);
    float* X = out + OUT_Y;
    for (int u = tid; u < (LDS_BYTES - LDSCTL_OFF) / 4; u += NWAVES * 64) ((LAS unsigned*)(lds + LDSCTL_OFF))[u] = 0u;
    __syncthreads();
    XcdBarrier bar; bar.bar = (unsigned*)(ctl + CW_BAR); bar.x = 0; bar.st = nullptr;
    if (MK_N_LAUNCHES == 1) bar = xcd_barrier_post((unsigned*)(ctl + CW_BAR), MISC + 8);
    const int lo = args.ph_lo, hi = args.ph_hi;
#define IN(k) (lo <= (k) && (k) < hi)
#define SEAM(k) do { if (IN(k) && IN((k) + 1)) xcd_barrier(bar); } while (0)

    if (IN(0)) {
        LAS float* scr = (LAS float*)(lds + wave * 16384);
        const int gw = bx * NWAVES + wave, NGW = G * NWAVES;
        constexpr int I0 = 16 * 128, I1 = 16 * 32, I2 = 16 * 128, I3 = 64 * 32, I4 = 16 * 97, I5 = I1, I6 = I2, I7 = I3, NITEMS = I0 + I1 + I2 + I3 + I4 + I5 + I6 + I7;
        for (int it = gw; it < NITEMS; it += NGW) {
            int r = it;
            if (r < I0) { p0_transpose_item(args.in[8], 1024, 4096, args.in[6], Win0, scr, r, lane); continue; } r -= I0;
            if (r < I1) { p0_transpose_item(args.in[11], 1024, 1024, nullptr, Wout0, scr, r, lane); continue; } r -= I1;
            if (r < I2) { p0_transpose_item(args.in[16], 1024, 4096, args.in[7], Wup0, scr, r, lane); continue; } r -= I2;
            if (r < I3) { p0_transpose_item(args.in[17], 4096, 1024, nullptr, Wdn0, scr, r, lane); continue; } r -= I3;
            if (r < I4) { p0_transpose_item(args.in[12], 1024, NIN1, args.in[6] + 1024, Win1, scr, r, lane); continue; } r -= I4;
            if (r < I5) { p0_transpose_item(args.in[15], 1024, 1024, nullptr, Wout1, scr, r, lane); continue; } r -= I5;
            if (r < I6) { p0_transpose_item(args.in[16] + (size_t)1024 * 4096, 1024, 4096, args.in[7] + 1024, Wup1, scr, r, lane); continue; } r -= I6;
            p0_transpose_item(args.in[17] + (size_t)4096 * 1024, 4096, 1024, nullptr, Wdn1, scr, r, lane);
        }
        for (int m = gw; m < MROWS; m += NGW) {
            const float* xr = m < MP ? args.in[0] + (size_t)m * 1024 : args.in[1] + (size_t)(m - MP) * 1024;
            f32x4 v[4]; float s = 0.f;
#pragma unroll
            for (int j = 0; j < 4; ++j) { v[j] = *((const f32x4*)xr + lane + 64 * j); s += (v[j][0] * v[j][0] + v[j][1] * v[j][1]) + (v[j][2] * v[j][2] + v[j][3] * v[j][3]); }
            s = wave_sum(s); if (lane == 0) SS[m] = s;
#pragma unroll
            for (int j = 0; j < 4; ++j) *((v2u*)(Xb + (size_t)m * 1024) + lane + 64 * j) = (v2u){pk2(v[j][0], v[j][1]), pk2(v[j][2], v[j][3])};
        }
        if (bx == 0) for (int d = tid; d < 1024; d += NWAVES * 64) { const float l0 = args.in[9][d], l1 = args.in[9][1024 + d], l2 = args.in[9][2048 + d]; const float mx = fmaxf(l0, fmaxf(l1, l2));
            const float e0 = expf(l0 - mx), e1 = expf(l1 - mx), e2 = expf(l2 - mx); LB[d] = e0 / (e0 + e1 + e2); }
    }
    SEAM(0);
    if (IN(1)) { pg8::Gemm g{Xb, Win0, MP, 4096, 1024}; pg8::StaticOrder S; S.init(MP, 4096, G, bx);
        pg8::EpiHgrnIn E{Qb, LFb, Vb, Gb, SS, LB};
        pg8::gemm_phase_x<pg8::EpiHgrnIn, pg8::StaticOrder>(lds, g, MP, S, E); }
    SEAM(1);
    if (IN(2)) {
        float* Escr = (float*)(ws + WS_XB); float* Dscr = (float*)(ws + WS_XB + 16 * MiB);
        for (int it = bx; it < 192; it += G) hgrn_seg_item<true>(lds, (it / 3) >> 3, (it / 3) & 7, it % 3, Qb, LFb, Vb, Gb, Qb, args.in[10], Escr, Dscr, out + OUT_SP);
        for (int it = bx; it < 768; it += G) hgrn_sample_item(lds, it >> 3, it & 7, Qb, LFb, Vb, Gb, Qb, args.in[10], args.in[2], out + OUT_SS);
        if (G == 256) { if (bx >= 192) for (int it = 768 + (bx - 192) * 4; it < 772 + (bx - 192) * 4; ++it) hgrn_sample_item(lds, it >> 3, it & 7, Qb, LFb, Vb, Gb, Qb, args.in[10], args.in[2], out + OUT_SS); }
        else for (int it = 768 + bx; it < 1024; it += G) hgrn_sample_item(lds, it >> 3, it & 7, Qb, LFb, Vb, Gb, Qb, args.in[10], args.in[2], out + OUT_SS);
    }
    SEAM(2);
    if (IN(3)) {
        float* Escr = (float*)(ws + WS_XB); float* Dscr = (float*)(ws + WS_XB + 16 * MiB);
        for (int it = bx; it < 256; it += G) hgrn_seg_item<false>(lds, it >> 5, (it >> 2) & 7, it & 3, Qb, LFb, Vb, Gb, Qb, args.in[10], Escr, Dscr, out + OUT_SP);
    }
    SEAM(3);
    if (IN(4)) { pg8::Gemm g{Qb, Wout0, MP, 1024, 1024}; pg8::StaticOrder S; S.init(MP, 1024, G, bx);
        pg8::EpiResid<true> E{args.in[0], args.in[1], Xb, SS + MROWS};
        pg8::gemm_phase_x<pg8::EpiResid<true>, pg8::StaticOrder>(lds, g, MP, S, E); }
    SEAM(4);
    if (IN(5)) { pg8::Gemm g{Xb, Wup0, MP, 4096, 1024}; pg8::StaticOrder S; S.init(MP, 4096, G, bx);
        pg8::EpiUp E{U, SS + MROWS};
        pg8::gemm_phase_x<pg8::EpiUp, pg8::StaticOrder>(lds, g, MP, S, E); }
    SEAM(5);
    if (IN(6)) { pg8::Gemm g{U, Wdn0, MP, 1024, 4096}; pg8::StaticOrder S; S.init(MP, 1024, G, bx);
        pg8::EpiResid<false> E{nullptr, nullptr, Xb, SS + 2 * MROWS};
        pg8::gemm_phase_x<pg8::EpiResid<false>, pg8::StaticOrder>(lds, g, MP, S, E); }
    SEAM(6);
    if (IN(7)) { pg8::Gemm g{Xb, Win1, MP, NIN1P, 1024}; pg8::StaticOrder S; S.init(MP, NIN1P, G, bx);
        pg8::EpiMlstmIn E{Qm, Km, Vm, Om, GTg, SS + 2 * MROWS, args.in[13]};
        pg8::gemm_phase_x<pg8::EpiMlstmIn, pg8::StaticOrder>(lds, g, MP, S, E); }
    SEAM(7);
    if (IN(8)) {
        float* Escr = (float*)(ws + WS_GT + 2 * MiB); float* Mscr = (float*)(ws + WS_GT + 14 * MiB);
        for (int it = bx; it < 192; it += G) mlstm_seg_item<true>(lds, (it / 3) >> 3, (it / 3) & 7, it % 3, Qm, Km, Vm, Om, GTg, Vm, args.in[14], Escr, Mscr, out + OUT_CP, out + OUT_NP, out + OUT_MP);
        for (int it = bx; it < 768; it += G) mlstm_sample_item(lds, it >> 3, it & 7, Qm, Km, Vm, Om, GTg, Vm, args.in[14], args.in[3], args.in[4], args.in[5], out + OUT_CS, out + OUT_NS, out + OUT_MS);
        if (G == 256) { if (bx >= 192) for (int it = 768 + (bx - 192) * 4; it < 772 + (bx - 192) * 4; ++it) mlstm_sample_item(lds, it >> 3, it & 7, Qm, Km, Vm, Om, GTg, Vm, args.in[14], args.in[3], args.in[4], args.in[5], out + OUT_CS, out + OUT_NS, out + OUT_MS); }
        else for (int it = 768 + bx; it < 1024; it += G) mlstm_sample_item(lds, it >> 3, it & 7, Qm, Km, Vm, Om, GTg, Vm, args.in[14], args.in[3], args.in[4], args.in[5], out + OUT_CS, out + OUT_NS, out + OUT_MS);
    }
    SEAM(8);
    if (IN(9)) {
        float* Escr = (float*)(ws + WS_GT + 2 * MiB); float* Mscr = (float*)(ws + WS_GT + 14 * MiB);
        for (int it = bx; it < 256; it += G) mlstm_seg_item<false>(lds, it >> 5, (it >> 2) & 7, it & 3, Qm, Km, Vm, Om, GTg, Vm, args.in[14], Escr, Mscr, out + OUT_CP, out + OUT_NP, out + OUT_MP);
    }
    SEAM(9);
    if (IN(10)) { pg8::Gemm g{Vm, Wout1, MP, 1024, 1024}; pg8::StaticOrder S; S.init(MP, 1024, G, bx);
        pg8::EpiResid<false> E{nullptr, nullptr, Xb, SS + 3 * MROWS};
        pg8::gemm_phase_x<pg8::EpiResid<false>, pg8::StaticOrder>(lds, g, MP, S, E); }
    SEAM(10);
    if (IN(11)) { pg8::Gemm g{Xb, Wup1, MP, 4096, 1024}; pg8::StaticOrder S; S.init(MP, 4096, G, bx);
        pg8::EpiUp E{U, SS + 3 * MROWS};
        pg8::gemm_phase_x<pg8::EpiUp, pg8::StaticOrder>(lds, g, MP, S, E); }
    SEAM(11);
    if (IN(12)) { pg8::Gemm g{U, Wdn1, MP, 1024, 4096}; pg8::StaticOrder S; S.init(MP, 1024, G, bx);
        pg8::EpiResid<false> E{nullptr, nullptr, Xb, SS + 4 * MROWS};
        pg8::gemm_phase_x<pg8::EpiResid<false>, pg8::StaticOrder>(lds, g, MP, S, E); }
    SEAM(12);
    if (IN(13)) {
        const int gw = bx * NWAVES + wave, NGW = G * NWAVES; const float* wf = args.in[18];
        f32x4 wv[4];
#pragma unroll
        for (int j = 0; j < 4; ++j) wv[j] = *((const f32x4*)wf + lane + 64 * j);
        for (int m = gw; m < MROWS; m += NGW) { const float rs = rsqrtf(SS[4 * MROWS + m] * (1.0f / 1024.0f) + 1e-6f); f32x4* yr = (f32x4*)(X + (size_t)m * 1024); const v2u* xr = (const v2u*)(Xb + (size_t)m * 1024);
#pragma unroll
            for (int j = 0; j < 4; ++j) { const v2u x = xr[lane + 64 * j]; yr[lane + 64 * j] = (f32x4){bflo(x.x), bfhi(x.x), bflo(x.y), bfhi(x.y)} * rs * wv[j]; } }
    }
#undef IN
#undef SEAM
}

extern "C" void kernel_launch(void* const* d_in, const int* in_sizes, int n_in, void* d_out, int out_size, void* d_ws, size_t ws_size, hipStream_t stream) {
    static int grid = 0;
    if (grid == 0) {
        if (n_in != 19 || out_size != (int)OUT_END || ws_size < WS_END) { fprintf(stderr, "kernel_launch: unexpected shapes: n_in %d out %d ws %zu\n", n_in, out_size, ws_size); grid = -1; return; }
        int dev = 0, cus = 0, per_cu = 0;
        if (hipGetDevice(&dev) != hipSuccess || hipDeviceGetAttribute(&cus, hipDeviceAttributeMultiprocessorCount, dev) != hipSuccess) { grid = -1; return; }
        if (hipFuncSetAttribute((const void*)trunk_fwd, hipFuncAttributeMaxDynamicSharedMemorySize, LDS_BYTES) != hipSuccess) { fprintf(stderr, "kernel_launch: hipFuncSetAttribute failed\n"); grid = -1; return; }
        if (hipOccupancyMaxActiveBlocksPerMultiprocessor(&per_cu, (const void*)trunk_fwd, NWAVES * 64, LDS_BYTES) != hipSuccess || per_cu < 1) { fprintf(stderr, "kernel_launch: occupancy query says %d blocks per CU\n", per_cu); grid = -1; return; }
        (void)hipGetLastError();
        grid = cus;
    }
    if (grid < 0) return;
    (void)hipMemsetAsync((char*)d_ws + WS_CTL, 0, CTL_ZERO_BYTES, stream);
    Args a{};
    for (int i = 0; i < 19; ++i) a.in[i] = (const float*)d_in[i];
    a.out = (float*)d_out; a.ws = (unsigned char*)d_ws;
#if MK_N_LAUNCHES == 1
    a.ph_lo = 0; a.ph_hi = N_PHASES; a.li = 0;
    hipLaunchKernelGGL(trunk_fwd, dim3(grid), dim3(NWAVES * 64), LDS_BYTES, stream, a);
#else
    for (int li = 0; li < N_PHASES; ++li) { a.ph_lo = li; a.ph_hi = li + 1; a.li = li; hipLaunchKernelGGL(trunk_fwd, dim3(grid), dim3(NWAVES * 64), LDS_BYTES, stream, a); }
#endif
}
```

```cpp
#include <hip/hip_runtime.h>
#include <cstdio>
#include <cstdint>
#include <cmath>
namespace pg8 {
#define PG8_LAS __attribute__((address_space(3)))
typedef unsigned short bf16_t;
typedef short bf16x8 __attribute__((ext_vector_type(8)));
typedef float f32x4 __attribute__((ext_vector_type(4)));
typedef unsigned u32x4 __attribute__((ext_vector_type(4)));
constexpr int BM = 256, BK = 64, HALF = 128, HTB = HALF * BK * 2  , STAGE_BYTES = 8 * HTB, NXCD = 8, WGM = 8;

__host__ __device__ __forceinline__ int lds_byte(int r, int c) { const int st = (r >> 4) * 2 + (c >> 5), rr = r & 15, cc = c & 31, ob = rr * 64 + cc * 2; return st * 1024 + (ob ^ (((ob >> 9) & 1) << 5)); }
__host__ __device__ __forceinline__ void stage_rc(int b, int& R, int& C) { const int st = b / 1024, sb = b % 1024, swz = sb ^ (((sb >> 9) & 1) << 5); R = (st >> 1) * 16 + swz / 64; C = (st & 1) * 32 + (swz % 64) / 2; }
__host__ __device__ __forceinline__ int perm32(int rho) { const int n = rho >> 4, i = rho & 15; return 8 * (i >> 2) + 4 * n + (i & 3); }

struct Unit { int pm, pn; };
struct Gemm { const bf16_t* A; const bf16_t* Bt; int M, N, K; };

struct StaticOrder {
    int nM, nN, nwg, G, c;
    __host__ __device__ void init(int M, int N, int G_, int c_) { nM = M / BM; nN = N / BM; nwg = nM * nN; G = G_; c = c_; }
    __host__ __device__ bool next(int i, Unit& u) const {
        const long L = (long)i * G + c; if (L >= nwg) return false;
        int wgid = (int)L; { const int q = nwg / NXCD, r = nwg % NXCD, xcd = wgid % NXCD, off = wgid / NXCD; wgid = (xcd < r ? xcd * (q + 1) : r * (q + 1) + (xcd - r) * q) + off; }
        const int nig = WGM * nN, gid = wgid / nig, fm = gid * WGM, gsz = (nM - fm) < WGM ? (nM - fm) : WGM;
        u.pm = fm + ((wgid % nig) % gsz); u.pn = (wgid % nig) / gsz; return true;
    }
    __device__ __forceinline__ void a_ready(const Unit&) const {}
    __device__ __forceinline__ void done(const Unit&) const {}
};

typedef unsigned u32x2 __attribute__((ext_vector_type(2)));
__device__ __forceinline__ unsigned f2bf_(float f) { unsigned u = __builtin_bit_cast(unsigned, f); return (u + 0x7fffu + ((u >> 16) & 1u)) >> 16; }
typedef float f32x2c_ __attribute__((ext_vector_type(2))); typedef __bf16 bf16x2c_ __attribute__((ext_vector_type(2)));
__device__ __forceinline__ unsigned pkbf(float lo, float hi) { f32x2c_ v = {lo, hi}; bf16x2c_ b = __builtin_convertvector(v, bf16x2c_); return __builtin_bit_cast(unsigned, b); }
__device__ __forceinline__ unsigned pkh(float lo, float hi) { const _Float16 a = (_Float16)lo, b = (_Float16)hi; return (unsigned)__builtin_bit_cast(unsigned short, a) | ((unsigned)__builtin_bit_cast(unsigned short, b) << 16); }
__device__ __forceinline__ float sigm(float x) { return __builtin_amdgcn_rcpf(1.0f + __expf(-x)); }
constexpr float NORM_EPS = 1e-6f;
constexpr int XROW0 = 16384;

struct EpiHgrnIn {
    static constexpr bool PERM = true, AFTER_DRAIN = false;
    bf16_t* Q; bf16_t* LF; bf16_t* V; bf16_t* G; const float* ss; const float* lb;
    template <int GRP> __device__ __forceinline__ void run(const f32x4 (&acc)[2][2][4][2], const Unit& u, int wr, int wc, int fr, int fq) const {
        const int row0 = u.pm * BM + wr * 64 + fr, gc0 = (u.pn & 3) * BM + wc * 32 + 8 * fq;
        bf16_t* dst = GRP == 0 ? Q : GRP == 1 ? LF : GRP == 2 ? V : G;
        f32x4 lbv[2][2];
        if (GRP == 1) {
#pragma unroll
            for (int bj = 0; bj < 2; ++bj)
#pragma unroll
                for (int n = 0; n < 2; ++n) lbv[bj][n] = *(const f32x4*)(lb + gc0 + bj * HALF + 4 * n);
        }
#pragma unroll
        for (int ai = 0; ai < 2; ++ai)
#pragma unroll
            for (int m = 0; m < 4; ++m) { const int row = row0 + ai * HALF + m * 16; const float rs = rsqrtf(ss[row] * (1.0f / 1024.0f) + NORM_EPS);
                bf16_t* rowp = dst + (size_t)row * 1024 + gc0;
#pragma unroll
                for (int bj = 0; bj < 2; ++bj) { float x[8];
#pragma unroll
                    for (int n = 0; n < 2; ++n)
#pragma unroll
                        for (int j = 0; j < 4; ++j) x[4 * n + j] = acc[ai][bj][m][n][j] * rs;
                    u32x4 w;
                    if (GRP == 0 || GRP == 3) {
#pragma unroll
                        for (int j = 0; j < 8; ++j) x[j] = x[j] * sigm(x[j]);
                    }
                    if (GRP == 1) {
#pragma unroll
                        for (int j = 0; j < 8; ++j) { const float l = lbv[bj][j >> 2][j & 3]; x[j] = __logf(l + (1.0f - l) * sigm(x[j])); }
                        w.x = pkh(x[0], x[1]); w.y = pkh(x[2], x[3]); w.z = pkh(x[4], x[5]); w.w = pkh(x[6], x[7]);
                    } else { w.x = pkbf(x[0], x[1]); w.y = pkbf(x[2], x[3]); w.z = pkbf(x[4], x[5]); w.w = pkbf(x[6], x[7]); }
                    *(u32x4*)(rowp + bj * HALF) = w; } }
    }
    __device__ __forceinline__ void operator()(const f32x4 (&acc)[2][2][4][2], const Unit& u, int wr, int wc, int fr, int fq) const {
        const int grp = u.pn >> 2;
        if (grp == 0) run<0>(acc, u, wr, wc, fr, fq); else if (grp == 1) run<1>(acc, u, wr, wc, fr, fq); else if (grp == 2) run<2>(acc, u, wr, wc, fr, fq); else run<3>(acc, u, wr, wc, fr, fq);
    }
    __device__ __forceinline__ void extra(const f32x4 (&accE)[2], const Unit& u, int wr, int wc, int fr, int fq) const {
        const int grp = u.pn >> 2, row = XROW0 + 16 * u.pm + fr, gc0 = (u.pn & 3) * BM + wr * HALF + wc * 32 + 8 * fq;
        const float rs = rsqrtf(ss[row] * (1.0f / 1024.0f) + NORM_EPS);
        float x[8];
#pragma unroll
        for (int j = 0; j < 8; ++j) x[j] = accE[j >> 2][j & 3] * rs;
        bf16_t* dst = grp == 0 ? Q : grp == 1 ? LF : grp == 2 ? V : G;
        u32x4 w;
        if (grp == 0 || grp == 3) {
#pragma unroll
            for (int j = 0; j < 8; ++j) x[j] = x[j] * sigm(x[j]);
        }
        if (grp == 1) {
#pragma unroll
            for (int j = 0; j < 8; ++j) { const float l = lb[gc0 + j]; x[j] = __logf(l + (1.0f - l) * sigm(x[j])); }
            w.x = pkh(x[0], x[1]); w.y = pkh(x[2], x[3]); w.z = pkh(x[4], x[5]); w.w = pkh(x[6], x[7]);
        } else { w.x = pkbf(x[0], x[1]); w.y = pkbf(x[2], x[3]); w.z = pkbf(x[4], x[5]); w.w = pkbf(x[6], x[7]); }
        *(u32x4*)(dst + (size_t)row * 1024 + gc0) = w;
    }
};

struct EpiMlstmIn {
    static constexpr bool PERM = true, AFTER_DRAIN = false;
    bf16_t* Qm; bf16_t* Km; bf16_t* Vm; bf16_t* Om; float* GT; const float* ss; const float* gb;
    template <int GRP> __device__ __forceinline__ void run(const f32x4 (&acc)[2][2][4][2], const Unit& u, int wr, int wc, int fr, int fq) const {
        const int row0 = u.pm * BM + wr * 64 + fr;
        const int ld = GRP < 2 ? 512 : 1024;
        const int tb = GRP == 0 ? 0 : GRP == 1 ? 2 : GRP == 2 ? 4 : 8;
        const int gc0 = (u.pn - tb) * BM + wc * 32 + 8 * fq;
        bf16_t* dst = GRP == 0 ? Qm : GRP == 1 ? Km : GRP == 2 ? Vm : Om;
#pragma unroll
        for (int ai = 0; ai < 2; ++ai)
#pragma unroll
            for (int m = 0; m < 4; ++m) { const int row = row0 + ai * HALF + m * 16; const float rs = rsqrtf(ss[row] * (1.0f / 1024.0f) + NORM_EPS);
                bf16_t* rowp = dst + (size_t)row * ld + gc0;
#pragma unroll
                for (int bj = 0; bj < 2; ++bj) { float x[8];
#pragma unroll
                    for (int n = 0; n < 2; ++n)
#pragma unroll
                        for (int j = 0; j < 4; ++j) x[4 * n + j] = acc[ai][bj][m][n][j] * rs;
                    if (GRP == 0) {
#pragma unroll
                        for (int j = 0; j < 8; ++j) x[j] *= 0.125f;
                    }
                    if (GRP == 3) {
#pragma unroll
                        for (int j = 0; j < 8; ++j) x[j] = sigm(x[j]);
                    }
                    u32x4 w; w.x = pkbf(x[0], x[1]); w.y = pkbf(x[2], x[3]); w.z = pkbf(x[4], x[5]); w.w = pkbf(x[6], x[7]);
                    *(u32x4*)(rowp + bj * HALF) = w; } }
    }
    __device__ __forceinline__ void gates(const f32x4 (&acc)[2][2][4][2], const Unit& u, int wr, int wc, int fr, int fq) const {
        if (wc != 0 || fq >= 2) return;
        const int row0 = u.pm * BM + wr * 64 + fr;
#pragma unroll
        for (int ai = 0; ai < 2; ++ai)
#pragma unroll
            for (int m = 0; m < 4; ++m) { const int row = row0 + ai * HALF + m * 16; const float rs = rsqrtf(ss[row] * (1.0f / 1024.0f) + NORM_EPS);
                float x[8];
#pragma unroll
                for (int n = 0; n < 2; ++n)
#pragma unroll
                    for (int j = 0; j < 4; ++j) x[4 * n + j] = acc[ai][0][m][n][j] * rs;
#pragma unroll
                for (int j = 0; j < 8; ++j) { const float y2 = (x[j] + gb[8 * fq + j]) * (2.0f / 15.0f); const float z = 15.0f - 30.0f * __builtin_amdgcn_rcpf(__expf(y2) + 1.0f); x[j] = fq == 0 ? z : -__logf(1.0f + __expf(-z)); }
                float* o = GT + (size_t)row * 16 + 8 * fq;
                *(f32x4*)o = (f32x4){x[0], x[1], x[2], x[3]}; *(f32x4*)(o + 4) = (f32x4){x[4], x[5], x[6], x[7]}; }
    }
    __device__ __forceinline__ void operator()(const f32x4 (&acc)[2][2][4][2], const Unit& u, int wr, int wc, int fr, int fq) const {
        const int pn = u.pn;
        if (pn < 2) run<0>(acc, u, wr, wc, fr, fq); else if (pn < 4) run<1>(acc, u, wr, wc, fr, fq); else if (pn < 8) run<2>(acc, u, wr, wc, fr, fq); else if (pn < 12) run<3>(acc, u, wr, wc, fr, fq); else gates(acc, u, wr, wc, fr, fq);
    }
    __device__ __forceinline__ void extra(const f32x4 (&accE)[2], const Unit& u, int wr, int wc, int fr, int fq) const {
        const int pn = u.pn, row = XROW0 + 16 * u.pm + fr;
        const float rs = rsqrtf(ss[row] * (1.0f / 1024.0f) + NORM_EPS);
        float x[8];
#pragma unroll
        for (int j = 0; j < 8; ++j) x[j] = accE[j >> 2][j & 3] * rs;
        if (pn == 12) {
            if (wr != 0 || wc != 0 || fq >= 2) return;
#pragma unroll
            for (int j = 0; j < 8; ++j) { const float y2 = (x[j] + gb[8 * fq + j]) * (2.0f / 15.0f); const float z = 15.0f - 30.0f * __builtin_amdgcn_rcpf(__expf(y2) + 1.0f); x[j] = fq == 0 ? z : -__logf(1.0f + __expf(-z)); }
            float* o = GT + (size_t)row * 16 + 8 * fq;
            *(f32x4*)o = (f32x4){x[0], x[1], x[2], x[3]}; *(f32x4*)(o + 4) = (f32x4){x[4], x[5], x[6], x[7]};
            return;
        }
        const int grp = pn < 2 ? 0 : pn < 4 ? 1 : pn < 8 ? 2 : 3, tb = grp == 0 ? 0 : grp == 1 ? 2 : grp == 2 ? 4 : 8, ld = grp < 2 ? 512 : 1024;
        const int gc0 = (pn - tb) * BM + wr * HALF + wc * 32 + 8 * fq;
        bf16_t* dst = grp == 0 ? Qm : grp == 1 ? Km : grp == 2 ? Vm : Om;
        if (grp == 0) {
#pragma unroll
            for (int j = 0; j < 8; ++j) x[j] *= 0.125f;
        }
        if (grp == 3) {
#pragma unroll
            for (int j = 0; j < 8; ++j) x[j] = sigm(x[j]);
        }
        u32x4 w; w.x = pkbf(x[0], x[1]); w.y = pkbf(x[2], x[3]); w.z = pkbf(x[4], x[5]); w.w = pkbf(x[6], x[7]);
        *(u32x4*)(dst + (size_t)row * ld + gc0) = w;
    }
};

struct EpiUp {
    static constexpr bool PERM = true, AFTER_DRAIN = false;
    bf16_t* U; const float* ss;
    __device__ __forceinline__ void operator()(const f32x4 (&acc)[2][2][4][2], const Unit& u, int wr, int wc, int fr, int fq) const {
        const int row0 = u.pm * BM + wr * 64 + fr, c0 = u.pn * BM + wc * 32 + 8 * fq;
#pragma unroll
        for (int ai = 0; ai < 2; ++ai)
#pragma unroll
            for (int m = 0; m < 4; ++m) { const int row = row0 + ai * HALF + m * 16; const float rs = rsqrtf(ss[row] * (1.0f / 1024.0f) + NORM_EPS);
                bf16_t* rowp = U + (size_t)row * 4096 + c0;
#pragma unroll
                for (int bj = 0; bj < 2; ++bj) { float x[8];
#pragma unroll
                    for (int n = 0; n < 2; ++n)
#pragma unroll
                        for (int j = 0; j < 4; ++j) { const float a = fmaxf(acc[ai][bj][m][n][j] * rs, 0.0f); x[4 * n + j] = a * a; }
                    u32x4 w; w.x = pkbf(x[0], x[1]); w.y = pkbf(x[2], x[3]); w.z = pkbf(x[4], x[5]); w.w = pkbf(x[6], x[7]);
                    *(u32x4*)(rowp + bj * HALF) = w; } }
    }
    __device__ __forceinline__ void extra(const f32x4 (&accE)[2], const Unit& u, int wr, int wc, int fr, int fq) const {
        const int row = XROW0 + 16 * u.pm + fr, c0 = u.pn * BM + wr * HALF + wc * 32 + 8 * fq;
        const float rs = rsqrtf(ss[row] * (1.0f / 1024.0f) + NORM_EPS);
        float x[8];
#pragma unroll
        for (int j = 0; j < 8; ++j) { const float a = fmaxf(accE[j >> 2][j & 3] * rs, 0.0f); x[j] = a * a; }
        u32x4 w; w.x = pkbf(x[0], x[1]); w.y = pkbf(x[2], x[3]); w.z = pkbf(x[4], x[5]); w.w = pkbf(x[6], x[7]);
        *(u32x4*)(U + (size_t)row * 4096 + c0) = w;
    }
};

struct EpiDummy {
    static constexpr bool PERM = true, AFTER_DRAIN = false;
    bf16_t* O;
    __device__ __forceinline__ void operator()(const f32x4 (&acc)[2][2][4][2], const Unit& u, int wr, int wc, int fr, int fq) const {
        const int row0 = u.pm * BM + wr * 64 + fr, c0 = u.pn * BM + wc * 32 + 8 * fq;
#pragma unroll
        for (int ai = 0; ai < 2; ++ai)
#pragma unroll
            for (int m = 0; m < 4; ++m) { bf16_t* rowp = O + (size_t)(row0 + ai * HALF + m * 16) * 1024 + c0;
#pragma unroll
                for (int bj = 0; bj < 2; ++bj) { u32x4 w; w.x = pkbf(acc[ai][bj][m][0][0], acc[ai][bj][m][0][1]); w.y = pkbf(acc[ai][bj][m][0][2], acc[ai][bj][m][0][3]); w.z = pkbf(acc[ai][bj][m][1][0], acc[ai][bj][m][1][1]); w.w = pkbf(acc[ai][bj][m][1][2], acc[ai][bj][m][1][3]);
                    *(u32x4*)(rowp + bj * HALF) = w; } }
    }
    __device__ __forceinline__ void extra(const f32x4 (&accE)[2], const Unit& u, int wr, int wc, int fr, int fq) const {
        const int row = XROW0 + 16 * u.pm + fr, c0 = u.pn * BM + wr * HALF + wc * 32 + 8 * fq;
        u32x4 w; w.x = pkbf(accE[0][0], accE[0][1]); w.y = pkbf(accE[0][2], accE[0][3]); w.z = pkbf(accE[1][0], accE[1][1]); w.w = pkbf(accE[1][2], accE[1][3]);
        *(u32x4*)(O + (size_t)row * 1024 + c0) = w;
    }
};
template <bool BASE_F32> struct EpiResid {
    static constexpr bool PERM = true, AFTER_DRAIN = false;
    const float* base0; const float* base1; bf16_t* Xb; float* ssq;
    __device__ __forceinline__ void row8(const float* brow, size_t off, const f32x4& a0, const f32x4& a1, float& s) const {
        float v[8];
        if (BASE_F32) { const f32x4 b0 = *(const f32x4*)(brow + off), b1 = *(const f32x4*)(brow + off + 4);
#pragma unroll
            for (int j = 0; j < 4; ++j) { v[j] = b0[j] + a0[j]; v[4 + j] = b1[j] + a1[j]; } }
        else { const u32x4 b = *(const u32x4*)(Xb + off);
#pragma unroll
            for (int j = 0; j < 4; ++j) { v[j] = __builtin_bit_cast(float, (j & 1) ? (b[j >> 1] & 0xffff0000u) : (b[j >> 1] << 16)) + a0[j]; v[4 + j] = __builtin_bit_cast(float, (j & 1) ? (b[2 + (j >> 1)] & 0xffff0000u) : (b[2 + (j >> 1)] << 16)) + a1[j]; } }
        u32x4 w; w.x = pkbf(v[0], v[1]); w.y = pkbf(v[2], v[3]); w.z = pkbf(v[4], v[5]); w.w = pkbf(v[6], v[7]);
        *(u32x4*)(Xb + off) = w;
#pragma unroll
        for (int j = 0; j < 8; ++j) s += v[j] * v[j];
    }
    __device__ __forceinline__ void operator()(const f32x4 (&acc)[2][2][4][2], const Unit& u, int wr, int wc, int fr, int fq) const {
        const int row0 = u.pm * BM + wr * 64 + fr, c0 = u.pn * BM + wc * 32 + 8 * fq;
#pragma unroll
        for (int ai = 0; ai < 2; ++ai)
#pragma unroll
            for (int m = 0; m < 4; ++m) { const int row = row0 + ai * HALF + m * 16; const size_t off = (size_t)row * 1024 + c0; float s = 0.f;
#pragma unroll
                for (int bj = 0; bj < 2; ++bj) row8(base0, off + bj * HALF, acc[ai][bj][m][0], acc[ai][bj][m][1], s);
                s += __shfl_xor(s, 16); s += __shfl_xor(s, 32);
                if (fq == 0) atomicAdd(ssq + row, s); }
    }
    __device__ __forceinline__ void extra(const f32x4 (&accE)[2], const Unit& u, int wr, int wc, int fr, int fq) const {
        const int row = XROW0 + 16 * u.pm + fr, c0 = u.pn * BM + wr * HALF + wc * 32 + 8 * fq;
        float s = 0.f; row8(base1 - (size_t)XROW0 * 1024, (size_t)row * 1024 + c0, accE[0], accE[1], s);
        s += __shfl_xor(s, 16); s += __shfl_xor(s, 32);
        if (fq == 0) atomicAdd(ssq + row, s);
    }
};
template <class Epi, class Sched, bool ALIGN_EPI = false, bool SP2 = false>
__device__ __forceinline__ void gemm_phase(PG8_LAS unsigned char* lds, const Gemm g, const Sched& S, const Epi& E) {
    const int tid = threadIdx.x, wid = __builtin_amdgcn_readfirstlane(tid >> 6), lane = tid & 63, wr = wid >> 2, wc = wid & 3, fr = lane & 15, fq = lane >> 4;
    const int K = g.K, nt = K / BK;
    unsigned voffA[2], voffB[2];
#pragma unroll
    for (int i = 0; i < 2; ++i) { int R, C; stage_rc(tid * 16 + i * 8192, R, C); const int Rb = Epi::PERM ? ((R & ~31) + perm32(R & 31)) : R;
        voffA[i] = (unsigned)(R * K + C) * 2u; voffB[i] = (unsigned)(Rb * K + C) * 2u; }
    const size_t kstep = (size_t)(BK * 2);
    const size_t hstep = (size_t)HALF * K * 2;
    const size_t tstep = 2 * hstep;
    const unsigned ldsw = (unsigned)wid * 1024u;
    const int aoff = lds_byte(wr * 64 + fr, fq * 8), boff = lds_byte(wc * 32 + fr, fq * 8);
#define PG8_SA(b, h) (((b) * 2 + (h)) * HTB)
#define PG8_SB(b, h) ((4 + (b) * 2 + (h)) * HTB)
#define PG8_STAGE(bufoff, gbase, voff) do { _Pragma("unroll") for (int _i = 0; _i < 2; ++_i) \
        __builtin_amdgcn_global_load_lds((const unsigned*)((const char*)(gbase) + (voff)[_i]), (PG8_LAS unsigned*)(lds + (bufoff) + ldsw + _i * 8192), 16, 0, 0); } while (0)
#define PG8_LDA(dst, b, h) do { _Pragma("unroll") for (int m = 0; m < 4; ++m) _Pragma("unroll") for (int k = 0; k < 2; ++k) dst[m][k] = *(const PG8_LAS bf16x8*)(lds + PG8_SA(b, h) + aoff + m * 2048 + k * 1024); } while (0)
#define PG8_LDB(dst, b, h) do { _Pragma("unroll") for (int n = 0; n < 2; ++n) _Pragma("unroll") for (int k = 0; k < 2; ++k) dst[n][k] = *(const PG8_LAS bf16x8*)(lds + PG8_SB(b, h) + boff + n * 2048 + k * 1024); } while (0)
#define PG8_MMA(ai, bj, At, Bt) do { __builtin_amdgcn_s_setprio(1); _Pragma("unroll") for (int m = 0; m < 4; ++m) _Pragma("unroll") for (int n = 0; n < 2; ++n) _Pragma("unroll") for (int k = 0; k < 2; ++k) \
        acc[ai][bj][m][n] = __builtin_amdgcn_mfma_f32_16x16x32_bf16(Bt[n][k], At[m][k], acc[ai][bj][m][n], 0, 0, 0); __builtin_amdgcn_s_setprio(0); } while (0)
#define PG8_WAIT_V(n) asm volatile("s_waitcnt vmcnt(" #n ")" ::: "memory")
#define PG8_WAIT_L(n) asm volatile("s_waitcnt lgkmcnt(" #n ")" ::: "memory")
#define PG8_BAR __builtin_amdgcn_s_barrier()
#define PG8_SCHED __builtin_amdgcn_sched_barrier(0)
    Unit cur, nxt; int ui = 0;
    if (!S.next(0, cur)) return;
    f32x4 acc[2][2][4][2];
#pragma unroll
    for (int a = 0; a < 2; ++a)
#pragma unroll
        for (int b = 0; b < 2; ++b)
#pragma unroll
            for (int m = 0; m < 4; ++m)
#pragma unroll
                for (int n = 0; n < 2; ++n) acc[a][b][m][n] = (f32x4){0.f, 0.f, 0.f, 0.f};
    bf16x8 At[4][2], B0[2][2], B1[2][2];
    const char* cA = (const char*)g.A + (size_t)cur.pm * tstep; const char* cB = (const char*)g.Bt + (size_t)cur.pn * tstep;
    S.a_ready(cur);
    if constexpr (SP2) {
        PG8_STAGE(PG8_SB(0, 0), cB, voffB); PG8_STAGE(PG8_SB(0, 1), cB + hstep, voffB); PG8_STAGE(PG8_SA(0, 0), cA, voffA); PG8_STAGE(PG8_SA(0, 1), cA + hstep, voffA);
        if (wr == 1) PG8_BAR;
        PG8_WAIT_V(2); PG8_BAR;
        PG8_STAGE(PG8_SB(1, 0), cB + kstep, voffB); PG8_STAGE(PG8_SA(1, 0), cA + kstep, voffA); PG8_STAGE(PG8_SB(1, 1), cB + hstep + kstep, voffB);
        PG8_WAIT_V(6); PG8_BAR;
    } else {
        PG8_STAGE(PG8_SB(0, 0), cB, voffB); PG8_STAGE(PG8_SA(0, 0), cA, voffA); PG8_STAGE(PG8_SB(0, 1), cB + hstep, voffB); PG8_STAGE(PG8_SA(0, 1), cA + hstep, voffA);
        if (wr == 1) PG8_BAR;
        PG8_WAIT_V(4); PG8_BAR;
        PG8_STAGE(PG8_SB(1, 0), cB + kstep, voffB); PG8_STAGE(PG8_SA(1, 0), cA + kstep, voffA); PG8_STAGE(PG8_SB(1, 1), cB + hstep + kstep, voffB);
        PG8_WAIT_V(6); PG8_BAR;
    }
    for (;;) {
        const bool has_next = S.next(ui + 1, nxt);
        const char* nA = has_next ? (const char*)g.A + (size_t)nxt.pm * tstep : cA; const char* nB = has_next ? (const char*)g.Bt + (size_t)nxt.pn * tstep : cB;
        for (int t = 0; t < nt; t += 2) {
            const bool last = (t == nt - 2);
            const char* a1 = cA + (size_t)(t + 1) * kstep;
            const char* a2 = last ? nA : cA + (size_t)(t + 2) * kstep; const char* b2 = last ? nB : cB + (size_t)(t + 2) * kstep;
            const char* a3 = a2 + kstep; const char* b3 = b2 + kstep;
            if (last && has_next) S.a_ready(nxt);
            if constexpr (SP2) {
            PG8_LDB(B0, 0, 0); PG8_LDB(B1, 0, 1); PG8_SCHED; PG8_LDA(At, 0, 0); PG8_STAGE(PG8_SA(1, 1), a1 + hstep, voffA);
            PG8_WAIT_V(8); PG8_WAIT_L(0); PG8_BAR; PG8_MMA(0, 0, At, B0); PG8_MMA(0, 1, At, B1); PG8_BAR; PG8_SCHED;
            PG8_LDA(At, 0, 1); PG8_STAGE(PG8_SB(0, 0), b2, voffB); PG8_STAGE(PG8_SB(0, 1), b2 + hstep, voffB); PG8_STAGE(PG8_SA(0, 0), a2, voffA);
            PG8_WAIT_V(8); PG8_WAIT_L(0); PG8_BAR; PG8_MMA(1, 0, At, B0); PG8_MMA(1, 1, At, B1); PG8_BAR; PG8_SCHED;
            PG8_LDB(B0, 1, 0); PG8_LDB(B1, 1, 1); PG8_SCHED; PG8_LDA(At, 1, 0); PG8_STAGE(PG8_SA(0, 1), a2 + hstep, voffA);
            PG8_WAIT_V(8); PG8_WAIT_L(0); PG8_BAR; PG8_MMA(0, 0, At, B0); PG8_MMA(0, 1, At, B1); PG8_BAR; PG8_SCHED;
            PG8_LDA(At, 1, 1); PG8_STAGE(PG8_SB(1, 0), b3, voffB); PG8_STAGE(PG8_SB(1, 1), b3 + hstep, voffB); PG8_STAGE(PG8_SA(1, 0), a3, voffA);
            PG8_WAIT_V(8); PG8_WAIT_L(0); PG8_BAR; PG8_MMA(1, 0, At, B0); PG8_MMA(1, 1, At, B1); PG8_BAR; PG8_SCHED;
            } else {
            PG8_LDB(B0, 0, 0); PG8_SCHED; PG8_LDA(At, 0, 0); PG8_STAGE(PG8_SA(1, 1), a1 + hstep, voffA);
            PG8_WAIT_L(8); PG8_BAR; PG8_WAIT_L(0); PG8_MMA(0, 0, At, B0); PG8_BAR; PG8_SCHED;
            PG8_LDB(B1, 0, 1); PG8_STAGE(PG8_SB(0, 0), b2, voffB);
            PG8_BAR; PG8_WAIT_L(0); PG8_MMA(0, 1, At, B1); PG8_BAR;
            PG8_LDA(At, 0, 1); PG8_STAGE(PG8_SA(0, 0), a2, voffA);
            PG8_BAR; PG8_WAIT_L(0); PG8_MMA(1, 0, At, B0); PG8_BAR; PG8_SCHED;
            PG8_STAGE(PG8_SB(0, 1), b2 + hstep, voffB);
            PG8_WAIT_V(6); PG8_BAR; PG8_MMA(1, 1, At, B1); PG8_BAR;
            PG8_LDB(B0, 1, 0); PG8_SCHED; PG8_LDA(At, 1, 0); PG8_STAGE(PG8_SA(0, 1), a2 + hstep, voffA);
            PG8_WAIT_L(8); PG8_BAR; PG8_WAIT_L(0); PG8_MMA(0, 0, At, B0); PG8_BAR; PG8_SCHED;
            PG8_LDB(B1, 1, 1); PG8_STAGE(PG8_SB(1, 0), b3, voffB);
            PG8_BAR; PG8_WAIT_L(0); PG8_MMA(0, 1, At, B1); PG8_BAR;
            PG8_LDA(At, 1, 1); PG8_STAGE(PG8_SA(1, 0), a3, voffA);
            PG8_BAR; PG8_WAIT_L(0); PG8_MMA(1, 0, At, B0); PG8_BAR; PG8_SCHED;
            PG8_STAGE(PG8_SB(1, 1), b3 + hstep, voffB);
            PG8_WAIT_V(6); PG8_BAR; PG8_MMA(1, 1, At, B1); PG8_BAR;
            }
        }
        if constexpr (ALIGN_EPI) { if (wr == 0) PG8_BAR; }
        if constexpr (!Epi::AFTER_DRAIN) { E(acc, cur, wr, wc, fr, fq); S.done(cur); }
        if (!has_next) break;
#pragma unroll
        for (int a = 0; a < 2; ++a)
#pragma unroll
            for (int b = 0; b < 2; ++b)
#pragma unroll
                for (int m = 0; m < 4; ++m)
#pragma unroll
                    for (int n = 0; n < 2; ++n) acc[a][b][m][n] = (f32x4){0.f, 0.f, 0.f, 0.f};
        cur = nxt; cA = nA; cB = nB; ++ui;
        if constexpr (ALIGN_EPI) { if (wr == 1) PG8_BAR; }
    }
    PG8_WAIT_V(0);
    if constexpr (!ALIGN_EPI) { if (wr == 0) PG8_BAR; }
    PG8_BAR;
    if constexpr (Epi::AFTER_DRAIN) { E.fused(acc, cur, wr, wc, fr, fq, lds, wid, lane); S.done(cur); }
#undef PG8_SA
#undef PG8_SB
#undef PG8_STAGE
#undef PG8_LDA
#undef PG8_LDB
#undef PG8_MMA
#undef PG8_WAIT_V
#undef PG8_WAIT_L
#undef PG8_BAR
#undef PG8_SCHED
}
template <class Epi, class Sched>
__device__ __forceinline__ void gemm_phase_x(PG8_LAS unsigned char* lds, const Gemm g, const int Mx, const Sched& S, const Epi& E) {
    const int tid = threadIdx.x, wid = __builtin_amdgcn_readfirstlane(tid >> 6), lane = tid & 63, wr = wid >> 2, wc = wid & 3, fr = lane & 15, fq = lane >> 4;
    const int K = g.K, nt = K / BK;
    unsigned voffA, voffB, voffE;
    { int R, C; stage_rc(tid * 16, R, C); const int Rb = Epi::PERM ? ((R & ~31) + perm32(R & 31)) : R;
        voffA = (unsigned)(R * K + C) * 2u; voffB = (unsigned)(Rb * K + C) * 2u; }
    { const int b = tid * 4; int R, C; stage_rc(b & ~15, R, C); C += (b & 15) >> 1; voffE = (unsigned)(R * K + C) * 2u; }
    const size_t kstep = (size_t)(BK * 2);
    const size_t hstep = (size_t)HALF * K * 2;
    const size_t tstep = 2 * hstep;
    const size_t qstep = (size_t)64 * K * 2;
    const size_t estep = (size_t)16 * K * 2;
    const unsigned ldsw = (unsigned)wid * 1024u;
    const int aoff = lds_byte(wr * 64 + fr, fq * 8), boff = lds_byte(wc * 32 + fr, fq * 8), eoff = lds_byte(fr, fq * 8);
    constexpr int ES0 = 135168;
#define PG8_SA(b, h) (((b) * 2 + (h)) * HTB)
#define PG8_SB(b, h) ((4 + (b) * 2 + (h)) * HTB)
#define PG8_STAGE(bufoff, gbase, voff) do { _Pragma("unroll") for (int _i = 0; _i < 2; ++_i) \
        __builtin_amdgcn_global_load_lds((const unsigned*)((const char*)(gbase) + (size_t)_i * qstep + (voff)), (PG8_LAS unsigned*)(lds + (bufoff) + ldsw + _i * 8192), 16, 0, 0); } while (0)
#define PG8_STAGE_E(b, gbase) __builtin_amdgcn_global_load_lds((const unsigned*)((const char*)(gbase) + voffE), (PG8_LAS unsigned*)(lds + ES0 + (b) * 2048 + wid * 256), 4, 0, 0)
#define PG8_LDA(dst, b, h) do { _Pragma("unroll") for (int m = 0; m < 4; ++m) _Pragma("unroll") for (int k = 0; k < 2; ++k) dst[m][k] = *(const PG8_LAS bf16x8*)(lds + PG8_SA(b, h) + aoff + m * 2048 + k * 1024); } while (0)
#define PG8_LDB(dst, b, h) do { _Pragma("unroll") for (int n = 0; n < 2; ++n) _Pragma("unroll") for (int k = 0; k < 2; ++k) dst[n][k] = *(const PG8_LAS bf16x8*)(lds + PG8_SB(b, h) + boff + n * 2048 + k * 1024); } while (0)
#define PG8_LDE(dst, b) do { _Pragma("unroll") for (int k = 0; k < 2; ++k) dst[k] = *(const PG8_LAS bf16x8*)(lds + ES0 + (b) * 2048 + eoff + k * 1024); } while (0)
#define PG8_MMA(ai, bj, At, Bt) do { __builtin_amdgcn_s_setprio(1); _Pragma("unroll") for (int m = 0; m < 4; ++m) _Pragma("unroll") for (int n = 0; n < 2; ++n) _Pragma("unroll") for (int k = 0; k < 2; ++k) \
        acc[ai][bj][m][n] = __builtin_amdgcn_mfma_f32_16x16x32_bf16(Bt[n][k], At[m][k], acc[ai][bj][m][n], 0, 0, 0); __builtin_amdgcn_s_setprio(0); } while (0)
#define PG8_MMA_E(Bt) do { _Pragma("unroll") for (int n = 0; n < 2; ++n) _Pragma("unroll") for (int k = 0; k < 2; ++k) accE[n] = __builtin_amdgcn_mfma_f32_16x16x32_bf16(Bt[n][k], Et[k], accE[n], 0, 0, 0); } while (0)
#define PG8_WAIT_V(n) asm volatile("s_waitcnt vmcnt(" #n ")" ::: "memory")
#define PG8_WAIT_L(n) asm volatile("s_waitcnt lgkmcnt(" #n ")" ::: "memory")
#define PG8_BAR __builtin_amdgcn_s_barrier()
#define PG8_SCHED __builtin_amdgcn_sched_barrier(0)
    Unit cur, nxt; int ui = 0;
    if (!S.next(0, cur)) return;
    f32x4 acc[2][2][4][2], accE[2];
#pragma unroll
    for (int a = 0; a < 2; ++a)
#pragma unroll
        for (int b = 0; b < 2; ++b)
#pragma unroll
            for (int m = 0; m < 4; ++m)
#pragma unroll
                for (int n = 0; n < 2; ++n) acc[a][b][m][n] = (f32x4){0.f, 0.f, 0.f, 0.f};
    accE[0] = (f32x4){0.f, 0.f, 0.f, 0.f}; accE[1] = accE[0];
    bf16x8 At[4][2], B0[2][2], B1[2][2], Et[2];
    const char* cA = (const char*)g.A + (size_t)cur.pm * tstep; const char* cB = (const char*)g.Bt + (size_t)cur.pn * tstep;
    const char* cE = (const char*)g.A + (size_t)Mx * K * 2 + (size_t)cur.pm * estep;
    S.a_ready(cur);
    PG8_STAGE(PG8_SB(0, 0), cB, voffB); PG8_STAGE(PG8_SB(0, 1), cB + hstep, voffB); PG8_STAGE(PG8_SA(0, 0), cA, voffA); PG8_STAGE_E(0, cE); PG8_STAGE(PG8_SA(0, 1), cA + hstep, voffA);
    if (wr == 1) PG8_BAR;
    PG8_WAIT_V(2); PG8_BAR;
    PG8_STAGE(PG8_SB(1, 0), cB + kstep, voffB); PG8_STAGE(PG8_SA(1, 0), cA + kstep, voffA); PG8_STAGE(PG8_SB(1, 1), cB + hstep + kstep, voffB);
    PG8_WAIT_V(6); PG8_BAR;
    for (;;) {
        const bool has_next = S.next(ui + 1, nxt);
        const char* nA = has_next ? (const char*)g.A + (size_t)nxt.pm * tstep : cA; const char* nB = has_next ? (const char*)g.Bt + (size_t)nxt.pn * tstep : cB;
        const char* nE = has_next ? (const char*)g.A + (size_t)Mx * K * 2 + (size_t)nxt.pm * estep : cE;
        for (int t = 0; t < nt; t += 2) {
            const bool last = (t == nt - 2);
            const char* a1 = cA + (size_t)(t + 1) * kstep;
            const char* a2 = last ? nA : cA + (size_t)(t + 2) * kstep; const char* b2 = last ? nB : cB + (size_t)(t + 2) * kstep; const char* e2 = last ? nE : cE + (size_t)(t + 2) * kstep;
            const char* a3 = a2 + kstep; const char* b3 = b2 + kstep; const char* e1 = cE + (size_t)(t + 1) * kstep;
            if (last && has_next) S.a_ready(nxt);
            PG8_LDB(B0, 0, 0); PG8_LDB(B1, 0, 1); PG8_SCHED; PG8_LDA(At, 0, 0); PG8_STAGE_E(1, e1); PG8_STAGE(PG8_SA(1, 1), a1 + hstep, voffA);
            PG8_WAIT_V(9); PG8_WAIT_L(0); PG8_BAR; PG8_MMA(0, 0, At, B0); PG8_MMA(0, 1, At, B1); PG8_SCHED; PG8_LDE(Et, 0); PG8_WAIT_L(0); if (wr == 0) PG8_MMA_E(B0); else PG8_MMA_E(B1); PG8_BAR; PG8_SCHED;
            PG8_LDA(At, 0, 1); PG8_STAGE(PG8_SB(0, 0), b2, voffB); PG8_STAGE(PG8_SB(0, 1), b2 + hstep, voffB); PG8_STAGE(PG8_SA(0, 0), a2, voffA);
            PG8_WAIT_V(8); PG8_WAIT_L(0); PG8_BAR; PG8_MMA(1, 0, At, B0); PG8_MMA(1, 1, At, B1); PG8_BAR; PG8_SCHED;
            PG8_LDB(B0, 1, 0); PG8_LDB(B1, 1, 1); PG8_SCHED; PG8_LDA(At, 1, 0); PG8_STAGE_E(0, e2); PG8_STAGE(PG8_SA(0, 1), a2 + hstep, voffA);
            PG8_WAIT_V(9); PG8_WAIT_L(0); PG8_BAR; PG8_MMA(0, 0, At, B0); PG8_MMA(0, 1, At, B1); PG8_SCHED; PG8_LDE(Et, 1); PG8_WAIT_L(0); if (wr == 0) PG8_MMA_E(B0); else PG8_MMA_E(B1); PG8_BAR; PG8_SCHED;
            PG8_LDA(At, 1, 1); PG8_STAGE(PG8_SB(1, 0), b3, voffB); PG8_STAGE(PG8_SB(1, 1), b3 + hstep, voffB); PG8_STAGE(PG8_SA(1, 0), a3, voffA);
            PG8_WAIT_V(8); PG8_WAIT_L(0); PG8_BAR; PG8_MMA(1, 0, At, B0); PG8_MMA(1, 1, At, B1); PG8_BAR; PG8_SCHED;
        }
        if (wr == 0) PG8_BAR;
        E(acc, cur, wr, wc, fr, fq); E.extra(accE, cur, wr, wc, fr, fq); S.done(cur);
        if (!has_next) break;
#pragma unroll
        for (int a = 0; a < 2; ++a)
#pragma unroll
            for (int b = 0; b < 2; ++b)
#pragma unroll
                for (int m = 0; m < 4; ++m)
#pragma unroll
                    for (int n = 0; n < 2; ++n) acc[a][b][m][n] = (f32x4){0.f, 0.f, 0.f, 0.f};
        accE[0] = (f32x4){0.f, 0.f, 0.f, 0.f}; accE[1] = accE[0];
        cur = nxt; cA = nA; cB = nB; cE = nE; ++ui;
        if (wr == 1) PG8_BAR;
    }
    PG8_WAIT_V(0);
    PG8_BAR;
#undef PG8_SA
#undef PG8_SB
#undef PG8_STAGE
#undef PG8_STAGE_E
#undef PG8_LDA
#undef PG8_LDB
#undef PG8_LDE
#undef PG8_MMA
#undef PG8_MMA_E
#undef PG8_WAIT_V
#undef PG8_WAIT_L
#undef PG8_BAR
#undef PG8_SCHED
}
}
constexpr int NWAVES = 8;
#ifndef MK_N_LAUNCHES
#define MK_N_LAUNCHES 1
#endif
constexpr int N_PHASES = 14;
constexpr int MROWS = 17408, MP = 16384, DM = 1024, DFF = 4096, NIN1 = 3088, NIN1P = 3328;
constexpr size_t MiB = 1u << 20;
constexpr size_t WS_CTL = 0, CTL_ZERO_BYTES = 1 * MiB;
constexpr size_t WS_SS = 128 * 1024;
constexpr size_t WS_LB = 1 * MiB;
constexpr size_t WS_WIN0 = 2 * MiB, WS_WOUT0 = 10 * MiB, WS_WUP0 = 12 * MiB, WS_WDN0 = 20 * MiB, WS_WIN1 = 28 * MiB, WS_WOUT1 = 35 * MiB, WS_WUP1 = 37 * MiB, WS_WDN1 = 45 * MiB;
constexpr size_t WS_XB = 53 * MiB;
constexpr size_t WS_ACT = 87 * MiB;
constexpr size_t ACT_T = (size_t)MROWS * 1024 * 2;
constexpr size_t WS_Q = WS_ACT, WS_LF = WS_ACT + ACT_T, WS_V = WS_ACT + 2 * ACT_T, WS_G = WS_ACT + 3 * ACT_T;
constexpr size_t WS_QM = WS_ACT, WS_KM = WS_ACT + ACT_T / 2, WS_VM = WS_ACT + ACT_T, WS_OM = WS_ACT + 2 * ACT_T, WS_GT = WS_ACT + 3 * ACT_T;
constexpr size_t WS_END = WS_ACT + 4 * ACT_T;
static_assert(WS_END <= 224 * MiB, "d_ws map");
constexpr int CW_BAR = 4096;
constexpr size_t OUT_Y = 0, OUT_SP = 17825792, OUT_CP = 18874368, OUT_NP = 19398656, OUT_MP = 19402752, OUT_SS = 19402816, OUT_CS = 36180032, OUT_NS = 44568640, OUT_MS = 44634176, OUT_END = 44635200;
constexpr int RING_BYTES = 131072, LDSCTL_OFF = RING_BYTES, MISC_OFF = LDSCTL_OFF + 320, LDS_BYTES = 147456;

#define GAS __attribute__((address_space(1)))
#define LAS __attribute__((address_space(3)))
typedef unsigned short bf16;
typedef unsigned v4u __attribute__((ext_vector_type(4)));
typedef unsigned v2u __attribute__((ext_vector_type(2)));
typedef float f32x4 __attribute__((ext_vector_type(4)));
typedef float f32x2 __attribute__((ext_vector_type(2)));
typedef short bf16x8 __attribute__((ext_vector_type(8)));
typedef GAS unsigned gu32;
#define RLX_AGENT __ATOMIC_RELAXED, __HIP_MEMORY_SCOPE_AGENT
#define LDS_WAIT() asm volatile("s_waitcnt lgkmcnt(0)" ::: "memory")
#define VM_WAIT() asm volatile("s_waitcnt vmcnt(0)" ::: "memory")
__device__ __forceinline__ unsigned f2bf(float f) { unsigned u = __builtin_bit_cast(unsigned, f); return (u + 0x7fffu + ((u >> 16) & 1u)) >> 16; }
typedef __bf16 bf16x2c __attribute__((ext_vector_type(2)));
__device__ __forceinline__ unsigned pk2(float lo, float hi) { f32x2 v = {lo, hi}; bf16x2c b = __builtin_convertvector(v, bf16x2c); return __builtin_bit_cast(unsigned, b); }
__device__ __forceinline__ float bflo(unsigned w) { return __builtin_bit_cast(float, w << 16); }
__device__ __forceinline__ float bfhi(unsigned w) { return __builtin_bit_cast(float, w & 0xffff0000u); }
__device__ __forceinline__ float bf1(unsigned short h) { return __builtin_bit_cast(float, (unsigned)h << 16); }
__device__ __forceinline__ float hlo(unsigned w) { return (float)__builtin_bit_cast(_Float16, (unsigned short)(w & 0xffffu)); }
__device__ __forceinline__ float hhi(unsigned w) { return (float)__builtin_bit_cast(_Float16, (unsigned short)(w >> 16)); }
__device__ __forceinline__ float h1(unsigned short h) { return (float)__builtin_bit_cast(_Float16, h); }

#define XB_TMO      128
#define XB_XCNT(j)  (256  + 64 * (j))
#define XB_XSUB(j)  (1280 + 64 * (j))
#define XB_XGEN(j)  (2304 + 64 * (j))
#define XB_TOP      3328
#define XB_TOPGEN   3392
#define XCD_BAR_WORDS 3456
#define XB_SPIN_CAP (1u << 18)
__device__ __forceinline__ unsigned xb_ld(unsigned* p)              { return __hip_atomic_load(p, __ATOMIC_RELAXED, __HIP_MEMORY_SCOPE_AGENT); }
__device__ __forceinline__ unsigned xb_add(unsigned* p, unsigned v) { return __hip_atomic_fetch_add(p, v, __ATOMIC_RELAXED, __HIP_MEMORY_SCOPE_AGENT); }
__device__ __forceinline__ unsigned xb_xcc_id() { return (unsigned)__builtin_amdgcn_s_getreg((3 << 11) | 20) & 0xFu; }
#define XB_SPIN(cond, bar) do { unsigned _sp = 0; while (cond) { __builtin_amdgcn_s_sleep(1); \
    if ((++_sp & 255u) == 0u) { if (xb_ld(&(bar)[XB_TMO])) break; if (_sp > XB_SPIN_CAP) { atomicAdd(&(bar)[XB_TMO], 1u); break; } } } } while (0)
struct XcdBarrier { unsigned* bar; unsigned x; volatile LAS unsigned* st; };
__device__ __forceinline__ XcdBarrier xcd_barrier_post(unsigned* bar, volatile LAS unsigned* st) {
    XcdBarrier b; b.bar = bar; b.x = xb_xcc_id(); b.st = st;
    if (threadIdx.x == 0) (void)xb_add(&bar[XB_XCNT(b.x)], 1u);
    return b;
}
__device__ __forceinline__ void xcd_barrier_complete(unsigned* bar, unsigned x, unsigned& nloc, unsigned& nx) {
    const unsigned G = gridDim.x * gridDim.y * gridDim.z;
    unsigned sum, cnt, mine, sp = 0u;
    for (;;) {
        sum = 0u; cnt = 0u; mine = 0u;
#pragma unroll
        for (unsigned j = 0; j < 16; ++j) { const unsigned c = xb_ld(&bar[XB_XCNT(j)]); sum += c; cnt += (c > 0u) ? 1u : 0u; mine = (j == x) ? c : mine; }
        if (sum == G) break;
        __builtin_amdgcn_s_sleep(1);
        if ((++sp & 255u) == 0u) { if (xb_ld(&bar[XB_TMO])) break; if (sp > XB_SPIN_CAP) { atomicAdd(&bar[XB_TMO], 1u); break; } }
    }
    nloc = mine > 0u ? mine : 1u; nx = cnt > 0u ? cnt : 1u;
}
__device__ __forceinline__ void xcd_barrier(const XcdBarrier& b) {
    asm volatile("s_waitcnt vmcnt(0)" ::: "memory");
    __syncthreads();
    if (threadIdx.x == 0) {
        unsigned* bar = b.bar;
        __builtin_amdgcn_s_waitcnt(0);
        unsigned nloc = b.st[0], nx = b.st[1];
        if (nloc == 0u) { xcd_barrier_complete(bar, b.x, nloc, nx); b.st[0] = nloc; b.st[1] = nx; }
        const unsigned old = xb_add(&bar[XB_XSUB(b.x)], 1u);
        const unsigned gen = old / nloc;
        if (old + 1u == (gen + 1u) * nloc) {
            __builtin_amdgcn_fence(__ATOMIC_RELEASE, "agent");
            asm volatile("s_waitcnt vmcnt(0)" ::: "memory");
            const unsigned og = xb_add(&bar[XB_TOP], 1u);
            const unsigned tg = og / nx;
            if (og + 1u == (tg + 1u) * nx) xb_add(&bar[XB_TOPGEN], 1u);
            else XB_SPIN(xb_ld(&bar[XB_TOPGEN]) == tg, bar);
            __builtin_amdgcn_fence(__ATOMIC_ACQUIRE, "agent");
            xb_add(&bar[XB_XGEN(b.x)], 1u);
            asm volatile("s_waitcnt vmcnt(0)" ::: "memory");
        } else {
            XB_SPIN(xb_ld(&bar[XB_XGEN(b.x)]) == gen, bar);
            __builtin_amdgcn_fence(__ATOMIC_ACQUIRE, "agent");
            asm volatile("s_waitcnt vmcnt(0)" ::: "memory");
        }
    }
    __syncthreads();
}

__device__ __forceinline__ float wave_sum(float v) {
#pragma unroll
    for (int o = 1; o < 64; o <<= 1) v += __shfl_xor(v, o);
    return v;
}
__device__ __forceinline__ void p0_transpose_item(const float* W, int K, int N, const float* sc, bf16* WT, LAS float* scr, int item, int lane) {
    const int nblk = (N + 31) / 32, kb = item / nblk, nb = item % nblk, k0 = 64 * kb, n0 = 32 * nb;
    const bool nok = (n0 + (lane & 31)) < N;
    float wv[32];
#pragma unroll
    for (int i = 0; i < 32; ++i) { const int kk = 2 * i + (lane >> 5); wv[i] = nok ? W[(size_t)(k0 + kk) * N + n0 + (lane & 31)] : 0.f; }
    const float s0 = sc ? sc[k0 + lane] : 1.0f;
#pragma unroll
    for (int i = 0; i < 32; ++i) { const int kk = 2 * i + (lane >> 5); scr[kk * 33 + (lane & 31)] = wv[i] * __shfl(s0, kk); }
    LDS_WAIT(); asm volatile("" ::: "memory");
    const int c = lane & 7;
#pragma unroll
    for (int j = 0; j < 4; ++j) { const int n = (lane >> 3) + 8 * j; const LAS float* s = scr + (8 * c) * 33 + n;
        v4u o; o.x = pk2(s[0 * 33], s[1 * 33]); o.y = pk2(s[2 * 33], s[3 * 33]); o.z = pk2(s[4 * 33], s[5 * 33]); o.w = pk2(s[6 * 33], s[7 * 33]);
        *(GAS v4u*)(WT + (size_t)(n0 + n) * K + k0 + 8 * c) = o; }
    LDS_WAIT(); asm volatile("" ::: "memory");
}
#define MFMA16(a, b, c) __builtin_amdgcn_mfma_f32_16x16x32_bf16((a), (b), (c), 0, 0, 0)
#define LDSV(T, off) (*(LAS T*)(lds + (off)))
#define LDSF(off) (*(const LAS bf16x8*)(lds + (off)))
#define BAR_LDS() do { asm volatile("s_waitcnt lgkmcnt(0)" ::: "memory"); __builtin_amdgcn_s_barrier(); asm volatile("" ::: "memory"); } while (0)
namespace hg {
constexpr int QP = 0, KP = QP + 64 * 272, KPPT = KP + 64 * 272, VT = KPPT + 128 * 144, AM = VT + 128 * 144, ST = AM + 64 * 144, GT = ST + 128 * 272, DEC = GT + 8 * 128 * 4, NP = DEC + 512, END = NP + 512;
static_assert(END <= RING_BYTES, "hgrn LDS");
}
template <bool STATE_ONLY>
__device__ __forceinline__ void hgrn_seg_item(LAS unsigned char* lds, int b, int h, int g, const bf16* Qb, const bf16* LFb, const bf16* Vb, const bf16* Gb, bf16* Ob, const float* onw, float* Escr, float* Dscr, float* S_out) {
    using namespace hg;
    constexpr int NCH = 8;
    const int tid = threadIdx.x, lane = tid & 63, w = __builtin_amdgcn_readfirstlane(tid >> 6), fr = lane & 15, fq = lane >> 4;
    const int tb = w & 3, wh = w >> 2;
    const size_t rowb = (size_t)b * 2048 + (size_t)g * 512;
    const int colp = h * 128 + 2 * lane;
    const int item0 = (b * 8 + h) * 4;
    __syncthreads();
    f32x4 sacc[8];
#pragma unroll
    for (int j = 0; j < 8; ++j) sacc[j] = (f32x4){0.f, 0.f, 0.f, 0.f};
    if (!STATE_ONLY && g > 0) {
#pragma unroll
        for (int j = 0; j < 8; ++j) sacc[j] = *(const f32x4*)(Escr + ((size_t)item0 * 16384) + ((w * 8 + j) * 64 + lane) * 4);
        for (int gg = 1; gg < g; ++gg) { const f32x4 dec = *(const f32x4*)(Dscr + (item0 + gg) * 128 + 16 * w + 4 * fq);
#pragma unroll
            for (int j = 0; j < 8; ++j) sacc[j] = sacc[j] * dec + *(const f32x4*)(Escr + ((size_t)(item0 + gg) * 16384) + ((w * 8 + j) * 64 + lane) * 4); }
#pragma unroll
        for (int j = 0; j < 8; ++j) LDSV(v2u, ST + (j * 16 + fr) * 272 + (16 * w + 4 * fq) * 2) = (v2u){pk2(sacc[j][0], sacc[j][1]), pk2(sacc[j][2], sacc[j][3])};
    } else if (!STATE_ONLY) {
        for (int i = tid; i < 128 * 272 / 4; i += 512) LDSV(unsigned, ST + 4 * i) = 0u;
    }
    __syncthreads();
    f32x4 wn[4];
#pragma unroll
    for (int j = 0; j < 4; ++j) wn[j] = *(const f32x4*)(onw + h * 128 + (4 * wh + j) * 16 + 4 * fq);
    unsigned rq[8], rl[8], rv[8]; float bp0 = 0.f, bp1 = 0.f;
#pragma unroll
    for (int i = 0; i < 8; ++i) { const size_t e = (rowb + 8 * w + i) * 1024 + colp; if (!STATE_ONLY) rq[i] = *(const unsigned*)(Qb + e); rl[i] = *(const unsigned*)(LFb + e); rv[i] = *(const unsigned*)(Vb + e); }
    for (int c = 0; c < NCH; ++c) {
        float c0[8], c1[8]; { float a0 = 0.f, a1 = 0.f;
#pragma unroll
            for (int i = 0; i < 8; ++i) { a0 += hlo(rl[i]); a1 += hhi(rl[i]); c0[i] = a0; c1[i] = a1; }
            LDSV(f32x2, GT + (w * 128 + 2 * lane) * 4) = (f32x2){a0, a1}; }
        BAR_LDS();
        float pre0 = 0.f, pre1 = 0.f, tot0 = 0.f, tot1 = 0.f;
#pragma unroll
        for (int gi = 0; gi < 8; ++gi) { const f32x2 x = LDSV(f32x2, GT + (gi * 128 + 2 * lane) * 4); tot0 += x.x; tot1 += x.y; if (gi < w) { pre0 += x.x; pre1 += x.y; } }
        if (w == 0) LDSV(f32x2, DEC + 2 * lane * 4) = (f32x2){__expf(tot0), __expf(tot1)};
        bp0 += tot0; bp1 += tot1;
        { unsigned kk0[4], kk1[4], vv0[4], vv1[4]; float pk0 = 0.f, pk1 = 0.f;
#pragma unroll
            for (int i = 0; i < 8; ++i) {
                const float b0 = pre0 + c0[i], b1 = pre1 + c1[i];
                const float k0 = 1.0f - __expf(hlo(rl[i])), k1 = 1.0f - __expf(hhi(rl[i]));
                const float l0 = __expf(tot0 - b0), l1 = __expf(tot1 - b1);
                if (!STATE_ONLY) { const float e0 = __expf(b0), e1 = __expf(b1), n0 = __expf(-b0), n1 = __expf(-b1);
                    LDSV(unsigned, QP + (8 * w + i) * 272 + 4 * lane) = pk2(bflo(rq[i]) * e0, bfhi(rq[i]) * e1);
                    LDSV(unsigned, KP + (8 * w + i) * 272 + 4 * lane) = pk2(k0 * n0, k1 * n1); }
                const float x0 = k0 * l0, x1 = k1 * l1;
                if (i & 1) { kk0[i >> 1] = pk2(pk0, x0); kk1[i >> 1] = pk2(pk1, x1); vv0[i >> 1] = (rv[i - 1] & 0xffffu) | (rv[i] << 16); vv1[i >> 1] = (rv[i - 1] >> 16) | (rv[i] & 0xffff0000u); }
                else { pk0 = x0; pk1 = x1; }
            }
            LDSV(v4u, KPPT + (2 * lane) * 144 + 16 * w) = (v4u){kk0[0], kk0[1], kk0[2], kk0[3]};
            LDSV(v4u, KPPT + (2 * lane + 1) * 144 + 16 * w) = (v4u){kk1[0], kk1[1], kk1[2], kk1[3]};
            LDSV(v4u, VT + (2 * lane) * 144 + 16 * w) = (v4u){vv0[0], vv0[1], vv0[2], vv0[3]};
            LDSV(v4u, VT + (2 * lane + 1) * 144 + 16 * w) = (v4u){vv1[0], vv1[1], vv1[2], vv1[3]}; }
        const size_t orow = (rowb + (size_t)c * 64 + tb * 16 + fr) * 1024 + h * 128 + 4 * fq;
        v2u rg[4];
        if (!STATE_ONLY) {
#pragma unroll
            for (int j = 0; j < 4; ++j) rg[j] = *(const v2u*)(Gb + orow + (4 * wh + j) * 16);
        }
        if (c + 1 < NCH) {
#pragma unroll
            for (int i = 0; i < 8; ++i) { const size_t e = (rowb + (size_t)(c + 1) * 64 + 8 * w + i) * 1024 + colp; if (!STATE_ONLY) rq[i] = *(const unsigned*)(Qb + e); rl[i] = *(const unsigned*)(LFb + e); rv[i] = *(const unsigned*)(Vb + e); }
        }
        BAR_LDS();
        f32x4 oacc[4];
        if (!STATE_ONLY) {
#pragma unroll
        for (int j = 0; j < 2; ++j) { const int sb = 2 * wh + j; f32x4 a = (f32x4){0.f, 0.f, 0.f, 0.f};
            if (sb <= tb) {
#pragma unroll
                for (int kk = 0; kk < 4; ++kk) a = MFMA16(LDSF(KP + (sb * 16 + fr) * 272 + kk * 64 + fq * 16), LDSF(QP + (tb * 16 + fr) * 272 + kk * 64 + fq * 16), a);
                const int t = tb * 16 + fr, s0 = sb * 16 + 4 * fq;
#pragma unroll
                for (int r = 0; r < 4; ++r) if (s0 + r > t) a[r] = 0.f;
            }
            LDSV(v2u, AM + (tb * 16 + fr) * 144 + (sb * 16 + 4 * fq) * 2) = (v2u){pk2(a[0], a[1]), pk2(a[2], a[3])}; }
        BAR_LDS();
        { bf16x8 bA[2], bQ[4];
#pragma unroll
            for (int kk = 0; kk < 2; ++kk) bA[kk] = LDSF(AM + (tb * 16 + fr) * 144 + kk * 64 + fq * 16);
#pragma unroll
            for (int kk = 0; kk < 4; ++kk) bQ[kk] = LDSF(QP + (tb * 16 + fr) * 272 + kk * 64 + fq * 16);
#pragma unroll
            for (int j = 0; j < 4; ++j) { const int dvb = 4 * wh + j; f32x4 a = (f32x4){0.f, 0.f, 0.f, 0.f};
#pragma unroll
                for (int kk = 0; kk < 2; ++kk) a = MFMA16(LDSF(VT + (dvb * 16 + fr) * 144 + kk * 64 + fq * 16), bA[kk], a);
#pragma unroll
                for (int kk = 0; kk < 4; ++kk) a = MFMA16(LDSF(ST + (dvb * 16 + fr) * 272 + kk * 64 + fq * 16), bQ[kk], a);
                oacc[j] = a; } }
        { float ss = 0.f;
#pragma unroll
            for (int j = 0; j < 4; ++j) ss += (oacc[j][0] * oacc[j][0] + oacc[j][1] * oacc[j][1]) + (oacc[j][2] * oacc[j][2] + oacc[j][3] * oacc[j][3]);
            ss += __shfl_xor(ss, 16); ss += __shfl_xor(ss, 32);
            if (fq == 0) LDSV(float, NP + ((tb * 16 + fr) * 2 + wh) * 4) = ss; }
        }
        { const f32x4 dec = LDSV(f32x4, DEC + (16 * w + 4 * fq) * 4); bf16x8 aK[2];
#pragma unroll
            for (int kk = 0; kk < 2; ++kk) aK[kk] = LDSF(KPPT + (16 * w + fr) * 144 + kk * 64 + fq * 16);
#pragma unroll
            for (int j = 0; j < 8; ++j) { f32x4 a = sacc[j] * dec;
#pragma unroll
                for (int kk = 0; kk < 2; ++kk) a = MFMA16(aK[kk], LDSF(VT + (j * 16 + fr) * 144 + kk * 64 + fq * 16), a);
                sacc[j] = a; } }
        BAR_LDS();
        if (!STATE_ONLY) {
        { const f32x2 p = LDSV(f32x2, NP + (tb * 16 + fr) * 8); const float rstd = rsqrtf((p.x + p.y) * (1.0f / 128.0f) + 1e-6f);
#pragma unroll
            for (int j = 0; j < 4; ++j) { const f32x4 o = oacc[j] * rstd * wn[j];
                *(v2u*)(Ob + orow + (4 * wh + j) * 16) = (v2u){pk2(o[0] * bflo(rg[j].x), o[1] * bfhi(rg[j].x)), pk2(o[2] * bflo(rg[j].y), o[3] * bfhi(rg[j].y))}; } }
#pragma unroll
        for (int j = 0; j < 8; ++j) LDSV(v2u, ST + (j * 16 + fr) * 272 + (16 * w + 4 * fq) * 2) = (v2u){pk2(sacc[j][0], sacc[j][1]), pk2(sacc[j][2], sacc[j][3])};
        }
    }
    if (STATE_ONLY) {
#pragma unroll
        for (int j = 0; j < 8; ++j) *(f32x4*)(Escr + ((size_t)(item0 + g) * 16384) + ((w * 8 + j) * 64 + lane) * 4) = sacc[j];
        if (w == 0) *(f32x2*)(Dscr + (item0 + g) * 128 + 2 * lane) = (f32x2){__expf(bp0), __expf(bp1)};
    } else if (g == 3) {
        float* so = S_out + (size_t)(b * 8 + h) * 128 * 128;
#pragma unroll
        for (int j = 0; j < 8; ++j)
#pragma unroll
            for (int r = 0; r < 4; ++r) so[(size_t)(16 * w + 4 * fq + r) * 128 + j * 16 + fr] = sacc[j][r];
    }
}
__device__ __forceinline__ void hgrn_sample_item(LAS unsigned char* lds, int b, int h, const bf16* Qb, const bf16* LFb, const bf16* Vb, const bf16* Gb, bf16* Ob, const float* onw, const float* S_in, float* S_out) {
    constexpr int FKQ = 0, VS = 16384, RED = 20480;
    const int tid = threadIdx.x, lane = tid & 63, w = __builtin_amdgcn_readfirstlane(tid >> 6), c4 = tid & 31, dg = tid >> 5;
    const size_t rowb = (size_t)MP + (size_t)b * 8;
    __syncthreads();
#pragma unroll
    for (int e = tid; e < 1024; e += 512) { const int t = e >> 7, d = e & 127; const size_t g = (rowb + t) * 1024 + h * 128 + d;
        const float f = __expf(h1(LFb[g])); LDSV(f32x4, FKQ + e * 16) = (f32x4){f, 1.0f - f, bf1(Qb[g]), 0.f}; LDSV(float, VS + e * 4) = bf1(Vb[g]); }
    const size_t sbase = ((size_t)(b * 8 + h) * 128 + 8 * dg) * 128 + 4 * c4;
    f32x4 s[8], po[8];
#pragma unroll
    for (int i = 0; i < 8; ++i) s[i] = *(const f32x4*)(S_in + sbase + (size_t)i * 128);
    __syncthreads();
#pragma unroll
    for (int t = 0; t < 8; ++t) { const f32x4 vv = LDSV(f32x4, VS + (t * 128 + 4 * c4) * 4); f32x4 p = (f32x4){0.f, 0.f, 0.f, 0.f};
#pragma unroll
        for (int i = 0; i < 8; ++i) { const f32x4 x = LDSV(f32x4, FKQ + (t * 128 + 8 * dg + i) * 16); s[i] = s[i] * x[0] + vv * x[1]; p += s[i] * x[2]; }
        po[t] = p; }
#pragma unroll
    for (int t = 0; t < 8; ++t) LDSV(f32x4, RED + ((dg * 8 + t) * 128 + 4 * c4) * 4) = po[t];
#pragma unroll
    for (int i = 0; i < 8; ++i) *(f32x4*)(S_out + sbase + (size_t)i * 128) = s[i];
    __syncthreads();
    { const int t = w; float o0 = 0.f, o1 = 0.f;
#pragma unroll
        for (int g = 0; g < 16; ++g) { const f32x2 x = LDSV(f32x2, RED + ((g * 8 + t) * 128 + 2 * lane) * 4); o0 += x.x; o1 += x.y; }
        const float rstd = rsqrtf(wave_sum(o0 * o0 + o1 * o1) * (1.0f / 128.0f) + 1e-6f);
        const size_t g = (rowb + t) * 1024 + h * 128 + 2 * lane; const unsigned gg = *(const unsigned*)(Gb + g);
        *(unsigned*)(Ob + g) = pk2(o0 * rstd * onw[h * 128 + 2 * lane] * bflo(gg), o1 * rstd * onw[h * 128 + 2 * lane + 1] * bfhi(gg)); }
}
namespace ml {
constexpr int Q = 0, K = Q + 64 * 144, KWT = K + 64 * 144, AM = KWT + 64 * 144, VTE = AM + 64 * 144, CTE = VTE + 144 * 144, AS = CTE + 144 * 144, MT = AS + 256, WI = MT + 256, EM = WI + 256, WS = EM + 256, DEN = WS + 256, SC = DEN + 256, NP = SC + 16, END = NP + 512;
static_assert(END <= RING_BYTES, "mlstm LDS");
}
template <bool STATE_ONLY>
__device__ __forceinline__ void mlstm_seg_item(LAS unsigned char* lds, int b, int h, int g, const bf16* Qm, const bf16* Km, const bf16* Vm, const bf16* Om, const float* GTg, bf16* Hb, const float* onw,
                                               float* Escr, float* Mscr, float* C_out, float* n_out, float* m_out) {
    using namespace ml;
    constexpr int NCH = 8;
    const int tid = threadIdx.x, lane = tid & 63, w = __builtin_amdgcn_readfirstlane(tid >> 6), fr = lane & 15, fq = lane >> 4;
    const int tb = w & 3, wh = w >> 2;
    const size_t rowb = (size_t)b * 2048 + (size_t)g * 512;
    const int dp = tid & 31, tg4 = tid >> 5;
    const int item0 = (b * 8 + h) * 4;
    __syncthreads();
    for (int i = tid; i < 144 * 144 / 4; i += 512) { LDSV(unsigned, CTE + 4 * i) = 0u; const int row = (4 * i) / 144; LDSV(unsigned, VTE + 4 * i) = row == 128 ? 0x3f803f80u : 0u; }
    __syncthreads();
    f32x4 cacc[5];
#pragma unroll
    for (int j = 0; j < 5; ++j) cacc[j] = (f32x4){0.f, 0.f, 0.f, 0.f};
    float m_prev = (STATE_ONLY && g > 0) ? -INFINITY : 0.f, btot = 0.f;
    if (!STATE_ONLY && g > 0) {
#pragma unroll
        for (int j = 0; j < 5; ++j) cacc[j] = *(const f32x4*)(Escr + (size_t)item0 * 10240 + ((w * 5 + j) * 64 + lane) * 4);
        m_prev = Mscr[item0 * 2];
        for (int gg = 1; gg < g; ++gg) { const float mE = Mscr[(item0 + gg) * 2], Bt = Mscr[(item0 + gg) * 2 + 1]; const float mn = fmaxf(m_prev + Bt, mE), f1 = __expf(m_prev + Bt - mn), f2 = __expf(mE - mn);
#pragma unroll
            for (int j = 0; j < 5; ++j) cacc[j] = cacc[j] * f1 + *(const f32x4*)(Escr + (size_t)(item0 + gg) * 10240 + ((w * 5 + j) * 64 + lane) * 4) * f2;
            m_prev = mn; }
#pragma unroll
        for (int j = 0; j < 5; ++j) { if (j == 4 && wh != 0) break; const int dvb = j == 4 ? 8 : 4 * wh + j;
            LDSV(v2u, CTE + (dvb * 16 + fr) * 144 + (16 * tb + 4 * fq) * 2) = (v2u){pk2(cacc[j][0], cacc[j][1]), pk2(cacc[j][2], cacc[j][3])}; }
    }
    f32x4 wn[4];
#pragma unroll
    for (int j = 0; j < 4; ++j) wn[j] = *(const f32x4*)(onw + h * 128 + (4 * wh + j) * 16 + 4 * fq);
    unsigned rq[4], rk[4], rv[8]; float gli = 0.f, glf = 0.f;
#pragma unroll
    for (int i = 0; i < 4; ++i) { const size_t e = (rowb + 4 * tg4 + i) * 512 + h * 64 + 2 * dp; if (!STATE_ONLY) rq[i] = *(const unsigned*)(Qm + e); rk[i] = *(const unsigned*)(Km + e); }
#pragma unroll
    for (int i = 0; i < 8; ++i) rv[i] = *(const unsigned*)(Vm + (rowb + 8 * w + i) * 1024 + h * 128 + 2 * lane);
    if (w == 0) { gli = GTg[(rowb + lane) * 16 + h]; glf = GTg[(rowb + lane) * 16 + 8 + h]; }
    for (int c = 0; c < NCH; ++c) {
        if (w == 0) {
            float bs = glf;
#pragma unroll
            for (int o = 1; o < 64; o <<= 1) { const float x = __shfl_up(bs, o); if (lane >= o) bs += x; }
            const float a = gli - bs; float pm = a;
#pragma unroll
            for (int o = 1; o < 64; o <<= 1) { const float x = __shfl_up(pm, o); if (lane >= o) pm = fmaxf(pm, x); }
            const float Mt = fmaxf(m_prev, pm), M63 = __shfl(Mt, 63), b63 = __shfl(bs, 63);
            LDSV(float, AS + 4 * lane) = a; LDSV(float, MT + 4 * lane) = Mt; LDSV(float, WI + 4 * lane) = __expf(m_prev - Mt); LDSV(float, EM + 4 * lane) = __expf(-(bs + Mt)); LDSV(float, WS + 4 * lane) = __expf(a - M63);
            if (lane == 0) { LDSV(float, SC) = __expf(m_prev - M63); LDSV(float, SC + 4) = b63 + M63; LDSV(float, SC + 8) = b63; }
        }
        if (!STATE_ONLY) {
#pragma unroll
            for (int i = 0; i < 4; ++i) { LDSV(unsigned, Q + (4 * tg4 + i) * 144 + 4 * dp) = rq[i]; LDSV(unsigned, K + (4 * tg4 + i) * 144 + 4 * dp) = rk[i]; }
        }
        LDSV(v4u, VTE + (2 * lane) * 144 + 16 * w) = (v4u){(rv[0] & 0xffffu) | (rv[1] << 16), (rv[2] & 0xffffu) | (rv[3] << 16), (rv[4] & 0xffffu) | (rv[5] << 16), (rv[6] & 0xffffu) | (rv[7] << 16)};
        LDSV(v4u, VTE + (2 * lane + 1) * 144 + 16 * w) = (v4u){(rv[0] >> 16) | (rv[1] & 0xffff0000u), (rv[2] >> 16) | (rv[3] & 0xffff0000u), (rv[4] >> 16) | (rv[5] & 0xffff0000u), (rv[6] >> 16) | (rv[7] & 0xffff0000u)};
        BAR_LDS();
        { const f32x4 ws = LDSV(f32x4, WS + 16 * tg4);
            LDSV(v2u, KWT + (2 * dp) * 144 + 8 * tg4) = (v2u){pk2(bflo(rk[0]) * ws[0], bflo(rk[1]) * ws[1]), pk2(bflo(rk[2]) * ws[2], bflo(rk[3]) * ws[3])};
            LDSV(v2u, KWT + (2 * dp + 1) * 144 + 8 * tg4) = (v2u){pk2(bfhi(rk[0]) * ws[0], bfhi(rk[1]) * ws[1]), pk2(bfhi(rk[2]) * ws[2], bfhi(rk[3]) * ws[3])}; }
        const float wc = LDSV(float, SC), m_next = LDSV(float, SC + 4); btot += LDSV(float, SC + 8);
        const size_t orow = (rowb + (size_t)c * 64 + tb * 16 + fr) * 1024 + h * 128 + 4 * fq;
        v2u rg[4];
        if (!STATE_ONLY) {
#pragma unroll
            for (int j = 0; j < 4; ++j) rg[j] = *(const v2u*)(Om + orow + (4 * wh + j) * 16);
        }
        if (c + 1 < NCH) { const size_t r1 = rowb + (size_t)(c + 1) * 64;
#pragma unroll
            for (int i = 0; i < 4; ++i) { const size_t e = (r1 + 4 * tg4 + i) * 512 + h * 64 + 2 * dp; if (!STATE_ONLY) rq[i] = *(const unsigned*)(Qm + e); rk[i] = *(const unsigned*)(Km + e); }
#pragma unroll
            for (int i = 0; i < 8; ++i) rv[i] = *(const unsigned*)(Vm + (r1 + 8 * w + i) * 1024 + h * 128 + 2 * lane);
            if (w == 0) { gli = GTg[(r1 + lane) * 16 + h]; glf = GTg[(r1 + lane) * 16 + 8 + h]; }
        }
        BAR_LDS();
        f32x4 num[5];
        if (!STATE_ONLY) {
        { const float Mt = LDSV(float, MT + (tb * 16 + fr) * 4);
#pragma unroll
            for (int j = 0; j < 2; ++j) { const int sb = 2 * wh + j; f32x4 a = (f32x4){0.f, 0.f, 0.f, 0.f};
                if (sb <= tb) {
#pragma unroll
                    for (int kk = 0; kk < 2; ++kk) a = MFMA16(LDSF(K + (sb * 16 + fr) * 144 + kk * 64 + fq * 16), LDSF(Q + (tb * 16 + fr) * 144 + kk * 64 + fq * 16), a);
                    const int t = tb * 16 + fr, s0 = sb * 16 + 4 * fq; const f32x4 as = LDSV(f32x4, AS + s0 * 4);
#pragma unroll
                    for (int r = 0; r < 4; ++r) a[r] = (s0 + r > t) ? 0.f : a[r] * __expf(as[r] - Mt);
                }
                LDSV(v2u, AM + (tb * 16 + fr) * 144 + (sb * 16 + 4 * fq) * 2) = (v2u){pk2(a[0], a[1]), pk2(a[2], a[3])}; } }
        BAR_LDS();
        { bf16x8 bA[2], bQ[2]; const float wi = LDSV(float, WI + (tb * 16 + fr) * 4);
#pragma unroll
            for (int kk = 0; kk < 2; ++kk) { bA[kk] = LDSF(AM + (tb * 16 + fr) * 144 + kk * 64 + fq * 16); bQ[kk] = LDSF(Q + (tb * 16 + fr) * 144 + kk * 64 + fq * 16); }
#pragma unroll
            for (int j = 0; j < 5; ++j) { if (j == 4 && wh != 0) break; const int dvb = j == 4 ? 8 : 4 * wh + j; f32x4 a1 = (f32x4){0.f, 0.f, 0.f, 0.f}, a2 = a1;
#pragma unroll
                for (int kk = 0; kk < 2; ++kk) { a1 = MFMA16(LDSF(VTE + (dvb * 16 + fr) * 144 + kk * 64 + fq * 16), bA[kk], a1); a2 = MFMA16(LDSF(CTE + (dvb * 16 + fr) * 144 + kk * 64 + fq * 16), bQ[kk], a2); }
                num[j] = a1 + a2 * wi; }
            if (wh == 0 && fq == 0) LDSV(float, DEN + (tb * 16 + fr) * 4) = num[4][0]; }
        }
        { bf16x8 aK[2];
#pragma unroll
            for (int kk = 0; kk < 2; ++kk) aK[kk] = LDSF(KWT + (16 * tb + fr) * 144 + kk * 64 + fq * 16);
#pragma unroll
            for (int j = 0; j < 5; ++j) { if (j == 4 && wh != 0) break; const int dvb = j == 4 ? 8 : 4 * wh + j; f32x4 a = cacc[j] * wc;
#pragma unroll
                for (int kk = 0; kk < 2; ++kk) a = MFMA16(aK[kk], LDSF(VTE + (dvb * 16 + fr) * 144 + kk * 64 + fq * 16), a);
                cacc[j] = a; } }
        BAR_LDS();
        if (!STATE_ONLY) {
        { const float dn = fmaxf(fabsf(LDSV(float, DEN + (tb * 16 + fr) * 4)), LDSV(float, EM + (tb * 16 + fr) * 4)); const float inv = 1.0f / dn; float ss = 0.f;
#pragma unroll
            for (int j = 0; j < 4; ++j) { num[j] = num[j] * inv; ss += (num[j][0] * num[j][0] + num[j][1] * num[j][1]) + (num[j][2] * num[j][2] + num[j][3] * num[j][3]); }
            ss += __shfl_xor(ss, 16); ss += __shfl_xor(ss, 32);
            if (fq == 0) LDSV(float, NP + ((tb * 16 + fr) * 2 + wh) * 4) = ss; }
        BAR_LDS();
        { const f32x2 p = LDSV(f32x2, NP + (tb * 16 + fr) * 8); const float rstd = rsqrtf((p.x + p.y) * (1.0f / 128.0f) + 1e-6f);
#pragma unroll
            for (int j = 0; j < 4; ++j) { const f32x4 o = num[j] * rstd * wn[j];
                *(v2u*)(Hb + orow + (4 * wh + j) * 16) = (v2u){pk2(o[0] * bflo(rg[j].x), o[1] * bfhi(rg[j].x)), pk2(o[2] * bflo(rg[j].y), o[3] * bfhi(rg[j].y))}; } }
#pragma unroll
        for (int j = 0; j < 5; ++j) { if (j == 4 && wh != 0) break; const int dvb = j == 4 ? 8 : 4 * wh + j;
            LDSV(v2u, CTE + (dvb * 16 + fr) * 144 + (16 * tb + 4 * fq) * 2) = (v2u){pk2(cacc[j][0], cacc[j][1]), pk2(cacc[j][2], cacc[j][3])}; }
        }
        m_prev = m_next;
    }
    if (STATE_ONLY) {
#pragma unroll
        for (int j = 0; j < 5; ++j) *(f32x4*)(Escr + (size_t)(item0 + g) * 10240 + ((w * 5 + j) * 64 + lane) * 4) = cacc[j];
        if (tid == 0) { Mscr[(item0 + g) * 2] = m_prev; Mscr[(item0 + g) * 2 + 1] = btot; }
    } else if (g == 3) {
        float* co = C_out + (size_t)(b * 8 + h) * 64 * 128;
#pragma unroll
        for (int j = 0; j < 4; ++j)
#pragma unroll
            for (int r = 0; r < 4; ++r) co[(size_t)(16 * tb + 4 * fq + r) * 128 + (4 * wh + j) * 16 + fr] = cacc[j][r];
        if (wh == 0 && fr == 0) {
#pragma unroll
            for (int r = 0; r < 4; ++r) n_out[(size_t)(b * 8 + h) * 64 + 16 * tb + 4 * fq + r] = cacc[4][r]; }
        if (tid == 0) m_out[b * 8 + h] = m_prev;
    }
}
__device__ __forceinline__ void mlstm_sample_item(LAS unsigned char* lds, int b, int h, const bf16* Qm, const bf16* Km, const bf16* Vm, const bf16* Om, const float* GTg, bf16* Hb, const float* onw,
                                                  const float* C_in, const float* n_in, const float* m_in, float* C_out, float* n_out, float* m_out) {
    constexpr int KQ = 0, VS = 4096, SCL = 8192, DENR = 8320, RED = 20480;
    const int tid = threadIdx.x, lane = tid & 63, w = __builtin_amdgcn_readfirstlane(tid >> 6), c4 = tid & 31, dg = tid >> 5;
    const size_t rowb = (size_t)MP + (size_t)b * 8;
    __syncthreads();
    { const int t = tid >> 6, d = tid & 63; const size_t g = (rowb + t) * 512 + h * 64 + d; LDSV(f32x2, KQ + tid * 8) = (f32x2){bf1(Km[g]), bf1(Qm[g])}; }
#pragma unroll
    for (int e = tid; e < 1024; e += 512) { const int t = e >> 7, d = e & 127; LDSV(float, VS + e * 4) = bf1(Vm[(rowb + t) * 1024 + h * 128 + d]); }
    if (tid == 0) { float m = m_in[b * 8 + h];
        for (int t = 0; t < 8; ++t) { const float li = GTg[(rowb + t) * 16 + h], lf = GTg[(rowb + t) * 16 + 8 + h]; const float mn = fmaxf(lf + m, li);
            LDSV(f32x4, SCL + t * 16) = (f32x4){__expf(lf + m - mn), __expf(li - mn), __expf(-mn), 0.f}; m = mn; }
        m_out[b * 8 + h] = m; }
    const size_t cbase = ((size_t)(b * 8 + h) * 64 + 4 * dg) * 128 + 4 * c4;
    f32x4 cc[4], pn[8]; float nn[4], pd[8];
#pragma unroll
    for (int i = 0; i < 4; ++i) { cc[i] = *(const f32x4*)(C_in + cbase + (size_t)i * 128); nn[i] = n_in[(size_t)(b * 8 + h) * 64 + 4 * dg + i]; }
    __syncthreads();
#pragma unroll
    for (int t = 0; t < 8; ++t) { const f32x4 vv = LDSV(f32x4, VS + (t * 128 + 4 * c4) * 4); const f32x4 sc = LDSV(f32x4, SCL + t * 16); f32x4 p = (f32x4){0.f, 0.f, 0.f, 0.f}; float d = 0.f;
#pragma unroll
        for (int i = 0; i < 4; ++i) { const f32x2 kq = LDSV(f32x2, KQ + (t * 64 + 4 * dg + i) * 8); const float ik = sc[1] * kq.x;
            cc[i] = cc[i] * sc[0] + vv * ik; p += cc[i] * kq.y; nn[i] = nn[i] * sc[0] + ik; d += nn[i] * kq.y; }
        pn[t] = p; pd[t] = d; }
#pragma unroll
    for (int t = 0; t < 8; ++t) { LDSV(f32x4, RED + ((dg * 8 + t) * 128 + 4 * c4) * 4) = pn[t]; if (c4 == 0) LDSV(float, DENR + (dg * 8 + t) * 4) = pd[t]; }
#pragma unroll
    for (int i = 0; i < 4; ++i) { *(f32x4*)(C_out + cbase + (size_t)i * 128) = cc[i]; if (c4 == 0) n_out[(size_t)(b * 8 + h) * 64 + 4 * dg + i] = nn[i]; }
    __syncthreads();
    { const int t = w; float o0 = 0.f, o1 = 0.f, dn = 0.f;
#pragma unroll
        for (int g = 0; g < 16; ++g) { const f32x2 x = LDSV(f32x2, RED + ((g * 8 + t) * 128 + 2 * lane) * 4); o0 += x.x; o1 += x.y; dn += LDSV(float, DENR + (g * 8 + t) * 4); }
        const float inv = 1.0f / fmaxf(fabsf(dn), LDSV(f32x4, SCL + t * 16)[2]); o0 *= inv; o1 *= inv;
        const float rstd = rsqrtf(wave_sum(o0 * o0 + o1 * o1) * (1.0f / 128.0f) + 1e-6f);
        const size_t g = (rowb + t) * 1024 + h * 128 + 2 * lane; const unsigned gg = *(const unsigned*)(Om + g);
        *(unsigned*)(Hb + g) = pk2(o0 * rstd * onw[h * 128 + 2 * lane] * bflo(gg), o1 * rstd * onw[h * 128 + 2 * lane + 1] * bfhi(gg)); }
}

__device__ __forceinline__ void small_unit_resid(LAS unsigned char* lds, const bf16* A, const bf16* Bt, int K, int R0, int C0, const float* basep, float* X, bf16* Xb, float* ssq) {
    const int tid = threadIdx.x, lane = tid & 63, w = __builtin_amdgcn_readfirstlane(tid >> 6), fr = lane & 15, fq = lane >> 4;
    const int kw = K >> 3;
    const bf16* ap = A + (size_t)(R0 + fr) * K + w * kw + 8 * fq;
    const bf16* bp = Bt + (size_t)(C0 + fr) * K + w * kw + 8 * fq;
    const size_t rs16 = (size_t)16 * K;
    f32x4 acc[4][4];
#pragma unroll
    for (int i = 0; i < 4; ++i)
#pragma unroll
        for (int j = 0; j < 4; ++j) acc[i][j] = (f32x4){0.f, 0.f, 0.f, 0.f};
    bf16x8 a0[4], b0[4], a1[4], b1[4];
#pragma unroll
    for (int i = 0; i < 4; ++i) { a0[i] = *(const bf16x8*)(ap + i * rs16); b0[i] = *(const bf16x8*)(bp + i * rs16); }
    for (int ks = 0; ks < kw; ks += 64) {
#pragma unroll
        for (int i = 0; i < 4; ++i) { a1[i] = *(const bf16x8*)(ap + i * rs16 + ks + 32); b1[i] = *(const bf16x8*)(bp + i * rs16 + ks + 32); }
#pragma unroll
        for (int i = 0; i < 4; ++i)
#pragma unroll
            for (int j = 0; j < 4; ++j) acc[i][j] = MFMA16(b0[j], a0[i], acc[i][j]);
        if (ks + 64 < kw) {
#pragma unroll
            for (int i = 0; i < 4; ++i) { a0[i] = *(const bf16x8*)(ap + i * rs16 + ks + 64); b0[i] = *(const bf16x8*)(bp + i * rs16 + ks + 64); }
        }
#pragma unroll
        for (int i = 0; i < 4; ++i)
#pragma unroll
            for (int j = 0; j < 4; ++j) acc[i][j] = MFMA16(b1[j], a1[i], acc[i][j]);
    }
    __syncthreads();
#pragma unroll
    for (int i = 0; i < 4; ++i)
#pragma unroll
        for (int j = 0; j < 4; ++j) LDSV(f32x4, w * 16384 + (16 * i + fr) * 256 + (((4 * j + fq) ^ fr) << 4)) = acc[i][j];
    __syncthreads();
    { const int row = tid >> 3, cg = tid & 7; f32x4 x0 = (f32x4){0.f, 0.f, 0.f, 0.f}, x1 = x0;
#pragma unroll
        for (int g = 0; g < 8; ++g) { x0 += LDSV(f32x4, g * 16384 + row * 256 + (((2 * cg) ^ (row & 15)) << 4)); x1 += LDSV(f32x4, g * 16384 + row * 256 + (((2 * cg + 1) ^ (row & 15)) << 4)); }
        const size_t off = (size_t)(R0 + row) * 1024 + C0 + 8 * cg;
        const f32x4 v0 = *(const f32x4*)(basep + off) + x0, v1 = *(const f32x4*)(basep + off + 4) + x1;
        *(f32x4*)(X + off) = v0; *(f32x4*)(X + off + 4) = v1;
        *(v4u*)(Xb + off) = (v4u){pk2(v0[0], v0[1]), pk2(v0[2], v0[3]), pk2(v1[0], v1[1]), pk2(v1[2], v1[3])};
        float sq = (v0[0] * v0[0] + v0[1] * v0[1]) + (v0[2] * v0[2] + v0[3] * v0[3]) + (v1[0] * v1[0] + v1[1] * v1[1]) + (v1[2] * v1[2] + v1[3] * v1[3]);
        sq += __shfl_xor(sq, 1); sq += __shfl_xor(sq, 2); sq += __shfl_xor(sq, 4);
        if (cg == 0) atomicAdd(ssq + R0 + row, sq); }
}

__device__ __forceinline__ void mlstm_gate_block(int rb, const bf16* Xb, const bf16* Wg  , const float* ss, const float* gb, float* GT) {
    const int lane = threadIdx.x & 63, fr = lane & 15, fq = lane >> 4;
    const int row = rb * 16 + fr;
    const bf16* bp = Wg + (size_t)fr * 1024 + 8 * fq; const bf16* ap = Xb + (size_t)row * 1024 + 8 * fq;
    f32x4 acc0 = (f32x4){0.f, 0.f, 0.f, 0.f}, acc1 = acc0;
#pragma unroll
    for (int k0 = 0; k0 < 32; k0 += 8) { bf16x8 af[8], bf[8];
#pragma unroll
        for (int kk = 0; kk < 8; ++kk) { af[kk] = *(const bf16x8*)(ap + (k0 + kk) * 32); bf[kk] = *(const bf16x8*)(bp + (k0 + kk) * 32); }
#pragma unroll
        for (int kk = 0; kk < 8; kk += 2) { acc0 = MFMA16(bf[kk], af[kk], acc0); acc1 = MFMA16(bf[kk + 1], af[kk + 1], acc1); } }
    const f32x4 gbv = *(const f32x4*)(gb + 4 * fq); const float rs = rsqrtf(ss[row] * (1.0f / 1024.0f) + 1e-6f); f32x4 o;
#pragma unroll
    for (int r = 0; r < 4; ++r) { const float y2 = ((acc0[r] + acc1[r]) * rs + gbv[r]) * (2.0f / 15.0f); const float z = 15.0f - 30.0f * __builtin_amdgcn_rcpf(__expf(y2) + 1.0f); o[r] = fq < 2 ? z : -__logf(1.0f + __expf(-z)); }
    *(f32x4*)(GT + (size_t)row * 16 + 4 * fq) = o;
}
struct Args { const float* in[19]; float* out; unsigned char* ws; int ph_lo, ph_hi, li, pad; };
#ifndef PG8_SP2
#define PG8_SP2 true
#endif
#ifndef PG8_ALIGN
#define PG8_ALIGN true
#endif
__global__ void __launch_bounds__(NWAVES * 64, 2) trunk_fwd(Args args) {
    extern __shared__ __attribute__((aligned(16))) unsigned char lds_raw[];
    LAS unsigned char* lds = (LAS unsigned char*)lds_raw;
    volatile LAS unsigned* MISC = (volatile LAS unsigned*)(lds + MISC_OFF);
    const int tid = threadIdx.x, lane = tid & 63, wave = __builtin_amdgcn_readfirstlane(tid >> 6);
    const int G = gridDim.x, bx = blockIdx.x;
    unsigned char* ws = args.ws; float* out = args.out;
    gu32* ctl = (gu32*)(ws + WS_CTL);
    float* SS = (float*)(ws + WS_SS); float* LB = (float*)(ws + WS_LB);
    bf16* Win0 = (bf16*)(ws + WS_WIN0); bf16* Wout0 = (bf16*)(ws + WS_WOUT0); bf16* Wup0 = (bf16*)(ws + WS_WUP0); bf16* Wdn0 = (bf16*)(ws + WS_WDN0);
    bf16* Win1 = (bf16*)(ws + WS_WIN1); bf16* Wout1 = (bf16*)(ws + WS_WOUT1); bf16* Wup1 = (bf16*)(ws + WS_WUP1); bf16* Wdn1 = (bf16*)(ws + WS_WDN1);
    bf16* Xb = (bf16*)(ws + WS_XB); bf16* U = (bf16*)(ws + WS_ACT);
    bf16* Qb = (bf16*)(ws + WS_Q); bf16* LFb = (bf16*)(ws + WS_LF); bf16* Vb = (bf16*)(ws + WS_V); bf16* Gb = (bf16*)(ws + WS_G);
    bf16* Qm = (bf16*)(ws + WS_QM); bf16* Km = (bf16*)(ws + WS_KM); bf16* Vm = (bf16*)(ws + WS_VM); bf16* Om = (bf16*)(ws + WS_OM); float* GTg = (float*)(ws + WS_GT);
    float* X = out + OUT_Y;
    for (int u = tid; u < (LDS_BYTES - LDSCTL_OFF) / 4; u += NWAVES * 64) ((LAS unsigned*)(lds + LDSCTL_OFF))[u] = 0u;
    __syncthreads();
    XcdBarrier bar; bar.bar = (unsigned*)(ctl + CW_BAR); bar.x = 0; bar.st = nullptr;
    if (MK_N_LAUNCHES == 1) bar = xcd_barrier_post((unsigned*)(ctl + CW_BAR), MISC + 8);
    const int lo = args.ph_lo, hi = args.ph_hi;
#define IN(k) (lo <= (k) && (k) < hi)
#define SEAM(k) do { if (IN(k) && IN((k) + 1)) xcd_barrier(bar); } while (0)

    if (IN(0)) {
        LAS float* scr = (LAS float*)(lds + wave * 16384);
        const int gw = bx * NWAVES + wave, NGW = G * NWAVES;
        constexpr int I0 = 16 * 128, I1 = 16 * 32, I2 = 16 * 128, I3 = 64 * 32, I4 = 16 * 97, I5 = I1, I6 = I2, I7 = I3, NITEMS = I0 + I1 + I2 + I3 + I4 + I5 + I6 + I7;
        for (int it = gw; it < NITEMS; it += NGW) {
            int r = it;
            if (r < I0) { p0_transpose_item(args.in[8], 1024, 4096, args.in[6], Win0, scr, r, lane); continue; } r -= I0;
            if (r < I1) { p0_transpose_item(args.in[11], 1024, 1024, nullptr, Wout0, scr, r, lane); continue; } r -= I1;
            if (r < I2) { p0_transpose_item(args.in[16], 1024, 4096, args.in[7], Wup0, scr, r, lane); continue; } r -= I2;
            if (r < I3) { p0_transpose_item(args.in[17], 4096, 1024, nullptr, Wdn0, scr, r, lane); continue; } r -= I3;
            if (r < I4) { p0_transpose_item(args.in[12], 1024, NIN1, args.in[6] + 1024, Win1, scr, r, lane); continue; } r -= I4;
            if (r < I5) { p0_transpose_item(args.in[15], 1024, 1024, nullptr, Wout1, scr, r, lane); continue; } r -= I5;
            if (r < I6) { p0_transpose_item(args.in[16] + (size_t)1024 * 4096, 1024, 4096, args.in[7] + 1024, Wup1, scr, r, lane); continue; } r -= I6;
            p0_transpose_item(args.in[17] + (size_t)4096 * 1024, 4096, 1024, nullptr, Wdn1, scr, r, lane);
        }
        for (int m = gw; m < MROWS; m += NGW) {
            const float* xr = m < MP ? args.in[0] + (size_t)m * 1024 : args.in[1] + (size_t)(m - MP) * 1024;
            f32x4 v[4]; float s = 0.f;
#pragma unroll
            for (int j = 0; j < 4; ++j) { v[j] = *((const f32x4*)xr + lane + 64 * j); s += (v[j][0] * v[j][0] + v[j][1] * v[j][1]) + (v[j][2] * v[j][2] + v[j][3] * v[j][3]); }
            s = wave_sum(s); if (lane == 0) SS[m] = s;
#pragma unroll
            for (int j = 0; j < 4; ++j) *((v2u*)(Xb + (size_t)m * 1024) + lane + 64 * j) = (v2u){pk2(v[j][0], v[j][1]), pk2(v[j][2], v[j][3])};
        }
        if (bx == 0) for (int d = tid; d < 1024; d += NWAVES * 64) { const float l0 = args.in[9][d], l1 = args.in[9][1024 + d], l2 = args.in[9][2048 + d]; const float mx = fmaxf(l0, fmaxf(l1, l2));
            const float e0 = expf(l0 - mx), e1 = expf(l1 - mx), e2 = expf(l2 - mx); LB[d] = e0 / (e0 + e1 + e2); }
    }
    SEAM(0);
    if (IN(1)) { pg8::Gemm g{Xb, Win0, MP, 4096, 1024}; pg8::StaticOrder S; S.init(MP, 4096, G, bx);
        pg8::EpiHgrnIn E{Qb, LFb, Vb, Gb, SS, LB};
        pg8::gemm_phase_x<pg8::EpiHgrnIn, pg8::StaticOrder>(lds, g, MP, S, E); }
    SEAM(1);
    if (IN(2)) {
        float* Escr = (float*)(ws + WS_XB); float* Dscr = (float*)(ws + WS_XB + 16 * MiB);
        for (int it = bx; it < 192; it += G) hgrn_seg_item<true>(lds, (it / 3) >> 3, (it / 3) & 7, it % 3, Qb, LFb, Vb, Gb, Qb, args.in[10], Escr, Dscr, out + OUT_SP);
        for (int it = bx; it < 768; it += G) hgrn_sample_item(lds, it >> 3, it & 7, Qb, LFb, Vb, Gb, Qb, args.in[10], args.in[2], out + OUT_SS);
        if (G == 256) { if (bx >= 192) for (int it = 768 + (bx - 192) * 4; it < 772 + (bx - 192) * 4; ++it) hgrn_sample_item(lds, it >> 3, it & 7, Qb, LFb, Vb, Gb, Qb, args.in[10], args.in[2], out + OUT_SS); }
        else for (int it = 768 + bx; it < 1024; it += G) hgrn_sample_item(lds, it >> 3, it & 7, Qb, LFb, Vb, Gb, Qb, args.in[10], args.in[2], out + OUT_SS);
    }
    SEAM(2);
    if (IN(3)) {
        float* Escr = (float*)(ws + WS_XB); float* Dscr = (float*)(ws + WS_XB + 16 * MiB);
        for (int it = bx; it < 256; it += G) hgrn_seg_item<false>(lds, it >> 5, (it >> 2) & 7, it & 3, Qb, LFb, Vb, Gb, Qb, args.in[10], Escr, Dscr, out + OUT_SP);
    }
    SEAM(3);
    if (IN(4)) { pg8::Gemm g{Qb, Wout0, MP, 1024, 1024}; pg8::StaticOrder S; S.init(MP, 1024, G, bx);
        pg8::EpiResid<true> E{args.in[0], args.in[1], Xb, SS + MROWS};
        pg8::gemm_phase_x<pg8::EpiResid<true>, pg8::StaticOrder>(lds, g, MP, S, E); }
    SEAM(4);
    if (IN(5)) { pg8::Gemm g{Xb, Wup0, MP, 4096, 1024}; pg8::StaticOrder S; S.init(MP, 4096, G, bx);
        pg8::EpiUp E{U, SS + MROWS};
        pg8::gemm_phase_x<pg8::EpiUp, pg8::StaticOrder>(lds, g, MP, S, E); }
    SEAM(5);
    if (IN(6)) { pg8::Gemm g{U, Wdn0, MP, 1024, 4096}; pg8::StaticOrder S; S.init(MP, 1024, G, bx);
        pg8::EpiResid<false> E{nullptr, nullptr, Xb, SS + 2 * MROWS};
        pg8::gemm_phase_x<pg8::EpiResid<false>, pg8::StaticOrder>(lds, g, MP, S, E); }
    SEAM(6);
    if (IN(7)) { pg8::Gemm g{Xb, Win1, MP, 3072, 1024}; pg8::StaticOrder S; S.init(MP, 3072, G, bx);
        pg8::EpiMlstmIn E{Qm, Km, Vm, Om, GTg, SS + 2 * MROWS, args.in[13]};
        pg8::gemm_phase_x<pg8::EpiMlstmIn, pg8::StaticOrder>(lds, g, MP, S, E);
        for (int rb = wave * G + bx; rb < MROWS / 16; rb += NWAVES * G) mlstm_gate_block(rb, Xb, Win1 + (size_t)3072 * 1024, SS + 2 * MROWS, args.in[13], GTg); }
    SEAM(7);
    if (IN(8)) {
        float* Escr = (float*)(ws + WS_GT + 2 * MiB); float* Mscr = (float*)(ws + WS_GT + 14 * MiB);
        for (int it = bx; it < 192; it += G) mlstm_seg_item<true>(lds, (it / 3) >> 3, (it / 3) & 7, it % 3, Qm, Km, Vm, Om, GTg, Vm, args.in[14], Escr, Mscr, out + OUT_CP, out + OUT_NP, out + OUT_MP);
        for (int it = bx; it < 768; it += G) mlstm_sample_item(lds, it >> 3, it & 7, Qm, Km, Vm, Om, GTg, Vm, args.in[14], args.in[3], args.in[4], args.in[5], out + OUT_CS, out + OUT_NS, out + OUT_MS);
        if (G == 256) { if (bx >= 192) for (int it = 768 + (bx - 192) * 4; it < 772 + (bx - 192) * 4; ++it) mlstm_sample_item(lds, it >> 3, it & 7, Qm, Km, Vm, Om, GTg, Vm, args.in[14], args.in[3], args.in[4], args.in[5], out + OUT_CS, out + OUT_NS, out + OUT_MS); }
        else for (int it = 768 + bx; it < 1024; it += G) mlstm_sample_item(lds, it >> 3, it & 7, Qm, Km, Vm, Om, GTg, Vm, args.in[14], args.in[3], args.in[4], args.in[5], out + OUT_CS, out + OUT_NS, out + OUT_MS);
    }
    SEAM(8);
    if (IN(9)) {
        float* Escr = (float*)(ws + WS_GT + 2 * MiB); float* Mscr = (float*)(ws + WS_GT + 14 * MiB);
        for (int it = bx; it < 256; it += G) mlstm_seg_item<false>(lds, it >> 5, (it >> 2) & 7, it & 3, Qm, Km, Vm, Om, GTg, Vm, args.in[14], Escr, Mscr, out + OUT_CP, out + OUT_NP, out + OUT_MP);
    }
    SEAM(9);
    if (IN(10)) { pg8::Gemm g{Vm, Wout1, MP, 1024, 1024}; pg8::StaticOrder S; S.init(MP, 1024, G, bx);
        pg8::EpiResid<false> E{nullptr, nullptr, Xb, SS + 3 * MROWS};
        pg8::gemm_phase_x<pg8::EpiResid<false>, pg8::StaticOrder>(lds, g, MP, S, E); }
    SEAM(10);
    if (IN(11)) { pg8::Gemm g{Xb, Wup1, MP, 4096, 1024}; pg8::StaticOrder S; S.init(MP, 4096, G, bx);
        pg8::EpiUp E{U, SS + 3 * MROWS};
        pg8::gemm_phase_x<pg8::EpiUp, pg8::StaticOrder>(lds, g, MP, S, E); }
    SEAM(11);
    if (IN(12)) { pg8::Gemm g{U, Wdn1, MP, 1024, 4096}; pg8::StaticOrder S; S.init(MP, 1024, G, bx);
        pg8::EpiResid<false> E{nullptr, nullptr, Xb, SS + 4 * MROWS};
        pg8::gemm_phase_x<pg8::EpiResid<false>, pg8::StaticOrder>(lds, g, MP, S, E); }
    SEAM(12);
    if (IN(13)) {
        const int gw = bx * NWAVES + wave, NGW = G * NWAVES; const float* wf = args.in[18];
        f32x4 wv[4];
#pragma unroll
        for (int j = 0; j < 4; ++j) wv[j] = *((const f32x4*)wf + lane + 64 * j);
        for (int m = gw; m < MROWS; m += NGW) { const float rs = rsqrtf(SS[4 * MROWS + m] * (1.0f / 1024.0f) + 1e-6f); f32x4* yr = (f32x4*)(X + (size_t)m * 1024); const v2u* xr = (const v2u*)(Xb + (size_t)m * 1024);
#pragma unroll
            for (int j = 0; j < 4; ++j) { const v2u x = xr[lane + 64 * j]; yr[lane + 64 * j] = (f32x4){bflo(x.x), bfhi(x.x), bflo(x.y), bfhi(x.y)} * rs * wv[j]; } }
    }
#undef IN
#undef SEAM
}

extern "C" void kernel_launch(void* const* d_in, const int* in_sizes, int n_in, void* d_out, int out_size, void* d_ws, size_t ws_size, hipStream_t stream) {
    static int grid = 0;
    if (grid == 0) {
        if (n_in != 19 || out_size != (int)OUT_END || ws_size < WS_END) { fprintf(stderr, "kernel_launch: unexpected shapes: n_in %d out %d ws %zu\n", n_in, out_size, ws_size); grid = -1; return; }
        int dev = 0, cus = 0, per_cu = 0;
        if (hipGetDevice(&dev) != hipSuccess || hipDeviceGetAttribute(&cus, hipDeviceAttributeMultiprocessorCount, dev) != hipSuccess) { grid = -1; return; }
        if (hipFuncSetAttribute((const void*)trunk_fwd, hipFuncAttributeMaxDynamicSharedMemorySize, LDS_BYTES) != hipSuccess) { fprintf(stderr, "kernel_launch: hipFuncSetAttribute failed\n"); grid = -1; return; }
        if (hipOccupancyMaxActiveBlocksPerMultiprocessor(&per_cu, (const void*)trunk_fwd, NWAVES * 64, LDS_BYTES) != hipSuccess || per_cu < 1) { fprintf(stderr, "kernel_launch: occupancy query says %d blocks per CU\n", per_cu); grid = -1; return; }
        (void)hipGetLastError();
        grid = cus;
    }
    if (grid < 0) return;
    (void)hipMemsetAsync((char*)d_ws + WS_CTL, 0, CTL_ZERO_BYTES, stream);
    Args a{};
    for (int i = 0; i < 19; ++i) a.in[i] = (const float*)d_in[i];
    a.out = (float*)d_out; a.ws = (unsigned char*)d_ws;
#if MK_N_LAUNCHES == 1
    a.ph_lo = 0; a.ph_hi = N_PHASES; a.li = 0;
    hipLaunchKernelGGL(trunk_fwd, dim3(grid), dim3(NWAVES * 64), LDS_BYTES, stream, a);
#else
    for (int li = 0; li < N_PHASES; ++li) { a.ph_lo = li; a.ph_hi = li + 1; a.li = li; hipLaunchKernelGGL(trunk_fwd, dim3(grid), dim3(NWAVES * 64), LDS_BYTES, stream, a); }
#endif
}
```
